# Optimizing an MI355X kernel written in HIP

```python
import math
import jax
import jax.numpy as jnp
from jax import lax
import numpy as np

D_MODEL = 2048
BATCH = 4
SEQ = 4096
DEPTH = 1

HEAD_DIM = 128
DIL_GROUPS = ((128, 1), (512, 4), (2048, 16))
DIL_HEADS_PER_GROUP = 4
N_DIL_HEADS = len(DIL_GROUPS) * DIL_HEADS_PER_GROUP
N_DIFF_HEADS = 4
DIFF_DIM = HEAD_DIM // 2
BRANCH_WIDTH = DIL_HEADS_PER_GROUP * HEAD_DIM
N_BRANCHES = 2
ROPE_THETA = 500000.0
ROPE_FRACTION = 4
N_EXPERTS = 16
EXPERT_FF = 2048
EC_CAPACITY = 2
LN_EPS = 1e-5
DIFF_NORM_EPS = 1e-5
Q_BLOCK = 128
ALPHA = (2 * DEPTH) ** 0.25
BETA = (8 * DEPTH) ** -0.25
NEG_INF = -1e30

A_QKV = N_DIL_HEADS * HEAD_DIM
B_QK = N_DIFF_HEADS * 2 * DIFF_DIM
B_V = N_DIFF_HEADS * HEAD_DIM
GATE_COLS = N_BRANCHES * D_MODEL
IN_COLS = 3 * A_QKV + 2 * B_QK + B_V + GATE_COLS

kernel_name = "dilated_diff_attn_ec_moe_deepnorm_block"


def _normal(key, shape, scale):
    return jax.random.normal(key, shape, jnp.float32) * scale


def layer_norm(x, g, b):
    x32 = x.astype(jnp.float32)
    mu = jnp.mean(x32, axis=-1, keepdims=True)
    var = jnp.mean(jnp.square(x32 - mu), axis=-1, keepdims=True)
    y = (x32 - mu) * lax.rsqrt(var + LN_EPS) * g.astype(jnp.float32) + b.astype(jnp.float32)
    return y.astype(x.dtype)


def rope_partial(x, pos):
    dh = x.shape[-1]
    rot = dh // ROPE_FRACTION
    half = rot // 2
    inv_freq = ROPE_THETA ** (-2.0 * jnp.arange(half, dtype=jnp.float32) / rot)
    ang = pos.astype(jnp.float32)[:, None] * inv_freq[None, :]
    shape = (1, pos.shape[0]) + (1,) * (x.ndim - 3) + (half,)
    cos = jnp.cos(ang).reshape(shape).astype(x.dtype)
    sin = jnp.sin(ang).reshape(shape).astype(x.dtype)
    x1 = x[..., :half]
    x2 = x[..., half:rot]
    return jnp.concatenate([x1 * cos - x2 * sin, x2 * cos + x1 * sin, x[..., rot:]], axis=-1)


def band_attention(q, k, v, half):
    b_, n_, L, dh = q.shape
    qb = half
    nb = -(-L // qb)
    Lp = nb * qb
    qp = jnp.pad(q, ((0, 0), (0, 0), (0, Lp - L), (0, 0)))
    kv_pad = ((0, 0), (0, 0), (half, Lp - L + half), (0, 0))
    kp = jnp.pad(k, kv_pad)
    vp = jnp.pad(v, kv_pad)
    kb = qb + 2 * half
    idx = (jnp.arange(nb) * qb)[:, None] + jnp.arange(kb)[None, :]
    k_blk = kp[:, :, idx]
    v_blk = vp[:, :, idx]
    q_blk = qp.reshape(b_, n_, nb, qb, dh)
    s = jnp.einsum('bniqd,bnikd->bniqk', q_blk, k_blk).astype(jnp.float32) * (dh ** -0.5)
    qpos = (jnp.arange(nb) * qb)[:, None] + jnp.arange(qb)[None, :]
    kpos = (idx - half)[:, None, :]
    valid = (jnp.abs(qpos[:, :, None] - kpos) <= half) & (kpos >= 0) & (kpos < L)
    s = jnp.where(valid, s, NEG_INF)
    m = jnp.max(s, axis=-1, keepdims=True)
    p = jnp.exp(s - m)
    den = jnp.sum(p, axis=-1, keepdims=True)
    o = jnp.einsum('bniqk,bnikd->bniqd', (p / den).astype(v.dtype), v_blk)
    lse = (m + jnp.log(den))[..., 0]
    o = o.reshape(b_, n_, Lp, dh)[:, :, :L]
    lse = lse.reshape(b_, n_, Lp)[:, :, :L]
    return o, lse


def dilated_attention(q, k, v):
    b_, S, _, H, dh = q.shape
    outs, lses = [], []
    for g, (window, r) in enumerate(DIL_GROUPS):
        L = S // r

        def to_strided(t):
            return t.reshape(b_, L, r, H, dh).transpose(0, 3, 2, 1, 4).reshape(b_, H * r, L, dh)

        o, lse = band_attention(to_strided(q[:, :, g]), to_strided(k[:, :, g]),
                                to_strided(v[:, :, g]), window // (2 * r))
        outs.append(o.reshape(b_, H, r, L, dh).transpose(0, 3, 2, 1, 4).reshape(b_, S, H, dh))
        lses.append(lse.reshape(b_, H, r, L).transpose(0, 3, 2, 1).reshape(b_, S, H))
    o = jnp.stack(outs, axis=2)
    w = jax.nn.softmax(jnp.stack(lses, axis=2), axis=2)
    return jnp.sum(o * w[..., None].astype(o.dtype), axis=2)


def diff_attention(q, k, v, lam, norm_w, lambda_init):
    b_, S, H, _, dc = q.shape
    dv = v.shape[-1]
    nb = S // Q_BLOCK
    kt = k.transpose(0, 2, 3, 1, 4)
    vt = v.transpose(0, 2, 1, 3)
    q_blocks = q.transpose(0, 2, 3, 1, 4).reshape(b_, H, 2, nb, Q_BLOCK, dc).transpose(3, 0, 1, 2, 4, 5)
    scale = dc ** -0.5

    def one_block(qb):
        s = jnp.einsum('bhcqd,bhckd->bhcqk', qb, kt).astype(jnp.float32) * scale
        p = jax.nn.softmax(s, axis=-1)
        a = p[:, :, 0] - lam * p[:, :, 1]
        return jnp.einsum('bhqk,bhkd->bhqd', a.astype(vt.dtype), vt)

    o = lax.map(one_block, q_blocks)
    o = o.transpose(1, 0, 3, 2, 4).reshape(b_, S, H, dv)
    o32 = o.astype(jnp.float32)
    o32 = o32 * lax.rsqrt(jnp.mean(jnp.square(o32), axis=-1, keepdims=True) + DIFF_NORM_EPS)
    o32 = o32 * norm_w.astype(jnp.float32) * (1.0 - lambda_init)
    return o32.astype(v.dtype)


def expert_choice_ffn(x, w_router, w_gate, w_up, w_down):
    b_, S, D = x.shape
    cap = EC_CAPACITY * S // N_EXPERTS
    aff = jax.nn.softmax(jnp.einsum('bsd,de->bse', x, w_router).astype(jnp.float32), axis=-1)
    gates, idx = lax.top_k(aff.transpose(0, 2, 1), cap)
    xin = jax.vmap(lambda xb, ib: xb[ib])(x, idx)
    h = jax.nn.silu(jnp.einsum('becd,edf->becf', xin, w_gate)) * jnp.einsum('becd,edf->becf', xin, w_up)
    out = jnp.einsum('becf,efd->becd', h, w_down) * gates[..., None].astype(x.dtype)
    y = jax.vmap(lambda ib, ob: jnp.zeros((S, D), x.dtype).at[ib.reshape(-1)].add(ob.reshape(-1, D)))(idx, out)
    return y


def setup_inputs(seed: int = 0) -> dict:
    key = jax.random.key(seed)
    ks = jax.random.split(key, 20)
    d_sc = D_MODEL ** -0.5
    x = _normal(ks[0], (BATCH, SEQ, D_MODEL), 1.0)
    w_in = jnp.concatenate([
        _normal(ks[1], (DEPTH, D_MODEL, 2 * A_QKV), d_sc),
        _normal(ks[2], (DEPTH, D_MODEL, A_QKV), d_sc * BETA),
        _normal(ks[3], (DEPTH, D_MODEL, 2 * B_QK), d_sc),
        _normal(ks[4], (DEPTH, D_MODEL, B_V), d_sc * BETA),
        _normal(ks[5], (DEPTH, D_MODEL, GATE_COLS), d_sc),
    ], axis=-1)
    lambda_q1 = _normal(ks[6], (DEPTH, DIFF_DIM), 0.1)
    lambda_k1 = _normal(ks[7], (DEPTH, DIFF_DIM), 0.1)
    lambda_q2 = _normal(ks[8], (DEPTH, DIFF_DIM), 0.1)
    lambda_k2 = _normal(ks[9], (DEPTH, DIFF_DIM), 0.1)
    diff_norm_w = 1.0 + _normal(ks[10], (DEPTH, HEAD_DIM), 0.01)
    w_branch = _normal(ks[11], (DEPTH, N_BRANCHES, BRANCH_WIDTH, D_MODEL), BRANCH_WIDTH ** -0.5 * BETA)
    w_out = _normal(ks[12], (DEPTH, D_MODEL, D_MODEL), d_sc * BETA)
    ln1_g = 1.0 + _normal(ks[13], (DEPTH, D_MODEL), 0.01)
    ln1_b = _normal(ks[14], (DEPTH, D_MODEL), 0.01)
    w_router = _normal(ks[15], (DEPTH, D_MODEL, N_EXPERTS), d_sc)
    w_gate = _normal(ks[16], (DEPTH, N_EXPERTS, D_MODEL, EXPERT_FF), d_sc * BETA)
    w_up = _normal(ks[17], (DEPTH, N_EXPERTS, D_MODEL, EXPERT_FF), d_sc * BETA)
    w_down = _normal(ks[18], (DEPTH, N_EXPERTS, EXPERT_FF, D_MODEL), EXPERT_FF ** -0.5 * BETA)
    k_ln2g, k_ln2b = jax.random.split(ks[19])
    ln2_g = 1.0 + _normal(k_ln2g, (DEPTH, D_MODEL), 0.01)
    ln2_b = _normal(k_ln2b, (DEPTH, D_MODEL), 0.01)
    return {"x": x, "w_in": w_in, "lambda_q1": lambda_q1, "lambda_k1": lambda_k1,
            "lambda_q2": lambda_q2, "lambda_k2": lambda_k2, "diff_norm_w": diff_norm_w,
            "w_branch": w_branch, "w_out": w_out, "ln1_g": ln1_g, "ln1_b": ln1_b,
            "w_router": w_router, "w_gate": w_gate, "w_up": w_up, "w_down": w_down,
            "ln2_g": ln2_g, "ln2_b": ln2_b}


def reference(x, w_in, lambda_q1, lambda_k1, lambda_q2, lambda_k2, diff_norm_w,
              w_branch, w_out, ln1_g, ln1_b, w_router, w_gate, w_up, w_down, ln2_g, ln2_b):
    b_, S, D = x.shape
    pos = jnp.arange(S)
    o1 = A_QKV
    o2 = 2 * A_QKV
    o3 = 3 * A_QKV
    o4 = o3 + B_QK
    o5 = o4 + B_QK
    o6 = o5 + B_V
    n_groups = len(DIL_GROUPS)
    for l in range(DEPTH):
        lambda_init = 0.8 - 0.6 * math.exp(-0.3 * l)
        z = jnp.einsum('bsd,dc->bsc', x, w_in[l])
        qa = z[..., :o1].reshape(b_, S, n_groups, DIL_HEADS_PER_GROUP, HEAD_DIM)
        ka = z[..., o1:o2].reshape(b_, S, n_groups, DIL_HEADS_PER_GROUP, HEAD_DIM)
        va = z[..., o2:o3].reshape(b_, S, n_groups, DIL_HEADS_PER_GROUP, HEAD_DIM)
        qb = z[..., o3:o4].reshape(b_, S, N_DIFF_HEADS, 2, DIFF_DIM)
        kb = z[..., o4:o5].reshape(b_, S, N_DIFF_HEADS, 2, DIFF_DIM)
        vb = z[..., o5:o6].reshape(b_, S, N_DIFF_HEADS, HEAD_DIM)
        gate = jax.nn.sigmoid(z[..., o6:].reshape(b_, S, N_BRANCHES, D))
        out_a = dilated_attention(rope_partial(qa, pos), rope_partial(ka, pos), va)
        lam = (jnp.exp(jnp.sum(lambda_q1[l].astype(jnp.float32) * lambda_k1[l].astype(jnp.float32)))
               - jnp.exp(jnp.sum(lambda_q2[l].astype(jnp.float32) * lambda_k2[l].astype(jnp.float32)))
               + lambda_init)
        out_b = diff_attention(rope_partial(qb, pos), rope_partial(kb, pos), vb, lam, diff_norm_w[l], lambda_init)
        branches = jnp.stack([out_a.reshape(b_, S, BRANCH_WIDTH), out_b.reshape(b_, S, BRANCH_WIDTH)], axis=2)
        branch_d = jnp.einsum('bsgc,gcd->bsgd', branches, w_branch[l])
        merged = jnp.sum(gate * branch_d, axis=2)
        mix = jnp.einsum('bsd,de->bse', merged, w_out[l])
        x = layer_norm(ALPHA * x + mix, ln1_g[l], ln1_b[l])
        y = expert_choice_ffn(x, w_router[l], w_gate[l], w_up[l], w_down[l])
        x = layer_norm(ALPHA * x + y, ln2_g[l], ln2_b[l])
    return x
```

```cpp
#include <hip/hip_runtime.h>
#include <hip/hip_cooperative_groups.h>
#include <cstdio>
#include <cstdint>
namespace cg = cooperative_groups;

#define LAS __attribute__((address_space(3)))
typedef unsigned short bf16_t;
typedef short bf16x8 __attribute__((ext_vector_type(8)));
typedef short s16x4 __attribute__((ext_vector_type(4)));
typedef float f32x4 __attribute__((ext_vector_type(4)));
typedef float f32x16 __attribute__((ext_vector_type(16)));
typedef unsigned u32x4 __attribute__((ext_vector_type(4)));
typedef unsigned u32x2 __attribute__((ext_vector_type(2)));
typedef int i32x4 __attribute__((ext_vector_type(4)));
typedef int i32x8 __attribute__((ext_vector_type(8)));

constexpr int T_TOK = 16384, DM = 2048, SEQ = 4096, NB = 4, ZC = 10240, NE = 16, CAP = 512;
constexpr float ALPHA = 1.189207115002721f;
constexpr float LN_EPS = 1e-5f;
constexpr float SX8 = 8.f, SW8 = 64.f, SH8 = 16.f, SWG8 = 32.f;
constexpr int LDS_BG = 67584, LDS_BARW = 135168;
constexpr int LDS_BYTES = LDS_BARW + 64;
constexpr int NTHREADS = 512;
#ifndef PHASE_MASK
#define PHASE_MASK 0xFFFF
#endif
#ifndef REP_MASK
#define REP_MASK 0
#endif
#define REPS(k) for (int rep_ = 0; rep_ < 1 + ((REP_MASK >> (k)) & 1); ++rep_)

constexpr size_t MiB = (size_t)1 << 20;
constexpr size_t WS_WGUT = 0, WS_WDT = 128 * MiB;
constexpr size_t WS_XB = 384 * MiB, WS_WINT = 448 * MiB, WS_Z = 488 * MiB;
constexpr size_t WS_XG = 384 * MiB, WS_YS = 384 * MiB, WS_H = 512 * MiB;
constexpr size_t WS_WBT = 808 * MiB, WS_WOT = 812 * MiB, WS_COSA = 820 * MiB, WS_SINA = WS_COSA + 256 * 1024,
                 WS_COSB = WS_SINA + 256 * 1024, WS_SINB = WS_COSB + 128 * 1024, WS_WRT = 821 * MiB,
                 WS_AFFT = 822 * MiB, WS_SLOT = 823 * MiB, WS_GATE = 824 * MiB, WS_LSEG = 825 * MiB;
constexpr size_t WS_BR = 826 * MiB, WS_MERGED = 858 * MiB, WS_OG = 922 * MiB, WS_O0 = 970 * MiB;
constexpr size_t WS_X1B = 922 * MiB;
constexpr size_t WS_GF = 192 * MiB;
constexpr size_t WS_MIX = 576 * MiB;
constexpr size_t WS_X8 = 320 * MiB, WS_WING8 = 352 * MiB;
constexpr size_t WS_BARW = 1002 * MiB, WS_END = 1002 * MiB + 16384;

struct Params { const float* in[17]; float* out; unsigned char* ws; };

typedef __bf16 bf16x2_t __attribute__((ext_vector_type(2)));
typedef float f32x2_t __attribute__((ext_vector_type(2)));
__device__ __forceinline__ unsigned cvt_pk_bf16(float lo, float hi) { const f32x2_t v = {lo, hi}; const bf16x2_t b = __builtin_convertvector(v, bf16x2_t); return __builtin_bit_cast(unsigned, b); }
__device__ __forceinline__ unsigned cvt_pk4_fp8(float a, float b, float c, float d) { int w = __builtin_amdgcn_cvt_pk_fp8_f32(a, b, 0, false); w = __builtin_amdgcn_cvt_pk_fp8_f32(c, d, w, true); return (unsigned)w; }
__device__ __forceinline__ float bf_lo(unsigned w) { return __uint_as_float(w << 16); }
__device__ __forceinline__ float bf_hi(unsigned w) { return __uint_as_float(w & 0xffff0000u); }
__device__ __forceinline__ bf16_t f2bf(float f) { unsigned u = __float_as_uint(f); u += 0x7FFFu + ((u >> 16) & 1u); return (bf16_t)(u >> 16); }
template <int K> __device__ __forceinline__ float swz_xor(float v) { return __int_as_float(__builtin_amdgcn_ds_swizzle(__float_as_int(v), (K << 10) | 0x1f)); }
__device__ __forceinline__ float half_sum(float v) { v += swz_xor<1>(v); v += swz_xor<2>(v); v += swz_xor<4>(v); v += swz_xor<8>(v); v += swz_xor<16>(v); return v; }
__device__ __forceinline__ float wave_sum(float v) {
    v = half_sum(v);
    auto rr = __builtin_amdgcn_permlane32_swap(__float_as_uint(v), __float_as_uint(v), false, false);
    return __uint_as_float(rr[0]) + __uint_as_float(rr[1]);
}
__device__ __forceinline__ int fresh_tid() { int t = __builtin_amdgcn_workitem_id_x(); asm volatile("" : "+v"(t)); return t; }
#define LDS_WAIT() asm volatile("s_waitcnt lgkmcnt(0)" ::: "memory")


#define XB_TMO      128
#define XB_XCNT(j)  (256  + 64 * (j))
#define XB_XSUB(j)  (1280 + 64 * (j))
#define XB_XGEN(j)  (2304 + 64 * (j))
#define XB_TOP      3328
#define XB_TOPGEN   3392
#define XCD_BAR_WORDS 3456
#define XB_SPIN_CAP (1u << 18)
__device__ __forceinline__ unsigned xb_ld(unsigned* p)              { return __hip_atomic_load(p, __ATOMIC_RELAXED, __HIP_MEMORY_SCOPE_AGENT); }
__device__ __forceinline__ unsigned xb_add(unsigned* p, unsigned v) { return __hip_atomic_fetch_add(p, v, __ATOMIC_RELAXED, __HIP_MEMORY_SCOPE_AGENT); }
__device__ __forceinline__ unsigned xb_xcc_id() { return (unsigned)__builtin_amdgcn_s_getreg((3 << 11) | 20) & 0xFu; }
#define XB_SPIN(cond, bar) do { unsigned _sp = 0; while (cond) { __builtin_amdgcn_s_sleep(1); \
    if ((++_sp & 255u) == 0u) { if (xb_ld(&(bar)[XB_TMO])) break; if (_sp > XB_SPIN_CAP) { atomicAdd(&(bar)[XB_TMO], 1u); break; } } } } while (0)
struct XcdBarrier { unsigned* bar; unsigned x; volatile LAS unsigned* st; };
__device__ __forceinline__ XcdBarrier xcd_barrier_post(unsigned* bar, volatile LAS unsigned* st) {
    XcdBarrier b; b.bar = bar; b.x = xb_xcc_id(); b.st = st;
    if (fresh_tid() == 0) (void)xb_add(&bar[XB_XCNT(b.x)], 1u);
    return b;
}
__device__ __forceinline__ void xcd_barrier_complete(unsigned* bar, unsigned x, unsigned& nloc, unsigned& nx) {
    const unsigned G = gridDim.x * gridDim.y * gridDim.z;
    unsigned sum, cnt, mine, sp = 0u;
    for (;;) {
        sum = 0u; cnt = 0u; mine = 0u;
#pragma unroll
        for (unsigned j = 0; j < 16; ++j) { const unsigned c = xb_ld(&bar[XB_XCNT(j)]); sum += c; cnt += (c > 0u) ? 1u : 0u; mine = (j == x) ? c : mine; }
        if (sum == G) break;
        __builtin_amdgcn_s_sleep(1);
        if ((++sp & 255u) == 0u) { if (xb_ld(&bar[XB_TMO])) break; if (sp > XB_SPIN_CAP) { atomicAdd(&bar[XB_TMO], 1u); break; } }
    }
    nloc = mine > 0u ? mine : 1u; nx = cnt > 0u ? cnt : 1u;
}
__device__ __forceinline__ void xcd_barrier(const XcdBarrier& b) {
    asm volatile("s_waitcnt vmcnt(0)" ::: "memory");
    __syncthreads();
    if (fresh_tid() == 0) {
        unsigned* bar = b.bar;
        __builtin_amdgcn_s_waitcnt(0);
        unsigned nloc = b.st[0], nx = b.st[1];
        if (nloc == 0u) { xcd_barrier_complete(bar, b.x, nloc, nx); b.st[0] = nloc; b.st[1] = nx; }
        const unsigned old = xb_add(&bar[XB_XSUB(b.x)], 1u);
        const unsigned gen = old / nloc;
        if (old + 1u == (gen + 1u) * nloc) {
            __builtin_amdgcn_fence(__ATOMIC_RELEASE, "agent");
            asm volatile("s_waitcnt vmcnt(0)" ::: "memory");
            const unsigned og = xb_add(&bar[XB_TOP], 1u);
            const unsigned tg = og / nx;
            if (og + 1u == (tg + 1u) * nx) xb_add(&bar[XB_TOPGEN], 1u);
            else XB_SPIN(xb_ld(&bar[XB_TOPGEN]) == tg, bar);
            __builtin_amdgcn_fence(__ATOMIC_ACQUIRE, "agent");
            xb_add(&bar[XB_XGEN(b.x)], 1u);
            asm volatile("s_waitcnt vmcnt(0)" ::: "memory");
        } else {
            XB_SPIN(xb_ld(&bar[XB_XGEN(b.x)]) == gen, bar);
            __builtin_amdgcn_fence(__ATOMIC_ACQUIRE, "agent");
            asm volatile("s_waitcnt vmcnt(0)" ::: "memory");
        }
    }
    __syncthreads();
}

namespace pg8 {
constexpr int BM = 256, BK = 64, HALF = 128, HTB = HALF * BK * 2, STAGE_BYTES = 8 * HTB, NXCD = 8, WGM = 8;
__host__ __device__ __forceinline__ int lds_byte(int r, int c) { const int st = (r >> 4) * 2 + (c >> 5), rr = r & 15, cc = c & 31, ob = rr * 64 + cc * 2; return st * 1024 + (ob ^ (((ob >> 9) & 1) << 5)); }
__host__ __device__ __forceinline__ void stage_rc(int b, int& R, int& C) { const int st = b / 1024, sb = b % 1024, swz = sb ^ (((sb >> 9) & 1) << 5); R = (st >> 1) * 16 + swz / 64; C = (st & 1) * 32 + (swz % 64) / 2; }
__host__ __device__ __forceinline__ int perm32(int rho) { const int n = rho >> 4, i = rho & 15; return 8 * (i >> 2) + 4 * n + (i & 3); }
struct Unit { int pm, pn; };
struct Gemm { const bf16_t* A; const bf16_t* Bt; int M, N, K; };

__device__ __forceinline__ void static_map(int L, int nM, int nN, int& pm, int& pn) {
    const int nwg = nM * nN; int wgid = L;
    { const int q = nwg / NXCD, r = nwg % NXCD, xcd = wgid % NXCD, off = wgid / NXCD; wgid = (xcd < r ? xcd * (q + 1) : r * (q + 1) + (xcd - r) * q) + off; }
    const int nig = WGM * nN, gid = wgid / nig, fm = gid * WGM, gsz = (nM - fm) < WGM ? (nM - fm) : WGM;
    pm = fm + ((wgid % nig) % gsz); pn = (wgid % nig) / gsz;
}
struct StaticOrder {
    int nM, nN, nwg, G, c;
    __device__ void init(int M, int N, int G_, int c_) { nM = M / BM; nN = N / BM; nwg = nM * nN; G = G_; c = c_; }
    __device__ bool next(int i, Unit& u) const { const long L = (long)i * G + c; if (L >= nwg) return false; static_map((int)L, nM, nN, u.pm, u.pn); return true; }
    __device__ __forceinline__ void a_ready(const Unit&) const {}
    __device__ __forceinline__ void done(const Unit&) const {}
};
struct BranchOrder {
    int G, c;
    __device__ bool next(int i, Unit& u) const { const long L = (long)(i >> 1) * G + c; if (L >= 512) return false; int pm, pn; static_map((int)L, 64, 8, pm, pn); const int g = i & 1; u.pm = g * 64 + pm; u.pn = g * 8 + pn; return true; }
    __device__ __forceinline__ void a_ready(const Unit&) const {}
    __device__ __forceinline__ void done(const Unit&) const {}
};
struct InFp8Order {
    int G, c;
    __device__ bool next(int i, Unit& u) const { long L; if (G != 256) L = (long)i * G + c; else if (i < 8) L = (long)i * G + c; else if (i == 8 && c >= G / 2) L = 8L * G + (c - G / 2); else return false; if (L >= 2176) return false; static_map((int)L, 64, 34, u.pm, u.pn); return true; }
    __device__ __forceinline__ void a_ready(const Unit&) const {}
    __device__ __forceinline__ void done(const Unit&) const {}
};
struct InBf16Order {
    int G, c;
    __device__ bool next(int i, Unit& u) const { long L; if (G != 256) L = (long)i * G + c; else if (i == 0) L = c; else if (i == 1 && c < G / 2) L = (long)G + c; else return false; if (L >= 384) return false; static_map((int)L, 64, 6, u.pm, u.pn); return true; }
    __device__ __forceinline__ void a_ready(const Unit&) const {}
    __device__ __forceinline__ void done(const Unit&) const {}
};
struct UpOrder {
    int G, c;
    __device__ bool next(int i, Unit& u) const { const long L = (long)i * G + c; if (L >= 2048) return false; const int rd = (int)L >> 8, cc = (int)L & 255, x = cc & 7, k = cc >> 3;
        const int e = 2 * rd + (x >> 2), pn0 = (x & 3) * 4 + (k >> 3), pm0 = k & 7; u.pm = e * 8 + pm0; u.pn = e * 16 + pn0; return true; }
    __device__ __forceinline__ void a_ready(const Unit&) const {}
    __device__ __forceinline__ void done(const Unit&) const {}
};
struct DownOrder {
    int G, c;
    __device__ bool next(int i, Unit& u) const { const long L = (long)i * G + c; if (L >= 1024) return false; const int rd = (int)L >> 8, cc = (int)L & 255, x = cc & 7, k = cc >> 3;
        const int e = 4 * rd + (x >> 1), pn0 = (x & 1) * 4 + (k >> 3), pm0 = k & 7; u.pm = e * 8 + pm0; u.pn = e * 8 + pn0; return true; }
    __device__ __forceinline__ void a_ready(const Unit&) const {}
    __device__ __forceinline__ void done(const Unit&) const {}
};

template <class Epi, class Sched, bool FP8 = false>
__device__ __forceinline__ void gemm_phase(LAS unsigned char* lds, const Gemm g, const Sched& S, const Epi& E) {
    const int tid = fresh_tid(), wid = __builtin_amdgcn_readfirstlane(tid >> 6), lane = tid & 63, wr = wid >> 2, wc = wid & 3, fr = lane & 15, fq = lane >> 4;
    const int K = g.K, nt = FP8 ? K / 128 : K / BK, pitch = FP8 ? K : 2 * K;
    unsigned voffA[2], voffB[2];
#pragma unroll
    for (int i = 0; i < 2; ++i) { int R, C; stage_rc(tid * 16 + i * 8192, R, C); const int Rb = Epi::PERM ? ((R & ~31) + perm32(R & 31)) : R; voffA[i] = (unsigned)(R * pitch + C * 2); voffB[i] = (unsigned)(Rb * pitch + C * 2); }
    const size_t kstep = (size_t)(BK * 2);
    const size_t hstep = (size_t)HALF * pitch;
    const size_t tstep = 2 * hstep;
    const unsigned ldsw = (unsigned)wid * 1024u;
    const int aoff = lds_byte(wr * 64 + fr, fq * 8), boff = lds_byte(wc * 32 + fr, fq * 8);
#define PG8_SA(b, h) (((b) * 2 + (h)) * HTB)
#define PG8_SB(b, h) ((4 + (b) * 2 + (h)) * HTB)
#define PG8_STAGE(bufoff, gbase, voff) do { _Pragma("unroll") for (int _i = 0; _i < 2; ++_i) \
        __builtin_amdgcn_global_load_lds((const unsigned*)((const char*)(gbase) + (voff)[_i]), (LAS unsigned*)(lds + (bufoff) + ldsw + _i * 8192), 16, 0, 0); } while (0)
#define PG8_RD8(addr) __builtin_shufflevector(*(const LAS i32x4*)(addr), *(const LAS i32x4*)((addr) + 1024), 0, 1, 2, 3, 4, 5, 6, 7)
#define PG8_LDA(dst, b, h) do { _Pragma("unroll") for (int m = 0; m < 4; ++m) { if constexpr (FP8) dst##8[m] = PG8_RD8(lds + PG8_SA(b, h) + aoff + m * 2048); \
        else { _Pragma("unroll") for (int k = 0; k < 2; ++k) dst[m][k] = *(const LAS bf16x8*)(lds + PG8_SA(b, h) + aoff + m * 2048 + k * 1024); } } } while (0)
#define PG8_LDB(dst, b, h) do { _Pragma("unroll") for (int n = 0; n < 2; ++n) { if constexpr (FP8) dst##8[n] = PG8_RD8(lds + PG8_SB(b, h) + boff + n * 2048); \
        else { _Pragma("unroll") for (int k = 0; k < 2; ++k) dst[n][k] = *(const LAS bf16x8*)(lds + PG8_SB(b, h) + boff + n * 2048 + k * 1024); } } } while (0)
#define PG8_CAT(v) __builtin_shufflevector(__builtin_bit_cast(i32x4, v[0]), __builtin_bit_cast(i32x4, v[1]), 0, 1, 2, 3, 4, 5, 6, 7)
#define PG8_MMA(ai, bj, At, Bt) do { __builtin_amdgcn_s_setprio(1); _Pragma("unroll") for (int m = 0; m < 4; ++m) _Pragma("unroll") for (int n = 0; n < 2; ++n) { \
        if constexpr (FP8) asm volatile("v_mfma_f32_16x16x128_f8f6f4 %0, %1, %2, %0" : "+v"(acc[ai][bj][m][n]) : "v"(Bt##8[n]), "v"(At##8[m]));   \
        else { _Pragma("unroll") for (int k = 0; k < 2; ++k) acc[ai][bj][m][n] = __builtin_amdgcn_mfma_f32_16x16x32_bf16(Bt[n][k], At[m][k], acc[ai][bj][m][n], 0, 0, 0); } } \
        __builtin_amdgcn_s_setprio(0); } while (0)
#define PG8_WAIT_V(n) asm volatile("s_waitcnt vmcnt(" #n ")" ::: "memory")
#define PG8_WAIT_L(n) asm volatile("s_waitcnt lgkmcnt(" #n ")" ::: "memory")
#define PG8_BAR __builtin_amdgcn_s_barrier()
#define PG8_SCHED __builtin_amdgcn_sched_barrier(0)
    Unit cur, nxt; int ui = 0;
    if (!S.next(0, cur)) return;
    f32x4 acc[2][2][4][2];
#pragma unroll
    for (int a = 0; a < 2; ++a)
#pragma unroll
        for (int b = 0; b < 2; ++b)
#pragma unroll
            for (int m = 0; m < 4; ++m)
#pragma unroll
                for (int n = 0; n < 2; ++n) acc[a][b][m][n] = (f32x4){0.f, 0.f, 0.f, 0.f};
    bf16x8 At[4][2], B0[2][2], B1[2][2]; i32x8 At8[4], B08[2], B18[2];
    const char* cA = (const char*)g.A + (size_t)cur.pm * tstep; const char* cB = (const char*)g.Bt + (size_t)cur.pn * tstep;
    S.a_ready(cur);
    PG8_STAGE(PG8_SB(0, 0), cB, voffB); PG8_STAGE(PG8_SA(0, 0), cA, voffA); PG8_STAGE(PG8_SB(0, 1), cB + hstep, voffB); PG8_STAGE(PG8_SA(0, 1), cA + hstep, voffA);
    if (wr == 1) PG8_BAR;
    PG8_WAIT_V(4); PG8_BAR;
    PG8_STAGE(PG8_SB(1, 0), cB + kstep, voffB); PG8_STAGE(PG8_SA(1, 0), cA + kstep, voffA); PG8_STAGE(PG8_SB(1, 1), cB + hstep + kstep, voffB);
    PG8_WAIT_V(6); PG8_BAR;
    for (;;) {
        const bool has_next = S.next(ui + 1, nxt);
        const char* nA = has_next ? (const char*)g.A + (size_t)nxt.pm * tstep : cA; const char* nB = has_next ? (const char*)g.Bt + (size_t)nxt.pn * tstep : cB;
        for (int t = 0; t < nt; t += 2) {
            const bool last = (t == nt - 2);
            const char* a1 = cA + (size_t)(t + 1) * kstep;
            const char* a2 = last ? nA : cA + (size_t)(t + 2) * kstep; const char* b2 = last ? nB : cB + (size_t)(t + 2) * kstep;
            const char* a3 = a2 + kstep; const char* b3 = b2 + kstep;
            if (last && has_next) S.a_ready(nxt);
            if constexpr (Epi::MID_T > 0) { if (t == Epi::MID_T) { PG8_SCHED; E.mid(acc, cur, wr, wc, fr, fq); PG8_SCHED; } }
            PG8_LDB(B0, 0, 0); PG8_SCHED; PG8_LDA(At, 0, 0); PG8_STAGE(PG8_SA(1, 1), a1 + hstep, voffA);
            PG8_WAIT_L(8); PG8_BAR; PG8_WAIT_L(0); PG8_MMA(0, 0, At, B0); PG8_BAR; PG8_SCHED;
            PG8_LDB(B1, 0, 1); PG8_STAGE(PG8_SB(0, 0), b2, voffB);
            PG8_BAR; PG8_WAIT_L(0); PG8_MMA(0, 1, At, B1); PG8_BAR;
            PG8_LDA(At, 0, 1); PG8_STAGE(PG8_SA(0, 0), a2, voffA);
            PG8_BAR; PG8_WAIT_L(0); PG8_MMA(1, 0, At, B0); PG8_BAR; PG8_SCHED;
            PG8_STAGE(PG8_SB(0, 1), b2 + hstep, voffB);
            PG8_WAIT_V(6); PG8_BAR; PG8_MMA(1, 1, At, B1); PG8_BAR;
            PG8_LDB(B0, 1, 0); PG8_SCHED; PG8_LDA(At, 1, 0); PG8_STAGE(PG8_SA(0, 1), a2 + hstep, voffA);
            PG8_WAIT_L(8); PG8_BAR; PG8_WAIT_L(0); PG8_MMA(0, 0, At, B0); PG8_BAR; PG8_SCHED;
            PG8_LDB(B1, 1, 1); PG8_STAGE(PG8_SB(1, 0), b3, voffB);
            PG8_BAR; PG8_WAIT_L(0); PG8_MMA(0, 1, At, B1); PG8_BAR;
            PG8_LDA(At, 1, 1); PG8_STAGE(PG8_SA(1, 0), a3, voffA);
            PG8_BAR; PG8_WAIT_L(0); PG8_MMA(1, 0, At, B0); PG8_BAR; PG8_SCHED;
            PG8_STAGE(PG8_SB(1, 1), b3 + hstep, voffB);
            PG8_WAIT_V(6); PG8_BAR; PG8_MMA(1, 1, At, B1); PG8_BAR;
        }
        if constexpr (FP8) {
            asm volatile("s_nop 15\n\ts_nop 15\n\ts_nop 15" ::: "memory");
#pragma unroll
            for (int a = 0; a < 2; ++a)
#pragma unroll
                for (int b = 0; b < 2; ++b)
#pragma unroll
                    for (int m = 0; m < 4; ++m)
#pragma unroll
                        for (int n = 0; n < 2; ++n) asm volatile("" : "+v"(acc[a][b][m][n]));
        }
        E(acc, cur, wr, wc, fr, fq); S.done(cur);
        if (!has_next) break;
#pragma unroll
        for (int a = 0; a < 2; ++a)
#pragma unroll
            for (int b = 0; b < 2; ++b)
#pragma unroll
                for (int m = 0; m < 4; ++m)
#pragma unroll
                    for (int n = 0; n < 2; ++n) acc[a][b][m][n] = (f32x4){0.f, 0.f, 0.f, 0.f};
        cur = nxt; cA = nA; cB = nB; ++ui;
    }
    PG8_WAIT_V(0);
    if (wr == 0) PG8_BAR;
    PG8_BAR;
#undef PG8_SA
#undef PG8_SB
#undef PG8_STAGE
#undef PG8_LDA
#undef PG8_RD8
#undef PG8_LDB
#undef PG8_MMA
#undef PG8_CAT
#undef PG8_WAIT_V
#undef PG8_WAIT_L
#undef PG8_BAR
#undef PG8_SCHED
}

__device__ __forceinline__ void st_bf16x4(bf16_t* p, f32x4 v) { u32x2 w; w.x = cvt_pk_bf16(v[0], v[1]); w.y = cvt_pk_bf16(v[2], v[3]); *(u32x2*)p = w; }
__device__ __forceinline__ f32x4 ld_bf16x4(const bf16_t* p) { const u32x2 w = *(const u32x2*)p; return (f32x4){bf_lo(w.x), bf_hi(w.x), bf_lo(w.y), bf_hi(w.y)}; }

__device__ __forceinline__ size_t gf_off(int tile, int wid, int ai, int m, int bj, int lane) { return (size_t)tile * 131072 + wid * 16384 + (ai * 4 + m) * 2048 + bj * 1024 + lane * 16; }
struct EpiZ {
    static constexpr int MID_T = 0; static constexpr bool PERM = true;
    bf16_t* Z; const float* cosA; const float* sinA; const float* cosB; const float* sinB; int pn_off; float sc;
    __device__ __forceinline__ void operator()(const f32x4 (&acc)[2][2][4][2], const Unit& u, int wr, int wc, int fr, int fq) const {
        asm volatile("" : "+v"(fr), "+v"(fq));
        const int pn = u.pn + pn_off;
        const int type = pn < 12 ? 1 : pn < 18 ? 0 : pn < 22 ? 2 : 0;
        const int row0 = u.pm * BM + wr * 64 + fr, col0 = pn * BM + wc * 32 + 8 * fq;
#pragma unroll
        for (int ai = 0; ai < 2; ++ai)
#pragma unroll
            for (int m = 0; m < 4; ++m) {
                const int row = row0 + ai * HALF + m * 16, pos = row & (SEQ - 1);
                f32x4 c0 = {1.f, 1.f, 1.f, 1.f}, s0 = {0.f, 0.f, 0.f, 0.f}, c1 = c0, s1 = s0;
                if (type == 1 && wc == 0) { const float* cp = cosA + pos * 16 + 8 * (fq & 1); const float* sp = sinA + pos * 16 + 8 * (fq & 1);
                    c0 = *(const f32x4*)cp; c1 = *(const f32x4*)(cp + 4); s0 = *(const f32x4*)sp; s1 = *(const f32x4*)(sp + 4); }
                if (type == 2 && (wc & 1) == 0) { const float* cp = cosB + pos * 8; const float* sp = sinB + pos * 8;
                    c0 = *(const f32x4*)cp; c1 = *(const f32x4*)(cp + 4); s0 = *(const f32x4*)sp; s1 = *(const f32x4*)(sp + 4); }
                bf16_t* rowp = Z + (size_t)row * ZC + col0;
#pragma unroll
                for (int bj = 0; bj < 2; ++bj) {
                    f32x4 v0 = acc[ai][bj][m][0] * sc, v1 = acc[ai][bj][m][1] * sc;
                    if (type == 1 && wc == 0) {
                        f32x4 p0, p1;
#pragma unroll
                        for (int j = 0; j < 4; ++j) { p0[j] = __shfl_xor(v0[j], 32); p1[j] = __shfl_xor(v1[j], 32); }
                        if (fq < 2) { v0 = v0 * c0 - p0 * s0; v1 = v1 * c1 - p1 * s1; } else { v0 = v0 * c0 + p0 * s0; v1 = v1 * c1 + p1 * s1; }
                    }
                    if (type == 2 && (wc & 1) == 0) {
                        f32x4 p0, p1;
#pragma unroll
                        for (int j = 0; j < 4; ++j) { p0[j] = swz_xor<16>(v0[j]); p1[j] = swz_xor<16>(v1[j]); }
                        if (fq == 0) { v0 = v0 * c0 - p0 * s0; v1 = v1 * c1 - p1 * s1; } else if (fq == 1) { v0 = v0 * c0 + p0 * s0; v1 = v1 * c1 + p1 * s1; }
                    }
                    u32x4 w; w.x = cvt_pk_bf16(v0[0], v0[1]); w.y = cvt_pk_bf16(v0[2], v0[3]); w.z = cvt_pk_bf16(v1[0], v1[1]); w.w = cvt_pk_bf16(v1[2], v1[3]);
                    *(u32x4*)(rowp + bj * HALF) = w;
                }
            }
    }
};
struct EpiGate {
    static constexpr int MID_T = 0; static constexpr bool PERM = true;
    unsigned char* GF;
    __device__ __forceinline__ void operator()(const f32x4 (&acc)[2][2][4][2], const Unit& u, int wr, int wc, int fr, int fq) const {
        asm volatile("" : "+v"(fr), "+v"(fq));
        const int tile = ((u.pn >> 3) * 64 + u.pm) * 8 + (u.pn & 7), wid = wr * 4 + wc, lane = fq * 16 + fr;
        constexpr float SC = -1.f / (SX8 * SWG8);
#pragma unroll
        for (int ai = 0; ai < 2; ++ai)
#pragma unroll
            for (int m = 0; m < 4; ++m)
#pragma unroll
                for (int bj = 0; bj < 2; ++bj) {
                    f32x4 v0 = acc[ai][bj][m][0], v1 = acc[ai][bj][m][1];
#pragma unroll
                    for (int j = 0; j < 4; ++j) { v0[j] = __builtin_amdgcn_rcpf(1.f + __expf(v0[j] * SC)); v1[j] = __builtin_amdgcn_rcpf(1.f + __expf(v1[j] * SC)); }
                    u32x4 w; w.x = cvt_pk_bf16(v0[0], v0[1]); w.y = cvt_pk_bf16(v0[2], v0[3]); w.z = cvt_pk_bf16(v1[0], v1[1]); w.w = cvt_pk_bf16(v1[2], v1[3]);
                    *(u32x4*)(GF + gf_off(tile, wid, ai, m, bj, lane)) = w;
                }
    }
};
struct EpiInFp8 {
    static constexpr int MID_T = 0; static constexpr bool PERM = true;
    EpiZ z; EpiGate g;
    __device__ __forceinline__ void operator()(const f32x4 (&acc)[2][2][4][2], const Unit& u, int wr, int wc, int fr, int fq) const {
        if (u.pn < 18) z(acc, u, wr, wc, fr, fq);
        else { Unit u2; u2.pm = u.pm; u2.pn = u.pn - 18; g(acc, u2, wr, wc, fr, fq); }
    }
};
struct EpiBranch {
    static constexpr int MID_T = 8; static constexpr bool PERM = true;
    bf16_t* merged; const unsigned char* GF;
    __device__ __forceinline__ void mid(f32x4 (&acc)[2][2][4][2], const Unit& u, int wr, int wc, int fr, int fq) const {
        asm volatile("" : "+v"(fr), "+v"(fq));
        const int t0 = u.pm * 8 + u.pn, wid = wr * 4 + wc, lane = fq * 16 + fr;
#pragma unroll
        for (int ai = 0; ai < 2; ++ai) {
#pragma unroll
            for (int m = 0; m < 4; ++m)
#pragma unroll
                for (int bj = 0; bj < 2; ++bj) {
                    const u32x4 a = *(const u32x4*)(GF + gf_off(t0, wid, ai, m, bj, lane)), b = *(const u32x4*)(GF + gf_off(512 + t0, wid, ai, m, bj, lane));
                    const f32x4 g00 = {bf_lo(a.x), bf_hi(a.x), bf_lo(a.y), bf_hi(a.y)}, g01 = {bf_lo(a.z), bf_hi(a.z), bf_lo(a.w), bf_hi(a.w)};
                    const f32x4 g10 = {bf_lo(b.x), bf_hi(b.x), bf_lo(b.y), bf_hi(b.y)}, g11 = {bf_lo(b.z), bf_hi(b.z), bf_lo(b.w), bf_hi(b.w)};
#pragma unroll
                    for (int j = 0; j < 4; ++j) { acc[ai][bj][m][0][j] *= g00[j] * __builtin_amdgcn_rcpf(g10[j]); acc[ai][bj][m][1][j] *= g01[j] * __builtin_amdgcn_rcpf(g11[j]); }
                }
            asm volatile("" ::: "memory");
        }
    }
    __device__ __forceinline__ void operator()(const f32x4 (&acc)[2][2][4][2], const Unit& u, int wr, int wc, int fr, int fq) const {
        asm volatile("" : "+v"(fr), "+v"(fq));
        const int t1 = 512 + u.pm * 8 + u.pn, wid = wr * 4 + wc, lane = fq * 16 + fr;
        const int row0 = u.pm * BM + wr * 64 + fr, col0 = u.pn * BM + wc * 32 + 8 * fq;
#pragma unroll
        for (int ai = 0; ai < 2; ++ai)
#pragma unroll
            for (int m = 0; m < 4; ++m) {
                bf16_t* mp = merged + (size_t)(row0 + ai * HALF + m * 16) * DM + col0;
#pragma unroll
                for (int bj = 0; bj < 2; ++bj) {
                    const u32x4 b = *(const u32x4*)(GF + gf_off(t1, wid, ai, m, bj, lane));
                    const f32x4 g10 = {bf_lo(b.x), bf_hi(b.x), bf_lo(b.y), bf_hi(b.y)}, g11 = {bf_lo(b.z), bf_hi(b.z), bf_lo(b.w), bf_hi(b.w)};
                    const f32x4 y0 = acc[ai][bj][m][0] * g10, y1 = acc[ai][bj][m][1] * g11;
                    u32x4 w; w.x = cvt_pk_bf16(y0[0], y0[1]); w.y = cvt_pk_bf16(y0[2], y0[3]); w.z = cvt_pk_bf16(y1[0], y1[1]); w.w = cvt_pk_bf16(y1[2], y1[3]);
                    *(u32x4*)(mp + bj * HALF) = w;
                }
            }
    }
};
struct EpiOut {
    static constexpr int MID_T = 0; static constexpr bool PERM = true;
    bf16_t* MIX;
    __device__ __forceinline__ void operator()(const f32x4 (&acc)[2][2][4][2], const Unit& u, int wr, int wc, int fr, int fq) const {
        asm volatile("" : "+v"(fr), "+v"(fq));
        const int row0 = u.pm * BM + wr * 64 + fr, col0 = u.pn * BM + wc * 32 + 8 * fq;
#pragma unroll
        for (int ai = 0; ai < 2; ++ai)
#pragma unroll
            for (int m = 0; m < 4; ++m) {
                bf16_t* rowp = MIX + (size_t)(row0 + ai * HALF + m * 16) * DM + col0;
#pragma unroll
                for (int bj = 0; bj < 2; ++bj) { const f32x4 y0 = acc[ai][bj][m][0], y1 = acc[ai][bj][m][1];
                    u32x4 w; w.x = cvt_pk_bf16(y0[0], y0[1]); w.y = cvt_pk_bf16(y0[2], y0[3]); w.z = cvt_pk_bf16(y1[0], y1[1]); w.w = cvt_pk_bf16(y1[2], y1[3]);
                    *(u32x4*)(rowp + bj * HALF) = w; }
            }
    }
};
struct EpiUp {
    static constexpr int MID_T = 0; static constexpr bool PERM = true;
    unsigned char* H8;
    __device__ __forceinline__ void operator()(const f32x4 (&acc)[2][2][4][2], const Unit& u, int wr, int wc, int fr, int fq) const {
        asm volatile("" : "+v"(fr), "+v"(fq));
        const int pn0 = u.pn & 15;
        const int row0 = u.pm * BM + wr * 64 + fr, col0 = pn0 * HALF + wc * 32 + 8 * fq;
        constexpr float SC = 1.f / (SX8 * SW8);
#pragma unroll
        for (int ai = 0; ai < 2; ++ai)
#pragma unroll
            for (int m = 0; m < 4; ++m) {
                unsigned char* rowp = H8 + (size_t)(row0 + ai * HALF + m * 16) * DM + col0;
                u32x2 w8;
#pragma unroll
                for (int n = 0; n < 2; ++n) {
                    const f32x4 gt = acc[ai][0][m][n] * SC, up = acc[ai][1][m][n] * (SC * SH8); f32x4 h;
#pragma unroll
                    for (int j = 0; j < 4; ++j) h[j] = gt[j] * __builtin_amdgcn_rcpf(1.f + __expf(-gt[j])) * up[j];
                    w8[n] = cvt_pk4_fp8(h[0], h[1], h[2], h[3]);
                }
                *(u32x2*)rowp = w8;
            }
    }
};
struct EpiDown {
    static constexpr int MID_T = 0; static constexpr bool PERM = true;
    bf16_t* YS; const float* gate;
    __device__ __forceinline__ void operator()(const f32x4 (&acc)[2][2][4][2], const Unit& u, int wr, int wc, int fr, int fq) const {
        asm volatile("" : "+v"(fr), "+v"(fq));
        const int pn0 = u.pn & 7;
        const int row0 = u.pm * BM + wr * 64 + fr, col0 = pn0 * BM + wc * 32 + 8 * fq;
#pragma unroll
        for (int ai = 0; ai < 2; ++ai)
#pragma unroll
            for (int m = 0; m < 4; ++m) {
                const int row = row0 + ai * HALF + m * 16; const float gt = gate[row] * (1.f / (SH8 * SW8));
                bf16_t* rowp = YS + (size_t)row * DM + col0;
#pragma unroll
                for (int bj = 0; bj < 2; ++bj) { const f32x4 y0 = acc[ai][bj][m][0] * gt, y1 = acc[ai][bj][m][1] * gt;
                    u32x4 w; w.x = cvt_pk_bf16(y0[0], y0[1]); w.y = cvt_pk_bf16(y0[2], y0[3]); w.z = cvt_pk_bf16(y1[0], y1[1]); w.w = cvt_pk_bf16(y1[2], y1[3]);
                    *(u32x4*)(rowp + bj * HALF) = w; }
            }
    }
};
}


struct BgConv { const float* w0; const float* w1; const float* w2; unsigned char* WGUT; unsigned char* WDT; int NGW; int pad; };
struct BgState { int it, pend, par, tick; };
constexpr int BG_ITEMS = 3 * 65536;
__device__ __forceinline__ void bg_decode(const BgConv bg, int it, const float*& src, unsigned char*& dst) {
    const int mat = it >> 16, r = it & 65535, e = r >> 12, r2 = r & 4095, kb = r2 >> 6, nb = r2 & 63, k0 = 32 * kb, n0 = 32 * nb;
    src = (mat == 0 ? bg.w0 : mat == 1 ? bg.w1 : bg.w2) + ((size_t)e * DM + k0) * DM + n0;
    if (mat == 2) dst = bg.WDT + ((size_t)e * DM + n0) * DM + k0;
    else dst = bg.WGUT + ((size_t)e * 4096 + (n0 >> 7) * 256 + mat * 128 + (n0 & 127)) * DM + k0;
}
__device__ __forceinline__ void bg_finish(const BgConv bg, int& pend, int par, LAS unsigned char* scr, int lane) {
    if (pend < 0) return;
    const float* src; unsigned char* dst; bg_decode(bg, pend, src, dst);
    asm volatile("s_waitcnt vmcnt(0)" ::: "memory");
    const int c = lane & 1, n = lane >> 1;
    const LAS float* s0 = (const LAS float*)(scr + par * 4224 + (2 * c) * 1056) + n;
    const LAS float* s1 = (const LAS float*)(scr + par * 4224 + (2 * c + 1) * 1056) + n;
    u32x4 o;
    o.x = cvt_pk4_fp8(s0[0 * 32] * SW8, s0[1 * 32] * SW8, s0[2 * 32] * SW8, s0[3 * 32] * SW8); o.y = cvt_pk4_fp8(s0[4 * 32] * SW8, s0[5 * 32] * SW8, s0[6 * 32] * SW8, s0[7 * 32] * SW8);
    o.z = cvt_pk4_fp8(s1[0 * 32] * SW8, s1[1 * 32] * SW8, s1[2 * 32] * SW8, s1[3 * 32] * SW8); o.w = cvt_pk4_fp8(s1[4 * 32] * SW8, s1[5 * 32] * SW8, s1[6 * 32] * SW8, s1[7 * 32] * SW8);
    *(u32x4*)(dst + (size_t)n * DM + 16 * c) = o;
    LDS_WAIT();
    pend = -1;
}
__device__ __forceinline__ void bg_issue(const BgConv bg, int& it, int& pend, int& par, LAS unsigned char* scr, int lane) {
    if (it >= BG_ITEMS) return;
    const float* src; unsigned char* dst; bg_decode(bg, it, src, dst);
    par ^= 1;
    const float* lp = src + (size_t)(lane >> 3) * DM + (lane & 7) * 4;
#pragma unroll
    for (int i = 0; i < 4; ++i) __builtin_amdgcn_global_load_lds((const unsigned*)(lp + (size_t)(8 * i) * DM), (LAS unsigned*)(scr + par * 4224 + i * 1056), 16, 0, 0);
    pend = it; it += bg.NGW;
}

namespace att {
#define KSWZ128(row, colB) ((row) * 256 + ((colB) ^ (((row) & 7) << 4)))
#define KSWZ64(row, colB) ((row) * 128 + ((colB) ^ (((row) & 7) << 4)))
#define SBAR() __builtin_amdgcn_sched_barrier(0)
__device__ __forceinline__ int crow(int r, int hi) { return (r & 3) + 8 * (r >> 2) + 4 * hi; }
__device__ __forceinline__ int v_st(int k, int c) { const int kk = (k & ~0xC) | ((k & 4) << 1) | ((k & 8) >> 1); return ((kk >> 3) * 4 + (c >> 5)) * 512 + ((kk & 7) * 32 + (c & 31)) * 2; }
__device__ __forceinline__ int v_rd_base(int lane) { return ((lane & 3) << 3) | (((lane >> 2) & 3) << 6) | (((lane >> 4) & 1) << 5) | (((lane >> 5) & 1) << 8); }
constexpr int v_rd_off(int d0, int ks, int half) { return d0 * 512 + ks * 4096 + half * 2048; }
template <int OFF> __device__ __forceinline__ s16x4 tr_read(int vb) { s16x4 r; asm volatile("ds_read_b64_tr_b16 %0, %1 offset:%2" : "=&v"(r) : "v"(vb), "i"(OFF) : "memory"); return r; }
template <int D0> __device__ __forceinline__ void pv_one(f32x16& od, int vb, bf16x8 pa0, bf16x8 pa1, bf16x8 pa2, bf16x8 pa3) {
    const s16x4 l0 = tr_read<v_rd_off(D0, 0, 0)>(vb), h0 = tr_read<v_rd_off(D0, 0, 1)>(vb), l1 = tr_read<v_rd_off(D0, 1, 0)>(vb), h1 = tr_read<v_rd_off(D0, 1, 1)>(vb);
    const s16x4 l2 = tr_read<v_rd_off(D0, 2, 0)>(vb), h2 = tr_read<v_rd_off(D0, 2, 1)>(vb), l3 = tr_read<v_rd_off(D0, 3, 0)>(vb), h3 = tr_read<v_rd_off(D0, 3, 1)>(vb);
    asm volatile("s_waitcnt lgkmcnt(0)" ::: "memory"); SBAR();
#define PK(L, H) (bf16x8){L[0], L[1], L[2], L[3], H[0], H[1], H[2], H[3]}
    od = __builtin_amdgcn_mfma_f32_32x32x16_bf16(pa0, PK(l0, h0), od, 0, 0, 0);
    od = __builtin_amdgcn_mfma_f32_32x32x16_bf16(pa1, PK(l1, h1), od, 0, 0, 0);
    od = __builtin_amdgcn_mfma_f32_32x32x16_bf16(pa2, PK(l2, h2), od, 0, 0, 0);
    od = __builtin_amdgcn_mfma_f32_32x32x16_bf16(pa3, PK(l3, h3), od, 0, 0, 0);
#undef PK
}

template <int DQK, bool BAND>
__device__ __forceinline__ void attn_pass(const bf16_t* __restrict__ Qw, const bf16_t* __restrict__ Kb, const bf16_t* __restrict__ Vb, size_t kvs,
                                          int ntiles, int key0, int L, int qpos, int t_lo, int t_hi, LAS char* lds, f32x16 (&o)[4], float& m_reg, float& l_reg, const BgConv bg, BgState& bs) {
    constexpr float SCALE = DQK == 128 ? 0.08838834764831845f : 0.125f;
    constexpr float C = SCALE * 1.4426950408889634f;
    constexpr float THR = 8.f;
    constexpr int ND0 = DQK / 16;
    const int tid = fresh_tid(), wid = __builtin_amdgcn_readfirstlane(tid >> 6), lane = tid & 63, r32 = lane & 31, hi = lane >> 5;
    LAS char* V_lds = lds; LAS char* K_lds = lds + 32768;
    LAS float* al_l = (LAS float*)(lds + 65536) + wid * 64;
    LAS unsigned char* bgscr = (LAS unsigned char*)lds + LDS_BG + wid * 8448;
    bf16x8 qr[ND0];
#pragma unroll
    for (int d0 = 0; d0 < ND0; ++d0) qr[d0] = *(const bf16x8*)(Qw + d0 * 16);
    const int sr = tid >> 4, sc = (tid & 15) * 8, vst0 = v_st(sr, sc), vst1 = v_st(32 + sr, sc);
    const int kr64 = tid >> 3, kc64 = (tid & 7) * 8;
    const int vb0 = (int)(unsigned)(size_t)V_lds + v_rd_base(lane);
    bf16x8 vs0, vs1, ks0, ks1;
#define KPOS(j, row) ({ int _p = key0 + 64 * (j) + (row); if (BAND) { _p = _p < 0 ? 0 : (_p >= L ? L - 1 : _p); } (size_t)_p; })
#define SLOAD(j) do { const size_t _p0 = KPOS(j, sr) * kvs, _p1 = KPOS(j, 32 + sr) * kvs; \
        vs0 = *(const bf16x8*)(Vb + _p0 + sc); vs1 = *(const bf16x8*)(Vb + _p1 + sc); \
        if (DQK == 128) { ks0 = *(const bf16x8*)(Kb + _p0 + sc); ks1 = *(const bf16x8*)(Kb + _p1 + sc); } \
        else { ks0 = *(const bf16x8*)(Kb + KPOS(j, kr64) * kvs + kc64); } } while (0)
#define SWRITE(b) do { *(LAS bf16x8*)(V_lds + (b) * 16384 + vst0) = vs0; *(LAS bf16x8*)(V_lds + (b) * 16384 + vst1) = vs1; \
        if (DQK == 128) { *(LAS bf16x8*)(K_lds + (b) * 16384 + KSWZ128(sr, sc * 2)) = ks0; *(LAS bf16x8*)(K_lds + (b) * 16384 + KSWZ128(32 + sr, sc * 2)) = ks1; } \
        else { *(LAS bf16x8*)(K_lds + (b) * 16384 + KSWZ64(kr64, kc64 * 2)) = ks0; } } while (0)
    __syncthreads();
    SLOAD(0); SWRITE(0);
    for (int j = 0; j < ntiles; ++j) {
        __syncthreads();
        bg_finish(bg, bs.pend, bs.par, bgscr, lane);
        if (j + 1 < ntiles) SLOAD(j + 1);
        if (bs.tick != 2) bg_issue(bg, bs.it, bs.pend, bs.par, bgscr, lane);
        bs.tick = bs.tick == 2 ? 0 : bs.tick + 1;
        if (!BAND || (j >= t_lo && j <= t_hi)) {
            const LAS char* Kt = K_lds + (j & 1) * 16384;
            f32x16 p0 = {}, p1 = {};
#pragma unroll
            for (int d0 = 0; d0 < ND0; ++d0) { const int cb = (d0 * 16 + hi * 8) * 2;
                const bf16x8 b0 = *(const LAS bf16x8*)(Kt + (DQK == 128 ? KSWZ128(r32, cb) : KSWZ64(r32, cb)));
                const bf16x8 b1 = *(const LAS bf16x8*)(Kt + (DQK == 128 ? KSWZ128(32 + r32, cb) : KSWZ64(32 + r32, cb)));
                p0 = __builtin_amdgcn_mfma_f32_32x32x16_bf16(b0, qr[d0], p0, 0, 0, 0);
                p1 = __builtin_amdgcn_mfma_f32_32x32x16_bf16(b1, qr[d0], p1, 0, 0, 0); }
            unsigned vmask = 0xffffffffu;
            if (BAND) { vmask = 0u; const int kb = key0 + 64 * j;
#pragma unroll
                for (int r = 0; r < 16; ++r) { const int k0p = kb + crow(r, hi), k1p = k0p + 32; const int d0p = qpos - k0p, d1p = qpos - k1p;
                    const bool v0 = (d0p <= 64) && (d0p >= -64) && (k0p >= 0) && (k0p < L), v1 = (d1p <= 64) && (d1p >= -64) && (k1p >= 0) && (k1p < L);
                    vmask |= (v0 ? 1u : 0u) << r; vmask |= (v1 ? 1u : 0u) << (16 + r);
                    p0[r] = v0 ? p0[r] : -1e30f; p1[r] = v1 ? p1[r] : -1e30f; } }
            float pmax = p0[0];
#pragma unroll
            for (int r = 1; r < 16; ++r) pmax = fmaxf(pmax, p0[r]);
#pragma unroll
            for (int r = 0; r < 16; ++r) pmax = fmaxf(pmax, p1[r]);
            { auto rr = __builtin_amdgcn_permlane32_swap(__float_as_uint(pmax), __float_as_uint(pmax), false, false); pmax = fmaxf(__uint_as_float(rr[0]), __uint_as_float(rr[1])); }
            float mn, alpha;
            if (__all(pmax - m_reg <= THR / SCALE)) { mn = m_reg; alpha = 1.f; }
            else { mn = fmaxf(m_reg, pmax); alpha = __builtin_amdgcn_exp2f((m_reg - mn) * C); m_reg = mn; }
            const float mnC = -mn * C;
#pragma unroll
            for (int r = 0; r < 16; ++r) { p0[r] = __builtin_amdgcn_exp2f(fmaf(p0[r], C, mnC)); p1[r] = __builtin_amdgcn_exp2f(fmaf(p1[r], C, mnC)); }
            if (BAND) {
#pragma unroll
                for (int r = 0; r < 16; ++r) { p0[r] = ((vmask >> r) & 1u) ? p0[r] : 0.f; p1[r] = ((vmask >> (16 + r)) & 1u) ? p1[r] : 0.f; } }
            float ps = 0.f;
#pragma unroll
            for (int r = 0; r < 16; ++r) ps += p0[r];
#pragma unroll
            for (int r = 0; r < 16; ++r) ps += p1[r];
            { auto rr = __builtin_amdgcn_permlane32_swap(__float_as_uint(ps), __float_as_uint(ps), false, false); ps = __uint_as_float(rr[0]) + __uint_as_float(rr[1]); }
            l_reg = l_reg * alpha + ps;
            bf16x8 pa0, pa1, pa2, pa3;
#define PK4(P, BASE, OUT) do { unsigned a0 = cvt_pk_bf16(P[BASE + 0], P[BASE + 1]), a1 = cvt_pk_bf16(P[BASE + 2], P[BASE + 3]); \
        unsigned b0 = cvt_pk_bf16(P[BASE + 4], P[BASE + 5]), b1 = cvt_pk_bf16(P[BASE + 6], P[BASE + 7]); \
        auto r0 = __builtin_amdgcn_permlane32_swap(a0, b0, false, false); auto r1 = __builtin_amdgcn_permlane32_swap(a1, b1, false, false); \
        u32x4 w = {r0[0], r1[0], r0[1], r1[1]}; OUT = *reinterpret_cast<bf16x8*>(&w); } while (0)
            PK4(p0, 0, pa0); PK4(p0, 8, pa1); PK4(p1, 0, pa2); PK4(p1, 8, pa3);
#undef PK4
            if (__any(alpha < 1.f)) {
                if (hi == 0) al_l[r32] = alpha;
                LDS_WAIT();
#pragma unroll
                for (int r = 0; r < 16; ++r) { const float a = al_l[crow(r, hi)];
#pragma unroll
                    for (int d = 0; d < 4; ++d) o[d][r] *= a; }
            }
            const int vb = vb0 + (j & 1) * 16384;
            pv_one<0>(o[0], vb, pa0, pa1, pa2, pa3); pv_one<1>(o[1], vb, pa0, pa1, pa2, pa3); pv_one<2>(o[2], vb, pa0, pa1, pa2, pa3); pv_one<3>(o[3], vb, pa0, pa1, pa2, pa3);
        }
        if (j + 1 < ntiles) SWRITE((j + 1) & 1);
    }
#undef KPOS
#undef SLOAD
#undef SWRITE
}
}

__device__ __forceinline__ void transpose_item(const float* __restrict__ src, int N, bf16_t* __restrict__ dst, int dK, LAS float* scr, int lane) {
#pragma unroll 8
    for (int i = 0; i < 32; ++i) { const int kk = 2 * i + (lane >> 5); scr[kk * 33 + (lane & 31)] = src[(size_t)kk * N + (lane & 31)]; }
    LDS_WAIT();
    const int c = lane & 7;
#pragma unroll
    for (int j = 0; j < 4; ++j) { const int n = (lane >> 3) + 8 * j; const LAS float* s = scr + (8 * c) * 33 + n;
        u32x4 o; o.x = cvt_pk_bf16(s[0 * 33], s[1 * 33]); o.y = cvt_pk_bf16(s[2 * 33], s[3 * 33]); o.z = cvt_pk_bf16(s[4 * 33], s[5 * 33]); o.w = cvt_pk_bf16(s[6 * 33], s[7 * 33]);
        *(u32x4*)(dst + (size_t)n * dK + 8 * c) = o; }
    LDS_WAIT();
}

__device__ __forceinline__ void transpose_item_fp8(const float* __restrict__ src, int N, unsigned char* __restrict__ dst, int dK, float sc, LAS float* scr, int lane) {
#pragma unroll 8
    for (int i = 0; i < 32; ++i) { const int kk = 2 * i + (lane >> 5); scr[kk * 33 + (lane & 31)] = src[(size_t)kk * N + (lane & 31)]; }
    LDS_WAIT();
    const int c = lane & 7;
#pragma unroll
    for (int j = 0; j < 4; ++j) { const int n = (lane >> 3) + 8 * j; const LAS float* s = scr + (8 * c) * 33 + n;
        u32x2 o; o.x = cvt_pk4_fp8(s[0 * 33] * sc, s[1 * 33] * sc, s[2 * 33] * sc, s[3 * 33] * sc); o.y = cvt_pk4_fp8(s[4 * 33] * sc, s[5 * 33] * sc, s[6 * 33] * sc, s[7 * 33] * sc);
        *(u32x2*)(dst + (size_t)n * dK + 8 * c) = o; }
    LDS_WAIT();
}

__device__ __forceinline__ void phase0(const Params& p, LAS unsigned char* lds, int vcu, int G) {
    unsigned char* ws = p.ws;
    const int tid = fresh_tid(), wave = tid >> 6, lane = tid & 63;
    const int gw = vcu * 8 + wave, NGW = G * 8;
    LAS float* scr = (LAS float*)(lds + wave * 8448);
    { const float* x = p.in[0]; bf16_t* xb = (bf16_t*)(ws + WS_XB); const size_t n8 = (size_t)T_TOK * DM / 8;
      for (size_t i = (size_t)blockIdx.x * NTHREADS + tid; i < n8; i += (size_t)G * NTHREADS) {
          const f32x4 a = *(const f32x4*)(x + i * 8), b = *(const f32x4*)(x + i * 8 + 4);
          u32x4 o; o.x = cvt_pk_bf16(a[0], a[1]); o.y = cvt_pk_bf16(a[2], a[3]); o.z = cvt_pk_bf16(b[0], b[1]); o.w = cvt_pk_bf16(b[2], b[3]);
          *(u32x4*)(xb + i * 8) = o;
          u32x2 o8; o8.x = cvt_pk4_fp8(a[0] * SX8, a[1] * SX8, a[2] * SX8, a[3] * SX8); o8.y = cvt_pk4_fp8(b[0] * SX8, b[1] * SX8, b[2] * SX8, b[3] * SX8);
          *(u32x2*)(ws + WS_X8 + i * 8) = o8; } }
    { const float* w_in = p.in[1]; const float* w_br = p.in[7]; const float* w_out = p.in[8];
      bf16_t* WINT = (bf16_t*)(ws + WS_WINT); bf16_t* WBT = (bf16_t*)(ws + WS_WBT); bf16_t* WOT = (bf16_t*)(ws + WS_WOT);
      for (int it = gw; it < 10240 + 1024 + 2048; it += NGW) {
          int r = it;
          if (r < 10240) { const int kb = r / 320, nb = r % 320;
              if (nb >= 144 && nb < 192) transpose_item(w_in + (size_t)(64 * kb) * ZC + 32 * nb, ZC, WINT + (size_t)(32 * nb) * DM + 64 * kb, DM, scr, lane);
              else transpose_item_fp8(w_in + (size_t)(64 * kb) * ZC + 32 * nb, ZC, ws + WS_WING8 + (size_t)(32 * (nb < 144 ? nb : nb - 48)) * DM + 64 * kb, DM, SWG8, scr, lane);
              continue; }
          r -= 10240;
          if (r < 1024) { const int g = r >> 9, r2 = r & 511, kb = r2 >> 6, nb = r2 & 63; transpose_item(w_br + ((size_t)g * 512 + 64 * kb) * DM + 32 * nb, DM, WBT + (size_t)(32 * nb) * 1024 + g * 512 + 64 * kb, 1024, scr, lane); continue; }
          r -= 1024;
          { const int kb = r >> 6, nb = r & 63; transpose_item(w_out + (size_t)(64 * kb) * DM + 32 * nb, DM, WOT + (size_t)(32 * nb) * DM + 64 * kb, DM, scr, lane); }
      } }
    { float* cosA = (float*)(ws + WS_COSA); float* sinA = (float*)(ws + WS_SINA); float* cosB = (float*)(ws + WS_COSB); float* sinB = (float*)(ws + WS_SINB);
      const int gt = blockIdx.x * NTHREADS + tid, NGT = G * NTHREADS;
      for (int i = gt; i < SEQ * 16; i += NGT) { const int pos = i >> 4, k = i & 15; const float inv = (float)pow(500000.0, -(double)k / 16.0); const float ang = (float)pos * inv; cosA[i] = cosf(ang); sinA[i] = sinf(ang); }
      for (int i = gt; i < SEQ * 8; i += NGT) { const int pos = i >> 3, k = i & 7; const float inv = (float)pow(500000.0, -(double)k / 8.0); const float ang = (float)pos * inv; cosB[i] = cosf(ang); sinB[i] = sinf(ang); }
      const float* wr = p.in[11]; float* wrt = (float*)(ws + WS_WRT);
      for (int i = gt; i < NE * DM; i += NGT) { const int e = i >> 11, d = i & (DM - 1); wrt[i] = wr[d * NE + e]; } }
}

__device__ __forceinline__ void moe_weight_convert(LAS unsigned char* lds, const BgConv bg, BgState& bs) {
    const int tid = fresh_tid(), wave = __builtin_amdgcn_readfirstlane(tid >> 6), lane = tid & 63;
    LAS unsigned char* scr = lds + LDS_BG + wave * 8448;
    for (;;) { bg_finish(bg, bs.pend, bs.par, scr, lane); if (bs.it >= BG_ITEMS) break; bg_issue(bg, bs.it, bs.pend, bs.par, scr, lane); }
}
__device__ __forceinline__ void bg_drain(LAS unsigned char* lds, const BgConv bg, BgState& bs) {
    const int tid = fresh_tid(), wave = __builtin_amdgcn_readfirstlane(tid >> 6), lane = tid & 63;
    bg_finish(bg, bs.pend, bs.par, lds + LDS_BG + wave * 8448, lane);
}

__device__ __forceinline__ void dil_item(const Params& p, LAS unsigned char* lds, int idx, const BgConv bg, BgState& bs) {
    using namespace att;
    unsigned char* ws = p.ws;
    const bf16_t* Z = (const bf16_t*)(ws + WS_Z); bf16_t* OG = (bf16_t*)(ws + WS_OG); float* LSEG = (float*)(ws + WS_LSEG);
    const int tid = fresh_tid(), wid = __builtin_amdgcn_readfirstlane(tid >> 6), lane = tid & 63, r32 = lane & 31, hi = lane >> 5;
    const int sub = idx & 15, h = (idx >> 4) & 3, bgi = idx >> 6, g = bgi % 3, b = bgi / 3;
    const int lr = g * 2, r = 1 << lr, L = SEQ >> lr, phase = sub & (r - 1), qb = sub >> lr;
    const int head = g * 4 + h;
    const int qpos = qb * 256 + wid * 32 + r32;
    const size_t tokq = (size_t)b * SEQ + phase + (size_t)r * qpos;
    const bf16_t* Qw = Z + tokq * ZC + head * 128 + hi * 8;
    const bf16_t* Kb = Z + ((size_t)b * SEQ + phase) * ZC + 1536 + head * 128;
    const bf16_t* Vb = Z + ((size_t)b * SEQ + phase) * ZC + 3072 + head * 128;
    f32x16 o[4] = {}; float m_reg = -1e30f, l_reg = 0.f;
    attn_pass<128, true>(Qw, Kb, Vb, (size_t)r * ZC, 6, qb * 256 - 64, L, qpos, wid >> 1, (wid >> 1) + 2, (LAS char*)lds, o, m_reg, l_reg, bg, bs);
    LAS float* li_l = (LAS float*)(lds + 65536) + wid * 64 + 32;
    int r32e = r32, hie = hi; asm volatile("" : "+v"(r32e), "+v"(hie));
    if (hie == 0) { li_l[r32e] = l_reg; const size_t tq = (size_t)b * SEQ + phase + (size_t)r * (qb * 256 + wid * 32 + r32e); LSEG[((size_t)g * T_TOK + tq) * 4 + h] = m_reg * 0.08838834764831845f + __logf(l_reg); }
    LDS_WAIT();
#pragma unroll
    for (int rr = 0; rr < 16; ++rr) { const int row = crow(rr, hie); const float rl = 1.f / li_l[row];
        const size_t tok = (size_t)b * SEQ + phase + (size_t)r * (qb * 256 + wid * 32 + row);
        bf16_t* op = OG + ((size_t)g * T_TOK + tok) * 512 + h * 128 + r32e;
#pragma unroll
        for (int d0 = 0; d0 < 4; ++d0) op[d0 * 32] = f2bf(o[d0][rr] * rl);
        asm volatile("" ::: "memory"); }
    LDS_WAIT();
}

__device__ __forceinline__ void diff_item(const Params& p, LAS unsigned char* lds, int item, const BgConv bg, BgState& bs) {
    using namespace att;
    unsigned char* ws = p.ws;
    const bf16_t* Z = (const bf16_t*)(ws + WS_Z); float* O0 = (float*)(ws + WS_O0); bf16_t* BR = (bf16_t*)(ws + WS_BR);
    const int tid = fresh_tid(), wid = __builtin_amdgcn_readfirstlane(tid >> 6), lane = tid & 63, r32 = lane & 31, hi = lane >> 5;
    const int b = item >> 6, h = (item >> 4) & 3, qb = item & 15;
    const size_t tok0 = (size_t)b * SEQ + qb * 256 + wid * 32;
    LAS float* li_l = (LAS float*)(lds + 65536) + wid * 64 + 32;
    for (int c = 0; c < 2; ++c) {
        const bf16_t* Qw = Z + (tok0 + r32) * ZC + 4608 + h * 128 + c * 64 + hi * 8;
        const bf16_t* Kb = Z + ((size_t)b * SEQ) * ZC + 5120 + h * 128 + c * 64;
        const bf16_t* Vb = Z + ((size_t)b * SEQ) * ZC + 5632 + h * 128;
        f32x16 o[4] = {}; float m_reg = -1e30f, l_reg = 0.f;
        attn_pass<64, false>(Qw, Kb, Vb, (size_t)ZC, SEQ / 64, 0, SEQ, 0, 0, SEQ / 64 - 1, (LAS char*)lds, o, m_reg, l_reg, bg, bs);
        int r32e = r32, hie = hi, lanee = lane; asm volatile("" : "+v"(r32e), "+v"(hie), "+v"(lanee));
        if (hie == 0) li_l[r32e] = l_reg;
        LDS_WAIT();
        if (c == 0) {
#pragma unroll
            for (int rr = 0; rr < 16; ++rr) { const int row = crow(rr, hie); const float rl = 1.f / li_l[row];
                float* op = O0 + (tok0 + row) * 512 + h * 128 + r32e;
#pragma unroll
                for (int d0 = 0; d0 < 4; ++d0) op[d0 * 32] = o[d0][rr] * rl;
                asm volatile("" ::: "memory"); }
        } else {
            const float s1 = wave_sum(p.in[2][lanee] * p.in[3][lanee]), s2 = wave_sum(p.in[4][lanee] * p.in[5][lanee]);
            const float lam = __expf(s1) - __expf(s2) + 0.2f;
            const float* nw = p.in[6];
            float nwv[4];
#pragma unroll
            for (int d0 = 0; d0 < 4; ++d0) nwv[d0] = nw[d0 * 32 + r32e] * 0.8f;
#pragma unroll
            for (int rr = 0; rr < 16; ++rr) { const int row = crow(rr, hie); const float rl = 1.f / li_l[row];
                const float* ip = O0 + (tok0 + row) * 512 + h * 128 + r32e;
                float v[4], ss = 0.f;
#pragma unroll
                for (int d0 = 0; d0 < 4; ++d0) { v[d0] = ip[d0 * 32] - lam * (o[d0][rr] * rl); ss += v[d0] * v[d0]; }
                ss = half_sum(ss);
                const float rinv = rsqrtf(ss * (1.f / 128.f) + 1e-5f);
                bf16_t* op = BR + (tok0 + row) * 1024 + 512 + h * 128 + r32e;
#pragma unroll
                for (int d0 = 0; d0 < 4; ++d0) op[d0 * 32] = f2bf(v[d0] * rinv * nwv[d0]);
                asm volatile("" ::: "memory"); }
        }
        LDS_WAIT();
    }
}

__device__ __forceinline__ void combine_rows(const Params& p, int vcu, int G) {
    unsigned char* ws = p.ws;
    const bf16_t* OG = (const bf16_t*)(ws + WS_OG); const float* LSEG = (const float*)(ws + WS_LSEG); bf16_t* BR = (bf16_t*)(ws + WS_BR);
    const int tid = fresh_tid(), wave = tid >> 6, lane = tid & 63;
    const int h = lane >> 4;
    for (int t = vcu * 8 + wave; t < T_TOK; t += G * 8) {
        const float l0 = LSEG[((size_t)0 * T_TOK + t) * 4 + h], l1 = LSEG[((size_t)1 * T_TOK + t) * 4 + h], l2 = LSEG[((size_t)2 * T_TOK + t) * 4 + h];
        const float mx = fmaxf(l0, fmaxf(l1, l2)); float w0 = __expf(l0 - mx), w1 = __expf(l1 - mx), w2 = __expf(l2 - mx); const float inv = 1.f / (w0 + w1 + w2); w0 *= inv; w1 *= inv; w2 *= inv;
        const u32x4 a = *(const u32x4*)(OG + ((size_t)0 * T_TOK + t) * 512 + lane * 8), bq = *(const u32x4*)(OG + ((size_t)1 * T_TOK + t) * 512 + lane * 8), cq = *(const u32x4*)(OG + ((size_t)2 * T_TOK + t) * 512 + lane * 8);
        u32x4 o;
#pragma unroll
        for (int k = 0; k < 4; ++k) { const float lo = w0 * bf_lo(a[k]) + w1 * bf_lo(bq[k]) + w2 * bf_lo(cq[k]), hi2 = w0 * bf_hi(a[k]) + w1 * bf_hi(bq[k]) + w2 * bf_hi(cq[k]); o[k] = cvt_pk_bf16(lo, hi2); }
        *(u32x4*)(BR + (size_t)t * 1024 + lane * 8) = o;
    }
}

__device__ __forceinline__ void ln1_router(const Params& p, LAS unsigned char* lds, int vcu, int G) {
    unsigned char* ws = p.ws;
    const float* V1 = p.in[0]; const bf16_t* MIX = (const bf16_t*)(ws + WS_MIX); unsigned char* X1B = ws + WS_X1B;     const float* wrt = (const float*)(ws + WS_WRT); float* AFFT = (float*)(ws + WS_AFFT);
    const float* g1 = p.in[9]; const float* b1 = p.in[10];
    const int tid = fresh_tid(), wave = tid >> 6, lane = tid & 63;
    __syncthreads();
    for (int i = tid; i < NE * DM / 4; i += NTHREADS) ((LAS f32x4*)lds)[i] = ((const f32x4*)wrt)[i];
    __syncthreads();
    for (int rp = vcu * 8 + wave; rp < T_TOK / 4; rp += G * 8) {
        const int t0 = rp * 4;
        f32x4 v[4][8];
#pragma unroll
        for (int q = 0; q < 4; ++q) {
            const float* xr = V1 + (size_t)(t0 + q) * DM + lane * 4; const bf16_t* mr = MIX + (size_t)(t0 + q) * DM + lane * 4; float s = 0.f;
#pragma unroll
            for (int j = 0; j < 8; ++j) { v[q][j] = *(const f32x4*)(xr + 256 * j) * ALPHA + pg8::ld_bf16x4(mr + 256 * j); s += (v[q][j][0] + v[q][j][1]) + (v[q][j][2] + v[q][j][3]); }
            const float mean = wave_sum(s) * (1.f / DM); float s2 = 0.f;
#pragma unroll
            for (int j = 0; j < 8; ++j) { v[q][j] = v[q][j] - mean; s2 += (v[q][j][0] * v[q][j][0] + v[q][j][1] * v[q][j][1]) + (v[q][j][2] * v[q][j][2] + v[q][j][3] * v[q][j][3]); }
            const float rstd = rsqrtf(wave_sum(s2) * (1.f / DM) + LN_EPS);
            unsigned char* xbo = X1B + (size_t)(t0 + q) * DM + lane * 4;
#pragma unroll
            for (int j = 0; j < 8; ++j) { const f32x4 gg = *(const f32x4*)(g1 + lane * 4 + 256 * j), bb = *(const f32x4*)(b1 + lane * 4 + 256 * j);
                v[q][j] = v[q][j] * rstd * gg + bb; *(unsigned*)(xbo + 256 * j) = cvt_pk4_fp8(v[q][j][0] * SX8, v[q][j][1] * SX8, v[q][j][2] * SX8, v[q][j][3] * SX8); }
            asm volatile("" ::: "memory");
        }
        float lg[4] = {0.f, 0.f, 0.f, 0.f};
        const LAS float* wl = (const LAS float*)lds + lane * 4;
#pragma unroll 1
        for (int e = 0; e < NE; ++e) {
            f32x4 W[8];
#pragma unroll
            for (int j = 0; j < 8; ++j) W[j] = *(const LAS f32x4*)(wl + e * DM + 256 * j);
#pragma unroll
            for (int q = 0; q < 4; ++q) { float a = 0.f;
#pragma unroll
                for (int j = 0; j < 8; ++j) a += (v[q][j][0] * W[j][0] + v[q][j][1] * W[j][1]) + (v[q][j][2] * W[j][2] + v[q][j][3] * W[j][3]);
                a = wave_sum(a); lg[q] = (lane == e) ? a : lg[q]; }
        }
#pragma unroll
        for (int q = 0; q < 4; ++q) {
            float mx = lg[q];
            mx = fmaxf(mx, swz_xor<1>(mx)); mx = fmaxf(mx, swz_xor<2>(mx)); mx = fmaxf(mx, swz_xor<4>(mx)); mx = fmaxf(mx, swz_xor<8>(mx));
            const float ex = expf(lg[q] - mx); float sum = ex;
            sum += swz_xor<1>(sum); sum += swz_xor<2>(sum); sum += swz_xor<4>(sum); sum += swz_xor<8>(sum);
            const int t = t0 + q, bb = t >> 12, s = t & (SEQ - 1);
            if (lane < NE) AFFT[((size_t)bb * NE + lane) * SEQ + s] = ex / sum;
        }
    }
}

__device__ __forceinline__ void topk_gather(const Params& p, LAS unsigned char* lds, int G) {
    unsigned char* ws = p.ws;
    const float* AFFT = (const float*)(ws + WS_AFFT); int* SLOT = (int*)(ws + WS_SLOT); float* GATE = (float*)(ws + WS_GATE);
    const unsigned char* X1B = ws + WS_X1B; unsigned char* XG = ws + WS_XG;
    const int tid = fresh_tid(), wave = tid >> 6, lane = tid & 63;
    LAS unsigned* hist = (LAS unsigned*)lds;
    LAS unsigned* ctl = hist + 256;
    LAS unsigned* wtot = hist + 272;
    LAS int* rows = (LAS int*)(hist + 288);
    for (int item = blockIdx.x; item < NB * NE * 4; item += G) {
        const int qd = item & 3, be = item >> 2, b = be >> 4, e = be & 15;
        const float* ap = AFFT + (size_t)be * SEQ + tid * 8;
        const f32x4 fa = *(const f32x4*)ap, fb = *(const f32x4*)(ap + 4);
        float av[8] = {fa[0], fa[1], fa[2], fa[3], fb[0], fb[1], fb[2], fb[3]};
        unsigned key[8];
#pragma unroll
        for (int i = 0; i < 8; ++i) key[i] = __float_as_uint(av[i]);
        unsigned prefix = 0u, mask = 0u, remaining = CAP;
        for (int pass = 0; pass < 4; ++pass) {
            const int shift = 24 - 8 * pass;
            __syncthreads();
            if (tid < 256) hist[tid] = 0u;
            __syncthreads();
#pragma unroll
            for (int i = 0; i < 8; ++i) if ((key[i] & mask) == prefix) atomicAdd((unsigned*)&hist[(key[i] >> shift) & 255u], 1u);
            __syncthreads();
            if (wave == 0) {
                unsigned c0 = hist[4 * lane], c1 = hist[4 * lane + 1], c2 = hist[4 * lane + 2], c3 = hist[4 * lane + 3];
                const unsigned t = c0 + c1 + c2 + c3; unsigned v = t;
#pragma unroll
                for (int of = 1; of < 64; of <<= 1) { const unsigned u = __shfl_down(v, of); if (lane + of < 64) v += u; }
                unsigned cum = v - t;
                unsigned cs[4] = {c0, c1, c2, c3};
#pragma unroll
                for (int k = 3; k >= 0; --k) { if (cum < remaining && cum + cs[k] >= remaining) { ctl[0] = 4 * lane + k; ctl[1] = remaining - cum; } cum += cs[k]; }
            }
            __syncthreads();
            prefix |= ctl[0] << shift; mask |= 0xFFu << shift; remaining = ctl[1];
        }
        const unsigned Tk = prefix, need_eq = remaining, cnt_gt_total = CAP - need_eq;
        unsigned ngt = 0, neq = 0;
#pragma unroll
        for (int i = 0; i < 8; ++i) { ngt += key[i] > Tk ? 1u : 0u; neq += key[i] == Tk ? 1u : 0u; }
        const unsigned packed = ngt | (neq << 16); unsigned incl = packed;
#pragma unroll
        for (int of = 1; of < 64; of <<= 1) { const unsigned u = __shfl_up(incl, of); if (lane >= of) incl += u; }
        __syncthreads();
        if (lane == 63) wtot[wave] = incl;
        __syncthreads();
        unsigned base = 0;
        for (int w = 0; w < wave; ++w) base += wtot[w];
        unsigned excl = base + incl - packed; unsigned rgt = excl & 0xffffu, req = excl >> 16;
        int slots[8];
#pragma unroll
        for (int i = 0; i < 8; ++i) { int sl = -1;
            if (key[i] > Tk) { sl = (int)rgt; ++rgt; } else if (key[i] == Tk) { if (req < need_eq) sl = (int)(cnt_gt_total + req); ++req; }
            slots[i] = sl;
            if (sl >= 0) { if ((sl >> 7) == qd) rows[sl & 127] = tid * 8 + i; if (qd == 0) GATE[(size_t)e * 2048 + b * CAP + sl] = av[i]; } }
        if (qd == 0) { int* sp = SLOT + (size_t)be * SEQ + tid * 8; *(int4*)sp = make_int4(slots[0], slots[1], slots[2], slots[3]); *(int4*)(sp + 4) = make_int4(slots[4], slots[5], slots[6], slots[7]); }
        __syncthreads();
        for (int r = wave; r < 128; r += 8) {
            const int s = rows[r];
            const u32x4* src = (const u32x4*)(X1B + ((size_t)b * SEQ + s) * DM); u32x4* dst = (u32x4*)(XG + ((size_t)e * 2048 + b * CAP + qd * 128 + r) * DM);
#pragma unroll
            for (int j = 0; j < 2; ++j) dst[lane + 64 * j] = src[lane + 64 * j];
        }
    }
}

__device__ __forceinline__ void ln2_rows(const Params& p, int vcu, int G) {
    unsigned char* ws = p.ws;
    const bf16_t* YS = (const bf16_t*)(ws + WS_YS); const int* SLOT = (const int*)(ws + WS_SLOT);
    const float* g2 = p.in[15]; const float* b2 = p.in[16]; float* out = p.out;
    const int tid = fresh_tid(), wave = tid >> 6, lane = tid & 63;
    for (int t = vcu * 8 + wave; t < T_TOK; t += G * 8) {
        const int b = t >> 12, s = t & (SEQ - 1);
        const int myslot = lane < NE ? SLOT[((size_t)b * NE + lane) * SEQ + s] : -1;
        f32x4 v[8];
        const float* xr = p.in[0] + (size_t)t * DM + lane * 4; const bf16_t* mr = (const bf16_t*)(ws + WS_MIX) + (size_t)t * DM + lane * 4;
        { float s0 = 0.f;
#pragma unroll
          for (int j = 0; j < 8; ++j) { v[j] = *(const f32x4*)(xr + 256 * j) * ALPHA + pg8::ld_bf16x4(mr + 256 * j); s0 += (v[j][0] + v[j][1]) + (v[j][2] + v[j][3]); }
          const float mean1 = wave_sum(s0) * (1.f / DM); float q1 = 0.f;
#pragma unroll
          for (int j = 0; j < 8; ++j) { v[j] = v[j] - mean1; q1 += (v[j][0] * v[j][0] + v[j][1] * v[j][1]) + (v[j][2] * v[j][2] + v[j][3] * v[j][3]); }
          const float rstd1 = rsqrtf(wave_sum(q1) * (1.f / DM) + LN_EPS);
#pragma unroll
          for (int j = 0; j < 8; ++j) { const f32x4 gg = *(const f32x4*)(p.in[9] + lane * 4 + 256 * j), bb = *(const f32x4*)(p.in[10] + lane * 4 + 256 * j); v[j] = (v[j] * rstd1 * gg + bb) * ALPHA; } }
        for (int e = 0; e < NE; ++e) {
            const int sl = __builtin_amdgcn_readlane(myslot, e);
            if (sl >= 0) { const bf16_t* yr = YS + ((size_t)e * 2048 + b * CAP + sl) * DM + lane * 4;
#pragma unroll
                for (int j = 0; j < 8; ++j) v[j] += pg8::ld_bf16x4(yr + 256 * j); }
        }
        float sm = 0.f;
#pragma unroll
        for (int j = 0; j < 8; ++j) sm += (v[j][0] + v[j][1]) + (v[j][2] + v[j][3]);
        const float mean = wave_sum(sm) * (1.f / DM); float s2 = 0.f;
#pragma unroll
        for (int j = 0; j < 8; ++j) { v[j] = v[j] - mean; s2 += (v[j][0] * v[j][0] + v[j][1] * v[j][1]) + (v[j][2] * v[j][2] + v[j][3] * v[j][3]); }
        const float rstd = rsqrtf(wave_sum(s2) * (1.f / DM) + LN_EPS);
        float* orow = out + (size_t)t * DM + lane * 4;
#pragma unroll
        for (int j = 0; j < 8; ++j) { const f32x4 gg = *(const f32x4*)(g2 + lane * 4 + 256 * j), bb = *(const f32x4*)(b2 + lane * 4 + 256 * j); *(f32x4*)(orow + 256 * j) = v[j] * rstd * gg + bb; }
    }
}

__global__ void __launch_bounds__(NTHREADS, 2) mega(Params p) {
    extern __shared__ __attribute__((aligned(16))) unsigned char shm[];
    LAS unsigned char* lds = (LAS unsigned char*)shm;
    cg::grid_group grid = cg::this_grid();
    const int G = gridDim.x, bx = blockIdx.x;
    const int vcu = (G % 8 == 0) ? (bx % 8) * (G / 8) + bx / 8 : bx;
    unsigned char* ws = p.ws;
    if (fresh_tid() < 16) ((LAS unsigned*)(lds + LDS_BARW))[fresh_tid()] = 0u;
    __syncthreads();
    const XcdBarrier xb = xcd_barrier_post((unsigned*)(ws + WS_BARW), (volatile LAS unsigned*)(lds + LDS_BARW));

    const BgConv bg{p.in[12], p.in[13], p.in[14], ws + WS_WGUT, ws + WS_WDT, G * 8, 0};
    BgState bs; bs.it = vcu * 8 + __builtin_amdgcn_readfirstlane(fresh_tid() >> 6); bs.pend = -1; bs.par = 0; bs.tick = 0;
    if (PHASE_MASK & 1) REPS(0) phase0(p, lds, vcu, G);
    if (p.ws == nullptr) grid.sync();
    xcd_barrier(xb);
    if (PHASE_MASK & 2) REPS(1) {
      { pg8::Gemm g{(const bf16_t*)(ws + WS_XB), (const bf16_t*)(ws + WS_WINT) + (size_t)4608 * DM, T_TOK, 1536, DM}; pg8::InBf16Order S{G, bx};
        pg8::EpiZ E{(bf16_t*)(ws + WS_Z), (const float*)(ws + WS_COSA), (const float*)(ws + WS_SINA), (const float*)(ws + WS_COSB), (const float*)(ws + WS_SINB), 18, 1.f};
        pg8::gemm_phase(lds, g, S, E); }
      { pg8::Gemm g{(const bf16_t*)(ws + WS_X8), (const bf16_t*)(ws + WS_WING8), T_TOK, 8704, DM}; pg8::InFp8Order S{G, bx};
        pg8::EpiInFp8 E{pg8::EpiZ{(bf16_t*)(ws + WS_Z), (const float*)(ws + WS_COSA), (const float*)(ws + WS_SINA), (const float*)(ws + WS_COSB), (const float*)(ws + WS_SINB), 0, 1.f / (SX8 * SWG8)}, pg8::EpiGate{ws + WS_GF}};
        pg8::gemm_phase<pg8::EpiInFp8, pg8::InFp8Order, true>(lds, g, S, E); } }
    xcd_barrier(xb);
    if (PHASE_MASK & 4) REPS(2) for (int it = vcu; it < 768; it += G) dil_item(p, lds, it, bg, bs);
    bg_drain(lds, bg, bs);
    xcd_barrier(xb);
    if (PHASE_MASK & 8) REPS(3) combine_rows(p, vcu, G);
    if (PHASE_MASK & 16) REPS(4) for (int it = vcu; it < 256; it += G) diff_item(p, lds, it, bg, bs);
    bg_drain(lds, bg, bs);
    xcd_barrier(xb);
    if (PHASE_MASK & 32) REPS(5) { pg8::Gemm g{(const bf16_t*)(ws + WS_BR), (const bf16_t*)(ws + WS_WBT), T_TOK, DM, 1024}; pg8::StaticOrder S; S.init(T_TOK, DM, G, bx);
      pg8::EpiBranch E{(bf16_t*)(ws + WS_MERGED), ws + WS_GF};
      pg8::gemm_phase(lds, g, S, E); }
    xcd_barrier(xb);
    if (PHASE_MASK & 64) REPS(6) { pg8::Gemm g{(const bf16_t*)(ws + WS_MERGED), (const bf16_t*)(ws + WS_WOT), T_TOK, DM, DM}; pg8::StaticOrder S; S.init(T_TOK, DM, G, bx);
      pg8::EpiOut E{(bf16_t*)(ws + WS_MIX)};
      pg8::gemm_phase(lds, g, S, E); }
    xcd_barrier(xb);
    if (PHASE_MASK & 128) moe_weight_convert(lds, bg, bs);
    if (PHASE_MASK & 256) REPS(8) ln1_router(p, lds, vcu, G);
    xcd_barrier(xb);
    if (PHASE_MASK & 512) REPS(9) topk_gather(p, lds, G);
    xcd_barrier(xb);
    if (PHASE_MASK & 1024) REPS(10) { pg8::Gemm g{(const bf16_t*)(ws + WS_XG), (const bf16_t*)(ws + WS_WGUT), NE * 2048, NE * 4096, DM}; pg8::UpOrder S{G, bx};
      pg8::EpiUp E{ws + WS_H};
      pg8::gemm_phase<pg8::EpiUp, pg8::UpOrder, true>(lds, g, S, E); }
    xcd_barrier(xb);
    if (PHASE_MASK & 2048) REPS(11) { pg8::Gemm g{(const bf16_t*)(ws + WS_H), (const bf16_t*)(ws + WS_WDT), NE * 2048, NE * 2048, DM}; pg8::DownOrder S{G, bx};
      pg8::EpiDown E{(bf16_t*)(ws + WS_YS), (const float*)(ws + WS_GATE)};
      pg8::gemm_phase<pg8::EpiDown, pg8::DownOrder, true>(lds, g, S, E); }
    xcd_barrier(xb);
    if (PHASE_MASK & 4096) REPS(12) ln2_rows(p, vcu, G);
}

extern "C" void kernel_launch(void* const* d_in, const int* in_sizes, int n_in, void* d_out, int out_size, void* d_ws, size_t ws_size, hipStream_t stream) {
    static int grid = 0;
    if (grid == 0) {
        if (n_in != 17 || out_size != T_TOK * DM || ws_size < WS_END) { fprintf(stderr, "kernel_launch: unexpected shapes (n_in %d out %d ws %zu, need ws >= %zu)\n", n_in, out_size, ws_size, (size_t)WS_END); grid = -1; return; }
        int dev = 0, cus = 0, per_cu = 0;
        hipGetDevice(&dev); hipDeviceGetAttribute(&cus, hipDeviceAttributeMultiprocessorCount, dev);
        if (hipFuncSetAttribute((const void*)mega, hipFuncAttributeMaxDynamicSharedMemorySize, LDS_BYTES) != hipSuccess) { fprintf(stderr, "kernel_launch: hipFuncSetAttribute failed\n"); grid = -1; return; }
        if (hipOccupancyMaxActiveBlocksPerMultiprocessor(&per_cu, (const void*)mega, NTHREADS, LDS_BYTES) != hipSuccess || per_cu < 1) { fprintf(stderr, "kernel_launch: occupancy query gave %d\n", per_cu); per_cu = 1; }
        (void)hipGetLastError();
        grid = cus * per_cu;
    }
    if (grid < 0) return;
    Params p{};
    for (int i = 0; i < 17; ++i) p.in[i] = (const float*)d_in[i];
    p.out = (float*)d_out; p.ws = (unsigned char*)d_ws;
    void* args[] = {&p};
    if (hipMemsetAsync((char*)d_ws + WS_BARW, 0, XCD_BAR_WORDS * 4, stream) != hipSuccess) { fprintf(stderr, "kernel_launch: memset of the barrier words failed\n"); return; }
    hipError_t e = hipLaunchCooperativeKernel((void*)mega, dim3(grid), dim3(NTHREADS), args, LDS_BYTES, stream);
    if (e != hipSuccess) fprintf(stderr, "cooperative launch failed: %s (grid %d)\n", hipGetErrorString(e), grid);
}
```

```cpp
#include <hip/hip_runtime.h>
#include <hip/hip_cooperative_groups.h>
#include <cstdio>
#include <cstdint>
namespace cg = cooperative_groups;

#define LAS __attribute__((address_space(3)))
typedef unsigned short bf16_t;
typedef short bf16x8 __attribute__((ext_vector_type(8)));
typedef short s16x4 __attribute__((ext_vector_type(4)));
typedef float f32x4 __attribute__((ext_vector_type(4)));
typedef float f32x16 __attribute__((ext_vector_type(16)));
typedef unsigned u32x4 __attribute__((ext_vector_type(4)));
typedef unsigned u32x2 __attribute__((ext_vector_type(2)));
typedef int i32x4 __attribute__((ext_vector_type(4)));
typedef int i32x8 __attribute__((ext_vector_type(8)));

constexpr int T_TOK = 16384, DM = 2048, SEQ = 4096, NB = 4, ZC = 10240, NE = 16, CAP = 512;
constexpr float ALPHA = 1.189207115002721f;
constexpr float LN_EPS = 1e-5f;
constexpr float SX8 = 8.f, SW8 = 64.f, SH8 = 16.f, SWG8 = 32.f;
constexpr int LDS_BG = 67584, LDS_BARW = 135168;
constexpr int LDS_BYTES = LDS_BARW + 64;
constexpr int NTHREADS = 512;
#ifndef PHASE_MASK
#define PHASE_MASK 0xFFFF
#endif
#ifndef REP_MASK
#define REP_MASK 0
#endif
#define REPS(k) for (int rep_ = 0; rep_ < 1 + ((REP_MASK >> (k)) & 1); ++rep_)

constexpr size_t MiB = (size_t)1 << 20;
constexpr size_t WS_WGUT = 0, WS_WDT = 128 * MiB;
constexpr size_t WS_XB = 384 * MiB, WS_WINT = 448 * MiB, WS_Z = 488 * MiB;
constexpr size_t WS_XG = 384 * MiB, WS_YS = 384 * MiB, WS_H = 512 * MiB;
constexpr size_t WS_WBT = 808 * MiB, WS_WOT = 812 * MiB, WS_COSA = 820 * MiB, WS_SINA = WS_COSA + 256 * 1024,
                 WS_COSB = WS_SINA + 256 * 1024, WS_SINB = WS_COSB + 128 * 1024, WS_WRT = 821 * MiB,
                 WS_AFFT = 822 * MiB, WS_SLOT = 823 * MiB, WS_GATE = 824 * MiB, WS_LSEG = 825 * MiB;
constexpr size_t WS_BR = 826 * MiB, WS_MERGED = 858 * MiB, WS_OG = 922 * MiB, WS_O0 = 970 * MiB;
constexpr size_t WS_X1B = 922 * MiB;
constexpr size_t WS_GF = 192 * MiB;
constexpr size_t WS_MIX = 576 * MiB;
constexpr size_t WS_X8 = 320 * MiB, WS_WING8 = 352 * MiB;
constexpr size_t WS_BARW = 1002 * MiB, WS_END = 1002 * MiB + 16384;

struct Params { const float* in[17]; float* out; unsigned char* ws; };

typedef __bf16 bf16x2_t __attribute__((ext_vector_type(2)));
typedef float f32x2_t __attribute__((ext_vector_type(2)));
__device__ __forceinline__ unsigned cvt_pk_bf16(float lo, float hi) { const f32x2_t v = {lo, hi}; const bf16x2_t b = __builtin_convertvector(v, bf16x2_t); return __builtin_bit_cast(unsigned, b); }
__device__ __forceinline__ unsigned cvt_pk4_fp8(float a, float b, float c, float d) { int w = __builtin_amdgcn_cvt_pk_fp8_f32(a, b, 0, false); w = __builtin_amdgcn_cvt_pk_fp8_f32(c, d, w, true); return (unsigned)w; }
__device__ __forceinline__ float bf_lo(unsigned w) { return __uint_as_float(w << 16); }
__device__ __forceinline__ float bf_hi(unsigned w) { return __uint_as_float(w & 0xffff0000u); }
__device__ __forceinline__ bf16_t f2bf(float f) { unsigned u = __float_as_uint(f); u += 0x7FFFu + ((u >> 16) & 1u); return (bf16_t)(u >> 16); }
template <int K> __device__ __forceinline__ float swz_xor(float v) { return __int_as_float(__builtin_amdgcn_ds_swizzle(__float_as_int(v), (K << 10) | 0x1f)); }
__device__ __forceinline__ float half_sum(float v) { v += swz_xor<1>(v); v += swz_xor<2>(v); v += swz_xor<4>(v); v += swz_xor<8>(v); v += swz_xor<16>(v); return v; }
__device__ __forceinline__ float wave_sum(float v) {
    v = half_sum(v);
    auto rr = __builtin_amdgcn_permlane32_swap(__float_as_uint(v), __float_as_uint(v), false, false);
    return __uint_as_float(rr[0]) + __uint_as_float(rr[1]);
}
__device__ __forceinline__ int fresh_tid() { int t = __builtin_amdgcn_workitem_id_x(); asm volatile("" : "+v"(t)); return t; }
#define LDS_WAIT() asm volatile("s_waitcnt lgkmcnt(0)" ::: "memory")


#define XB_TMO      128
#define XB_XCNT(j)  (256  + 64 * (j))
#define XB_XSUB(j)  (1280 + 64 * (j))
#define XB_XGEN(j)  (2304 + 64 * (j))
#define XB_TOP      3328
#define XB_TOPGEN   3392
#define XCD_BAR_WORDS 3456
#define XB_SPIN_CAP (1u << 18)
__device__ __forceinline__ unsigned xb_ld(unsigned* p)              { return __hip_atomic_load(p, __ATOMIC_RELAXED, __HIP_MEMORY_SCOPE_AGENT); }
__device__ __forceinline__ unsigned xb_add(unsigned* p, unsigned v) { return __hip_atomic_fetch_add(p, v, __ATOMIC_RELAXED, __HIP_MEMORY_SCOPE_AGENT); }
__device__ __forceinline__ unsigned xb_xcc_id() { return (unsigned)__builtin_amdgcn_s_getreg((3 << 11) | 20) & 0xFu; }
#define XB_SPIN(cond, bar) do { unsigned _sp = 0; while (cond) { __builtin_amdgcn_s_sleep(1); \
    if ((++_sp & 255u) == 0u) { if (xb_ld(&(bar)[XB_TMO])) break; if (_sp > XB_SPIN_CAP) { atomicAdd(&(bar)[XB_TMO], 1u); break; } } } } while (0)
struct XcdBarrier { unsigned* bar; unsigned x; volatile LAS unsigned* st; };
__device__ __forceinline__ XcdBarrier xcd_barrier_post(unsigned* bar, volatile LAS unsigned* st) {
    XcdBarrier b; b.bar = bar; b.x = xb_xcc_id(); b.st = st;
    if (fresh_tid() == 0) (void)xb_add(&bar[XB_XCNT(b.x)], 1u);
    return b;
}
__device__ __forceinline__ void xcd_barrier_complete(unsigned* bar, unsigned x, unsigned& nloc, unsigned& nx) {
    const unsigned G = gridDim.x * gridDim.y * gridDim.z;
    unsigned sum, cnt, mine, sp = 0u;
    for (;;) {
        sum = 0u; cnt = 0u; mine = 0u;
#pragma unroll
        for (unsigned j = 0; j < 16; ++j) { const unsigned c = xb_ld(&bar[XB_XCNT(j)]); sum += c; cnt += (c > 0u) ? 1u : 0u; mine = (j == x) ? c : mine; }
        if (sum == G) break;
        __builtin_amdgcn_s_sleep(1);
        if ((++sp & 255u) == 0u) { if (xb_ld(&bar[XB_TMO])) break; if (sp > XB_SPIN_CAP) { atomicAdd(&bar[XB_TMO], 1u); break; } }
    }
    nloc = mine > 0u ? mine : 1u; nx = cnt > 0u ? cnt : 1u;
}
__device__ __forceinline__ void xcd_barrier(const XcdBarrier& b) {
    asm volatile("s_waitcnt vmcnt(0)" ::: "memory");
    __syncthreads();
    if (fresh_tid() == 0) {
        unsigned* bar = b.bar;
        __builtin_amdgcn_s_waitcnt(0);
        unsigned nloc = b.st[0], nx = b.st[1];
        if (nloc == 0u) { xcd_barrier_complete(bar, b.x, nloc, nx); b.st[0] = nloc; b.st[1] = nx; }
        const unsigned old = xb_add(&bar[XB_XSUB(b.x)], 1u);
        const unsigned gen = old / nloc;
        if (old + 1u == (gen + 1u) * nloc) {
            __builtin_amdgcn_fence(__ATOMIC_RELEASE, "agent");
            asm volatile("s_waitcnt vmcnt(0)" ::: "memory");
            const unsigned og = xb_add(&bar[XB_TOP], 1u);
            const unsigned tg = og / nx;
            if (og + 1u == (tg + 1u) * nx) xb_add(&bar[XB_TOPGEN], 1u);
            else XB_SPIN(xb_ld(&bar[XB_TOPGEN]) == tg, bar);
            __builtin_amdgcn_fence(__ATOMIC_ACQUIRE, "agent");
            xb_add(&bar[XB_XGEN(b.x)], 1u);
            asm volatile("s_waitcnt vmcnt(0)" ::: "memory");
        } else {
            XB_SPIN(xb_ld(&bar[XB_XGEN(b.x)]) == gen, bar);
            __builtin_amdgcn_fence(__ATOMIC_ACQUIRE, "agent");
            asm volatile("s_waitcnt vmcnt(0)" ::: "memory");
        }
    }
    __syncthreads();
}

namespace pg8 {
constexpr int BM = 256, BK = 64, HALF = 128, HTB = HALF * BK * 2, STAGE_BYTES = 8 * HTB, NXCD = 8, WGM = 8;
__host__ __device__ __forceinline__ int lds_byte(int r, int c) { const int st = (r >> 4) * 2 + (c >> 5), rr = r & 15, cc = c & 31, ob = rr * 64 + cc * 2; return st * 1024 + (ob ^ (((ob >> 9) & 1) << 5)); }
__host__ __device__ __forceinline__ void stage_rc(int b, int& R, int& C) { const int st = b / 1024, sb = b % 1024, swz = sb ^ (((sb >> 9) & 1) << 5); R = (st >> 1) * 16 + swz / 64; C = (st & 1) * 32 + (swz % 64) / 2; }
__host__ __device__ __forceinline__ int perm32(int rho) { const int n = rho >> 4, i = rho & 15; return 8 * (i >> 2) + 4 * n + (i & 3); }
struct Unit { int pm, pn; };
struct Gemm { const bf16_t* A; const bf16_t* Bt; int M, N, K; };

__device__ __forceinline__ void static_map(int L, int nM, int nN, int& pm, int& pn) {
    const int nwg = nM * nN; int wgid = L;
    { const int q = nwg / NXCD, r = nwg % NXCD, xcd = wgid % NXCD, off = wgid / NXCD; wgid = (xcd < r ? xcd * (q + 1) : r * (q + 1) + (xcd - r) * q) + off; }
    const int nig = WGM * nN, gid = wgid / nig, fm = gid * WGM, gsz = (nM - fm) < WGM ? (nM - fm) : WGM;
    pm = fm + ((wgid % nig) % gsz); pn = (wgid % nig) / gsz;
}
struct StaticOrder {
    int nM, nN, nwg, G, c;
    __device__ void init(int M, int N, int G_, int c_) { nM = M / BM; nN = N / BM; nwg = nM * nN; G = G_; c = c_; }
    __device__ bool next(int i, Unit& u) const { const long L = (long)i * G + c; if (L >= nwg) return false; static_map((int)L, nM, nN, u.pm, u.pn); return true; }
    __device__ __forceinline__ void a_ready(const Unit&) const {}
    __device__ __forceinline__ void done(const Unit&) const {}
};
struct BranchOrder {
    int G, c;
    __device__ bool next(int i, Unit& u) const { const long L = (long)(i >> 1) * G + c; if (L >= 512) return false; int pm, pn; static_map((int)L, 64, 8, pm, pn); const int g = i & 1; u.pm = g * 64 + pm; u.pn = g * 8 + pn; return true; }
    __device__ __forceinline__ void a_ready(const Unit&) const {}
    __device__ __forceinline__ void done(const Unit&) const {}
};
struct InFp8Order {
    int G, c;
    __device__ bool next(int i, Unit& u) const { long L; if (G != 256) L = (long)i * G + c; else if (i < 8) L = (long)i * G + c; else if (i == 8 && c >= G / 2) L = 8L * G + (c - G / 2); else return false; if (L >= 2176) return false; static_map((int)L, 64, 34, u.pm, u.pn); return true; }
    __device__ __forceinline__ void a_ready(const Unit&) const {}
    __device__ __forceinline__ void done(const Unit&) const {}
};
struct InBf16Order {
    int G, c;
    __device__ bool next(int i, Unit& u) const { long L; if (G != 256) L = (long)i * G + c; else if (i == 0) L = c; else if (i == 1 && c < G / 2) L = (long)G + c; else return false; if (L >= 384) return false; static_map((int)L, 64, 6, u.pm, u.pn); return true; }
    __device__ __forceinline__ void a_ready(const Unit&) const {}
    __device__ __forceinline__ void done(const Unit&) const {}
};
struct UpOrder {
    int G, c;
    __device__ bool next(int i, Unit& u) const { const long L = (long)i * G + c; if (L >= 2048) return false; const int rd = (int)L >> 8, cc = (int)L & 255, x = cc & 7, k = cc >> 3;
        const int e = 2 * rd + (x >> 2), pn0 = (x & 3) * 4 + (k >> 3), pm0 = k & 7; u.pm = e * 8 + pm0; u.pn = e * 16 + pn0; return true; }
    __device__ __forceinline__ void a_ready(const Unit&) const {}
    __device__ __forceinline__ void done(const Unit&) const {}
};
struct DownOrder {
    int G, c;
    __device__ bool next(int i, Unit& u) const { const long L = (long)i * G + c; if (L >= 1024) return false; const int rd = (int)L >> 8, cc = (int)L & 255, x = cc & 7, k = cc >> 3;
        const int e = 4 * rd + (x >> 1), pn0 = (x & 1) * 4 + (k >> 3), pm0 = k & 7; u.pm = e * 8 + pm0; u.pn = e * 8 + pn0; return true; }
    __device__ __forceinline__ void a_ready(const Unit&) const {}
    __device__ __forceinline__ void done(const Unit&) const {}
};

template <class Epi, class Sched, bool FP8 = false>
__device__ __forceinline__ void gemm_phase(LAS unsigned char* lds, const Gemm g, const Sched& S, const Epi& E) {
    const int tid = fresh_tid(), wid = __builtin_amdgcn_readfirstlane(tid >> 6), lane = tid & 63, wr = wid >> 2, wc = wid & 3, fr = lane & 15, fq = lane >> 4;
    const int K = g.K, nt = FP8 ? K / 128 : K / BK, pitch = FP8 ? K : 2 * K;
    unsigned voffA[2], voffB[2];
#pragma unroll
    for (int i = 0; i < 2; ++i) { int R, C; stage_rc(tid * 16 + i * 8192, R, C); const int Rb = Epi::PERM ? ((R & ~31) + perm32(R & 31)) : R; voffA[i] = (unsigned)(R * pitch + C * 2); voffB[i] = (unsigned)(Rb * pitch + C * 2); }
    const size_t kstep = (size_t)(BK * 2);
    const size_t hstep = (size_t)HALF * pitch;
    const size_t tstep = 2 * hstep;
    const unsigned ldsw = (unsigned)wid * 1024u;
    const int aoff = lds_byte(wr * 64 + fr, fq * 8), boff = lds_byte(wc * 32 + fr, fq * 8);
#define PG8_SA(b, h) (((b) * 2 + (h)) * HTB)
#define PG8_SB(b, h) ((4 + (b) * 2 + (h)) * HTB)
#define PG8_STAGE(bufoff, gbase, voff) do { _Pragma("unroll") for (int _i = 0; _i < 2; ++_i) \
        __builtin_amdgcn_global_load_lds((const unsigned*)((const char*)(gbase) + (voff)[_i]), (LAS unsigned*)(lds + (bufoff) + ldsw + _i * 8192), 16, 0, 0); } while (0)
#define PG8_RD8(addr) __builtin_shufflevector(*(const LAS i32x4*)(addr), *(const LAS i32x4*)((addr) + 1024), 0, 1, 2, 3, 4, 5, 6, 7)
#define PG8_LDA(dst, b, h) do { _Pragma("unroll") for (int m = 0; m < 4; ++m) { if constexpr (FP8) dst##8[m] = PG8_RD8(lds + PG8_SA(b, h) + aoff + m * 2048); \
        else { _Pragma("unroll") for (int k = 0; k < 2; ++k) dst[m][k] = *(const LAS bf16x8*)(lds + PG8_SA(b, h) + aoff + m * 2048 + k * 1024); } } } while (0)
#define PG8_LDB(dst, b, h) do { _Pragma("unroll") for (int n = 0; n < 2; ++n) { if constexpr (FP8) dst##8[n] = PG8_RD8(lds + PG8_SB(b, h) + boff + n * 2048); \
        else { _Pragma("unroll") for (int k = 0; k < 2; ++k) dst[n][k] = *(const LAS bf16x8*)(lds + PG8_SB(b, h) + boff + n * 2048 + k * 1024); } } } while (0)
#define PG8_CAT(v) __builtin_shufflevector(__builtin_bit_cast(i32x4, v[0]), __builtin_bit_cast(i32x4, v[1]), 0, 1, 2, 3, 4, 5, 6, 7)
#define PG8_MMA(ai, bj, At, Bt) do { __builtin_amdgcn_s_setprio(1); _Pragma("unroll") for (int m = 0; m < 4; ++m) _Pragma("unroll") for (int n = 0; n < 2; ++n) { \
        if constexpr (FP8) asm volatile("v_mfma_f32_16x16x128_f8f6f4 %0, %1, %2, %0" : "+v"(acc[ai][bj][m][n]) : "v"(Bt##8[n]), "v"(At##8[m]));   \
        else { _Pragma("unroll") for (int k = 0; k < 2; ++k) acc[ai][bj][m][n] = __builtin_amdgcn_mfma_f32_16x16x32_bf16(Bt[n][k], At[m][k], acc[ai][bj][m][n], 0, 0, 0); } } \
        __builtin_amdgcn_s_setprio(0); } while (0)
#define PG8_WAIT_V(n) asm volatile("s_waitcnt vmcnt(" #n ")" ::: "memory")
#define PG8_WAIT_L(n) asm volatile("s_waitcnt lgkmcnt(" #n ")" ::: "memory")
#define PG8_BAR __builtin_amdgcn_s_barrier()
#define PG8_SCHED __builtin_amdgcn_sched_barrier(0)
    Unit cur, nxt; int ui = 0;
    if (!S.next(0, cur)) return;
    f32x4 acc[2][2][4][2];
#pragma unroll
    for (int a = 0; a < 2; ++a)
#pragma unroll
        for (int b = 0; b < 2; ++b)
#pragma unroll
            for (int m = 0; m < 4; ++m)
#pragma unroll
                for (int n = 0; n < 2; ++n) acc[a][b][m][n] = (f32x4){0.f, 0.f, 0.f, 0.f};
    bf16x8 At[4][2], B0[2][2], B1[2][2]; i32x8 At8[4], B08[2], B18[2];
    const char* cA = (const char*)g.A + (size_t)cur.pm * tstep; const char* cB = (const char*)g.Bt + (size_t)cur.pn * tstep;
    S.a_ready(cur);
    PG8_STAGE(PG8_SB(0, 0), cB, voffB); PG8_STAGE(PG8_SA(0, 0), cA, voffA); PG8_STAGE(PG8_SB(0, 1), cB + hstep, voffB); PG8_STAGE(PG8_SA(0, 1), cA + hstep, voffA);
    if (wr == 1) PG8_BAR;
    PG8_WAIT_V(4); PG8_BAR;
    PG8_STAGE(PG8_SB(1, 0), cB + kstep, voffB); PG8_STAGE(PG8_SA(1, 0), cA + kstep, voffA); PG8_STAGE(PG8_SB(1, 1), cB + hstep + kstep, voffB);
    PG8_WAIT_V(6); PG8_BAR;
    for (;;) {
        const bool has_next = S.next(ui + 1, nxt);
        const char* nA = has_next ? (const char*)g.A + (size_t)nxt.pm * tstep : cA; const char* nB = has_next ? (const char*)g.Bt + (size_t)nxt.pn * tstep : cB;
        for (int t = 0; t < nt; t += 2) {
            const bool last = (t == nt - 2);
            const char* a1 = cA + (size_t)(t + 1) * kstep;
            const char* a2 = last ? nA : cA + (size_t)(t + 2) * kstep; const char* b2 = last ? nB : cB + (size_t)(t + 2) * kstep;
            const char* a3 = a2 + kstep; const char* b3 = b2 + kstep;
            if (last && has_next) S.a_ready(nxt);
            if constexpr (Epi::MID_T > 0) { if (t == Epi::MID_T) { PG8_SCHED; E.mid(acc, cur, wr, wc, fr, fq); PG8_SCHED; } }
            PG8_LDB(B0, 0, 0); PG8_SCHED; PG8_LDA(At, 0, 0); PG8_STAGE(PG8_SA(1, 1), a1 + hstep, voffA);
            PG8_WAIT_L(8); PG8_BAR; PG8_WAIT_L(0); PG8_MMA(0, 0, At, B0); PG8_BAR; PG8_SCHED;
            PG8_LDB(B1, 0, 1); PG8_STAGE(PG8_SB(0, 0), b2, voffB);
            PG8_BAR; PG8_WAIT_L(0); PG8_MMA(0, 1, At, B1); PG8_BAR;
            PG8_LDA(At, 0, 1); PG8_STAGE(PG8_SA(0, 0), a2, voffA);
            PG8_BAR; PG8_WAIT_L(0); PG8_MMA(1, 0, At, B0); PG8_BAR; PG8_SCHED;
            PG8_STAGE(PG8_SB(0, 1), b2 + hstep, voffB);
            PG8_WAIT_V(6); PG8_BAR; PG8_MMA(1, 1, At, B1); PG8_BAR;
            PG8_LDB(B0, 1, 0); PG8_SCHED; PG8_LDA(At, 1, 0); PG8_STAGE(PG8_SA(0, 1), a2 + hstep, voffA);
            PG8_WAIT_L(8); PG8_BAR; PG8_WAIT_L(0); PG8_MMA(0, 0, At, B0); PG8_BAR; PG8_SCHED;
            PG8_LDB(B1, 1, 1); PG8_STAGE(PG8_SB(1, 0), b3, voffB);
            PG8_BAR; PG8_WAIT_L(0); PG8_MMA(0, 1, At, B1); PG8_BAR;
            PG8_LDA(At, 1, 1); PG8_STAGE(PG8_SA(1, 0), a3, voffA);
            PG8_BAR; PG8_WAIT_L(0); PG8_MMA(1, 0, At, B0); PG8_BAR; PG8_SCHED;
            PG8_STAGE(PG8_SB(1, 1), b3 + hstep, voffB);
            PG8_WAIT_V(6); PG8_BAR; PG8_MMA(1, 1, At, B1); PG8_BAR;
        }
        if constexpr (FP8) {
            asm volatile("s_nop 15\n\ts_nop 15\n\ts_nop 15" ::: "memory");
#pragma unroll
            for (int a = 0; a < 2; ++a)
#pragma unroll
                for (int b = 0; b < 2; ++b)
#pragma unroll
                    for (int m = 0; m < 4; ++m)
#pragma unroll
                        for (int n = 0; n < 2; ++n) asm volatile("" : "+v"(acc[a][b][m][n]));
        }
        E(acc, cur, wr, wc, fr, fq); S.done(cur);
        if (!has_next) break;
#pragma unroll
        for (int a = 0; a < 2; ++a)
#pragma unroll
            for (int b = 0; b < 2; ++b)
#pragma unroll
                for (int m = 0; m < 4; ++m)
#pragma unroll
                    for (int n = 0; n < 2; ++n) acc[a][b][m][n] = (f32x4){0.f, 0.f, 0.f, 0.f};
        cur = nxt; cA = nA; cB = nB; ++ui;
    }
    PG8_WAIT_V(0);
    if (wr == 0) PG8_BAR;
    PG8_BAR;
#undef PG8_SA
#undef PG8_SB
#undef PG8_STAGE
#undef PG8_LDA
#undef PG8_RD8
#undef PG8_LDB
#undef PG8_MMA
#undef PG8_CAT
#undef PG8_WAIT_V
#undef PG8_WAIT_L
#undef PG8_BAR
#undef PG8_SCHED
}

__device__ __forceinline__ void st_bf16x4(bf16_t* p, f32x4 v) { u32x2 w; w.x = cvt_pk_bf16(v[0], v[1]); w.y = cvt_pk_bf16(v[2], v[3]); *(u32x2*)p = w; }
__device__ __forceinline__ f32x4 ld_bf16x4(const bf16_t* p) { const u32x2 w = *(const u32x2*)p; return (f32x4){bf_lo(w.x), bf_hi(w.x), bf_lo(w.y), bf_hi(w.y)}; }

__device__ __forceinline__ size_t gf_off(int tile, int wid, int ai, int m, int bj, int lane) { return (size_t)tile * 131072 + wid * 16384 + (ai * 4 + m) * 2048 + bj * 1024 + lane * 16; }
struct EpiZ {
    static constexpr int MID_T = 0; static constexpr bool PERM = true;
    bf16_t* Z; const float* cosA; const float* sinA; const float* cosB; const float* sinB; int pn_off; float sc;
    __device__ __forceinline__ void operator()(const f32x4 (&acc)[2][2][4][2], const Unit& u, int wr, int wc, int fr, int fq) const {
        asm volatile("" : "+v"(fr), "+v"(fq));
        const int pn = u.pn + pn_off;
        const int type = pn < 12 ? 1 : pn < 18 ? 0 : pn < 22 ? 2 : 0;
        const int row0 = u.pm * BM + wr * 64 + fr, col0 = pn * BM + wc * 32 + 8 * fq;
#pragma unroll
        for (int ai = 0; ai < 2; ++ai)
#pragma unroll
            for (int m = 0; m < 4; ++m) {
                const int row = row0 + ai * HALF + m * 16, pos = row & (SEQ - 1);
                f32x4 c0 = {1.f, 1.f, 1.f, 1.f}, s0 = {0.f, 0.f, 0.f, 0.f}, c1 = c0, s1 = s0;
                if (type == 1 && wc == 0) { const float* cp = cosA + pos * 16 + 8 * (fq & 1); const float* sp = sinA + pos * 16 + 8 * (fq & 1);
                    c0 = *(const f32x4*)cp; c1 = *(const f32x4*)(cp + 4); s0 = *(const f32x4*)sp; s1 = *(const f32x4*)(sp + 4); }
                if (type == 2 && (wc & 1) == 0) { const float* cp = cosB + pos * 8; const float* sp = sinB + pos * 8;
                    c0 = *(const f32x4*)cp; c1 = *(const f32x4*)(cp + 4); s0 = *(const f32x4*)sp; s1 = *(const f32x4*)(sp + 4); }
                bf16_t* rowp = Z + (size_t)row * ZC + col0;
#pragma unroll
                for (int bj = 0; bj < 2; ++bj) {
                    f32x4 v0 = acc[ai][bj][m][0] * sc, v1 = acc[ai][bj][m][1] * sc;
                    if (type == 1 && wc == 0) {
                        f32x4 p0, p1;
#pragma unroll
                        for (int j = 0; j < 4; ++j) { p0[j] = __shfl_xor(v0[j], 32); p1[j] = __shfl_xor(v1[j], 32); }
                        if (fq < 2) { v0 = v0 * c0 - p0 * s0; v1 = v1 * c1 - p1 * s1; } else { v0 = v0 * c0 + p0 * s0; v1 = v1 * c1 + p1 * s1; }
                    }
                    if (type == 2 && (wc & 1) == 0) {
                        f32x4 p0, p1;
#pragma unroll
                        for (int j = 0; j < 4; ++j) { p0[j] = swz_xor<16>(v0[j]); p1[j] = swz_xor<16>(v1[j]); }
                        if (fq == 0) { v0 = v0 * c0 - p0 * s0; v1 = v1 * c1 - p1 * s1; } else if (fq == 1) { v0 = v0 * c0 + p0 * s0; v1 = v1 * c1 + p1 * s1; }
                    }
                    u32x4 w; w.x = cvt_pk_bf16(v0[0], v0[1]); w.y = cvt_pk_bf16(v0[2], v0[3]); w.z = cvt_pk_bf16(v1[0], v1[1]); w.w = cvt_pk_bf16(v1[2], v1[3]);
                    *(u32x4*)(rowp + bj * HALF) = w;
                }
            }
    }
};
struct EpiGate {
    static constexpr int MID_T = 0; static constexpr bool PERM = true;
    unsigned char* GF;
    __device__ __forceinline__ void operator()(const f32x4 (&acc)[2][2][4][2], const Unit& u, int wr, int wc, int fr, int fq) const {
        asm volatile("" : "+v"(fr), "+v"(fq));
        const int tile = ((u.pn >> 3) * 64 + u.pm) * 8 + (u.pn & 7), wid = wr * 4 + wc, lane = fq * 16 + fr;
        constexpr float SC = -1.f / (SX8 * SWG8);
#pragma unroll
        for (int ai = 0; ai < 2; ++ai)
#pragma unroll
            for (int m = 0; m < 4; ++m)
#pragma unroll
                for (int bj = 0; bj < 2; ++bj) {
                    f32x4 v0 = acc[ai][bj][m][0], v1 = acc[ai][bj][m][1];
#pragma unroll
                    for (int j = 0; j < 4; ++j) { v0[j] = __builtin_amdgcn_rcpf(1.f + __expf(v0[j] * SC)); v1[j] = __builtin_amdgcn_rcpf(1.f + __expf(v1[j] * SC)); }
                    u32x4 w; w.x = cvt_pk_bf16(v0[0], v0[1]); w.y = cvt_pk_bf16(v0[2], v0[3]); w.z = cvt_pk_bf16(v1[0], v1[1]); w.w = cvt_pk_bf16(v1[2], v1[3]);
                    *(u32x4*)(GF + gf_off(tile, wid, ai, m, bj, lane)) = w;
                }
    }
};
struct EpiInFp8 {
    static constexpr int MID_T = 0; static constexpr bool PERM = true;
    EpiZ z; EpiGate g;
    __device__ __forceinline__ void operator()(const f32x4 (&acc)[2][2][4][2], const Unit& u, int wr, int wc, int fr, int fq) const {
        if (u.pn < 18) z(acc, u, wr, wc, fr, fq);
        else { Unit u2; u2.pm = u.pm; u2.pn = u.pn - 18; g(acc, u2, wr, wc, fr, fq); }
    }
};
struct EpiBranch {
    static constexpr int MID_T = 8; static constexpr bool PERM = true;
    bf16_t* merged; const unsigned char* GF;
    __device__ __forceinline__ void mid(f32x4 (&acc)[2][2][4][2], const Unit& u, int wr, int wc, int fr, int fq) const {
        asm volatile("" : "+v"(fr), "+v"(fq));
        const int t0 = u.pm * 8 + u.pn, wid = wr * 4 + wc, lane = fq * 16 + fr;
#pragma unroll
        for (int ai = 0; ai < 2; ++ai) {
#pragma unroll
            for (int m = 0; m < 4; ++m)
#pragma unroll
                for (int bj = 0; bj < 2; ++bj) {
                    const u32x4 a = *(const u32x4*)(GF + gf_off(t0, wid, ai, m, bj, lane)), b = *(const u32x4*)(GF + gf_off(512 + t0, wid, ai, m, bj, lane));
                    const f32x4 g00 = {bf_lo(a.x), bf_hi(a.x), bf_lo(a.y), bf_hi(a.y)}, g01 = {bf_lo(a.z), bf_hi(a.z), bf_lo(a.w), bf_hi(a.w)};
                    const f32x4 g10 = {bf_lo(b.x), bf_hi(b.x), bf_lo(b.y), bf_hi(b.y)}, g11 = {bf_lo(b.z), bf_hi(b.z), bf_lo(b.w), bf_hi(b.w)};
#pragma unroll
                    for (int j = 0; j < 4; ++j) { acc[ai][bj][m][0][j] *= g00[j] * __builtin_amdgcn_rcpf(g10[j]); acc[ai][bj][m][1][j] *= g01[j] * __builtin_amdgcn_rcpf(g11[j]); }
                }
            asm volatile("" ::: "memory");
        }
    }
    __device__ __forceinline__ void operator()(const f32x4 (&acc)[2][2][4][2], const Unit& u, int wr, int wc, int fr, int fq) const {
        asm volatile("" : "+v"(fr), "+v"(fq));
        const int t1 = 512 + u.pm * 8 + u.pn, wid = wr * 4 + wc, lane = fq * 16 + fr;
        const int row0 = u.pm * BM + wr * 64 + fr, col0 = u.pn * BM + wc * 32 + 8 * fq;
#pragma unroll
        for (int ai = 0; ai < 2; ++ai)
#pragma unroll
            for (int m = 0; m < 4; ++m) {
                bf16_t* mp = merged + (size_t)(row0 + ai * HALF + m * 16) * DM + col0;
#pragma unroll
                for (int bj = 0; bj < 2; ++bj) {
                    const u32x4 b = *(const u32x4*)(GF + gf_off(t1, wid, ai, m, bj, lane));
                    const f32x4 g10 = {bf_lo(b.x), bf_hi(b.x), bf_lo(b.y), bf_hi(b.y)}, g11 = {bf_lo(b.z), bf_hi(b.z), bf_lo(b.w), bf_hi(b.w)};
                    const f32x4 y0 = acc[ai][bj][m][0] * g10, y1 = acc[ai][bj][m][1] * g11;
                    u32x4 w; w.x = cvt_pk_bf16(y0[0], y0[1]); w.y = cvt_pk_bf16(y0[2], y0[3]); w.z = cvt_pk_bf16(y1[0], y1[1]); w.w = cvt_pk_bf16(y1[2], y1[3]);
                    *(u32x4*)(mp + bj * HALF) = w;
                }
            }
    }
};
struct EpiOut {
    static constexpr int MID_T = 0; static constexpr bool PERM = true;
    bf16_t* MIX;
    __device__ __forceinline__ void operator()(const f32x4 (&acc)[2][2][4][2], const Unit& u, int wr, int wc, int fr, int fq) const {
        asm volatile("" : "+v"(fr), "+v"(fq));
        const int row0 = u.pm * BM + wr * 64 + fr, col0 = u.pn * BM + wc * 32 + 8 * fq;
#pragma unroll
        for (int ai = 0; ai < 2; ++ai)
#pragma unroll
            for (int m = 0; m < 4; ++m) {
                bf16_t* rowp = MIX + (size_t)(row0 + ai * HALF + m * 16) * DM + col0;
#pragma unroll
                for (int bj = 0; bj < 2; ++bj) { const f32x4 y0 = acc[ai][bj][m][0], y1 = acc[ai][bj][m][1];
                    u32x4 w; w.x = cvt_pk_bf16(y0[0], y0[1]); w.y = cvt_pk_bf16(y0[2], y0[3]); w.z = cvt_pk_bf16(y1[0], y1[1]); w.w = cvt_pk_bf16(y1[2], y1[3]);
                    *(u32x4*)(rowp + bj * HALF) = w; }
            }
    }
};
struct EpiUp {
    static constexpr int MID_T = 0; static constexpr bool PERM = true;
    unsigned char* H8;
    __device__ __forceinline__ void operator()(const f32x4 (&acc)[2][2][4][2], const Unit& u, int wr, int wc, int fr, int fq) const {
        asm volatile("" : "+v"(fr), "+v"(fq));
        const int pn0 = u.pn & 15;
        const int row0 = u.pm * BM + wr * 64 + fr, col0 = pn0 * HALF + wc * 32 + 8 * fq;
        constexpr float SC = 1.f / (SX8 * SW8);
#pragma unroll
        for (int ai = 0; ai < 2; ++ai)
#pragma unroll
            for (int m = 0; m < 4; ++m) {
                unsigned char* rowp = H8 + (size_t)(row0 + ai * HALF + m * 16) * DM + col0;
                u32x2 w8;
#pragma unroll
                for (int n = 0; n < 2; ++n) {
                    const f32x4 gt = acc[ai][0][m][n] * SC, up = acc[ai][1][m][n] * (SC * SH8); f32x4 h;
#pragma unroll
                    for (int j = 0; j < 4; ++j) h[j] = gt[j] * __builtin_amdgcn_rcpf(1.f + __expf(-gt[j])) * up[j];
                    w8[n] = cvt_pk4_fp8(h[0], h[1], h[2], h[3]);
                }
                *(u32x2*)rowp = w8;
            }
    }
};
struct EpiDown {
    static constexpr int MID_T = 0; static constexpr bool PERM = true;
    bf16_t* YS; const float* gate;
    __device__ __forceinline__ void operator()(const f32x4 (&acc)[2][2][4][2], const Unit& u, int wr, int wc, int fr, int fq) const {
        asm volatile("" : "+v"(fr), "+v"(fq));
        const int pn0 = u.pn & 7;
        const int row0 = u.pm * BM + wr * 64 + fr, col0 = pn0 * BM + wc * 32 + 8 * fq;
#pragma unroll
        for (int ai = 0; ai < 2; ++ai)
#pragma unroll
            for (int m = 0; m < 4; ++m) {
                const int row = row0 + ai * HALF + m * 16; const float gt = gate[row] * (1.f / (SH8 * SW8));
                bf16_t* rowp = YS + (size_t)row * DM + col0;
#pragma unroll
                for (int bj = 0; bj < 2; ++bj) { const f32x4 y0 = acc[ai][bj][m][0] * gt, y1 = acc[ai][bj][m][1] * gt;
                    u32x4 w; w.x = cvt_pk_bf16(y0[0], y0[1]); w.y = cvt_pk_bf16(y0[2], y0[3]); w.z = cvt_pk_bf16(y1[0], y1[1]); w.w = cvt_pk_bf16(y1[2], y1[3]);
                    *(u32x4*)(rowp + bj * HALF) = w; }
            }
    }
};
}


struct BgConv { const float* w0; const float* w1; const float* w2; unsigned char* WGUT; unsigned char* WDT; int NGW; int pad; };
struct BgState { int it, pend, par, tick; };
constexpr int BG_ITEMS = 3 * 65536;
__device__ __forceinline__ void bg_decode(const BgConv bg, int it, const float*& src, unsigned char*& dst) {
    const int mat = it >> 16, r = it & 65535, e = r >> 12, r2 = r & 4095, kb = r2 >> 6, nb = r2 & 63, k0 = 32 * kb, n0 = 32 * nb;
    src = (mat == 0 ? bg.w0 : mat == 1 ? bg.w1 : bg.w2) + ((size_t)e * DM + k0) * DM + n0;
    if (mat == 2) dst = bg.WDT + ((size_t)e * DM + n0) * DM + k0;
    else dst = bg.WGUT + ((size_t)e * 4096 + (n0 >> 7) * 256 + mat * 128 + (n0 & 127)) * DM + k0;
}
template <bool WAIT = true> __device__ __forceinline__ void bg_finish(const BgConv bg, int& pend, int par, LAS unsigned char* scr, int lane) {
    if (pend < 0) return;
    const float* src; unsigned char* dst; bg_decode(bg, pend, src, dst);
    if (WAIT) asm volatile("s_waitcnt vmcnt(0)" ::: "memory");
    const int c = lane & 1, n = lane >> 1;
    const LAS float* s0 = (const LAS float*)(scr + par * 4224 + (2 * c) * 1056) + n;
    const LAS float* s1 = (const LAS float*)(scr + par * 4224 + (2 * c + 1) * 1056) + n;
    u32x4 o;
    o.x = cvt_pk4_fp8(s0[0 * 32] * SW8, s0[1 * 32] * SW8, s0[2 * 32] * SW8, s0[3 * 32] * SW8); o.y = cvt_pk4_fp8(s0[4 * 32] * SW8, s0[5 * 32] * SW8, s0[6 * 32] * SW8, s0[7 * 32] * SW8);
    o.z = cvt_pk4_fp8(s1[0 * 32] * SW8, s1[1 * 32] * SW8, s1[2 * 32] * SW8, s1[3 * 32] * SW8); o.w = cvt_pk4_fp8(s1[4 * 32] * SW8, s1[5 * 32] * SW8, s1[6 * 32] * SW8, s1[7 * 32] * SW8);
    *(u32x4*)(dst + (size_t)n * DM + 16 * c) = o;
    LDS_WAIT();
    pend = -1;
}
__device__ __forceinline__ void bg_issue(const BgConv bg, int& it, int& pend, int& par, LAS unsigned char* scr, int lane) {
    if (it >= BG_ITEMS) return;
    const float* src; unsigned char* dst; bg_decode(bg, it, src, dst);
    par ^= 1;
    const float* lp = src + (size_t)(lane >> 3) * DM + (lane & 7) * 4;
#pragma unroll
    for (int i = 0; i < 4; ++i) __builtin_amdgcn_global_load_lds((const unsigned*)(lp + (size_t)(8 * i) * DM), (LAS unsigned*)(scr + par * 4224 + i * 1056), 16, 0, 0);
    pend = it; it += bg.NGW;
}

namespace att {
#define KSWZ128(row, colB) ((row) * 256 + ((colB) ^ (((row) & 7) << 4)))
#define KSWZ64(row, colB) ((row) * 128 + ((colB) ^ (((row) & 7) << 4)))
#define SBAR() __builtin_amdgcn_sched_barrier(0)
__device__ __forceinline__ int crow(int r, int hi) { return (r & 3) + 8 * (r >> 2) + 4 * hi; }
__device__ __forceinline__ int v_st(int k, int c) { const int kk = (k & ~0xC) | ((k & 4) << 1) | ((k & 8) >> 1); return ((kk >> 3) * 4 + (c >> 5)) * 512 + ((kk & 7) * 32 + (c & 31)) * 2; }
__device__ __forceinline__ int v_rd_base(int lane) { return ((lane & 3) << 3) | (((lane >> 2) & 3) << 6) | (((lane >> 4) & 1) << 5) | (((lane >> 5) & 1) << 8); }
constexpr int v_rd_off(int d0, int ks, int half) { return d0 * 512 + ks * 4096 + half * 2048; }
template <int OFF> __device__ __forceinline__ s16x4 tr_read(int vb) { s16x4 r; asm volatile("ds_read_b64_tr_b16 %0, %1 offset:%2" : "=&v"(r) : "v"(vb), "i"(OFF) : "memory"); return r; }
template <int D0> __device__ __forceinline__ void pv_one(f32x16& od, int vb, bf16x8 pa0, bf16x8 pa1, bf16x8 pa2, bf16x8 pa3) {
    const s16x4 l0 = tr_read<v_rd_off(D0, 0, 0)>(vb), h0 = tr_read<v_rd_off(D0, 0, 1)>(vb), l1 = tr_read<v_rd_off(D0, 1, 0)>(vb), h1 = tr_read<v_rd_off(D0, 1, 1)>(vb);
    const s16x4 l2 = tr_read<v_rd_off(D0, 2, 0)>(vb), h2 = tr_read<v_rd_off(D0, 2, 1)>(vb), l3 = tr_read<v_rd_off(D0, 3, 0)>(vb), h3 = tr_read<v_rd_off(D0, 3, 1)>(vb);
    asm volatile("s_waitcnt lgkmcnt(0)" ::: "memory"); SBAR();
#define PK(L, H) (bf16x8){L[0], L[1], L[2], L[3], H[0], H[1], H[2], H[3]}
    od = __builtin_amdgcn_mfma_f32_32x32x16_bf16(pa0, PK(l0, h0), od, 0, 0, 0);
    od = __builtin_amdgcn_mfma_f32_32x32x16_bf16(pa1, PK(l1, h1), od, 0, 0, 0);
    od = __builtin_amdgcn_mfma_f32_32x32x16_bf16(pa2, PK(l2, h2), od, 0, 0, 0);
    od = __builtin_amdgcn_mfma_f32_32x32x16_bf16(pa3, PK(l3, h3), od, 0, 0, 0);
#undef PK
}

template <int DQK, bool BAND>
__device__ __forceinline__ void attn_pass(const bf16_t* __restrict__ Qw, const bf16_t* __restrict__ Kb, const bf16_t* __restrict__ Vb, size_t kvs,
                                          int ntiles, int key0, int L, int qpos, int t_lo, int t_hi, LAS char* lds, f32x16 (&o)[4], float& m_reg, float& l_reg, const BgConv bg, BgState& bs) {
    constexpr float SCALE = DQK == 128 ? 0.08838834764831845f : 0.125f;
    constexpr float C = SCALE * 1.4426950408889634f;
    constexpr float THR = 8.f;
    constexpr int ND0 = DQK / 16;
    const int tid = fresh_tid(), wid = __builtin_amdgcn_readfirstlane(tid >> 6), lane = tid & 63, r32 = lane & 31, hi = lane >> 5;
    LAS char* V_lds = lds; LAS char* K_lds = lds + 32768;
    LAS float* al_l = (LAS float*)(lds + 65536) + wid * 64;
    LAS unsigned char* bgscr = (LAS unsigned char*)lds + LDS_BG + wid * 8448;
    bf16x8 qr[ND0];
#pragma unroll
    for (int d0 = 0; d0 < ND0; ++d0) qr[d0] = *(const bf16x8*)(Qw + d0 * 16);
    const int sr = tid >> 4, sc = (tid & 15) * 8, vst0 = v_st(sr, sc), vst1 = v_st(32 + sr, sc);
    const int kr64 = tid >> 3, kc64 = (tid & 7) * 8;
    const int vb0 = (int)(unsigned)(size_t)V_lds + v_rd_base(lane);
    bf16x8 vs0, vs1, ks0, ks1;
#define KPOS(j, row) ({ int _p = key0 + 64 * (j) + (row); if (BAND) { _p = _p < 0 ? 0 : (_p >= L ? L - 1 : _p); } (size_t)_p; })
#define SLOAD(j) do { const size_t _p0 = KPOS(j, sr) * kvs, _p1 = KPOS(j, 32 + sr) * kvs; \
        vs0 = *(const bf16x8*)(Vb + _p0 + sc); vs1 = *(const bf16x8*)(Vb + _p1 + sc); \
        if (DQK == 128) { ks0 = *(const bf16x8*)(Kb + _p0 + sc); ks1 = *(const bf16x8*)(Kb + _p1 + sc); } \
        else { ks0 = *(const bf16x8*)(Kb + KPOS(j, kr64) * kvs + kc64); } } while (0)
#define SWRITE(b) do { *(LAS bf16x8*)(V_lds + (b) * 16384 + vst0) = vs0; *(LAS bf16x8*)(V_lds + (b) * 16384 + vst1) = vs1; \
        if (DQK == 128) { *(LAS bf16x8*)(K_lds + (b) * 16384 + KSWZ128(sr, sc * 2)) = ks0; *(LAS bf16x8*)(K_lds + (b) * 16384 + KSWZ128(32 + sr, sc * 2)) = ks1; } \
        else { *(LAS bf16x8*)(K_lds + (b) * 16384 + KSWZ64(kr64, kc64 * 2)) = ks0; } } while (0)
    __syncthreads();
    SLOAD(0); SWRITE(0);
    for (int j = 0; j < ntiles; ++j) {
        __syncthreads();
        constexpr bool SHADOW = (DQK == 64);
        if (SHADOW) { if (bs.pend >= 0) asm volatile("s_waitcnt vmcnt(0)" ::: "memory"); }
        else bg_finish<true>(bg, bs.pend, bs.par, bgscr, lane);
        if (j + 1 < ntiles) SLOAD(j + 1);
#define BG_STEP() do { bg_finish<false>(bg, bs.pend, bs.par, bgscr, lane); if (bs.tick != 2) bg_issue(bg, bs.it, bs.pend, bs.par, bgscr, lane); bs.tick = bs.tick == 2 ? 0 : bs.tick + 1; } while (0)
        if (!SHADOW || (BAND && !(j >= t_lo && j <= t_hi))) BG_STEP();
        if (!BAND || (j >= t_lo && j <= t_hi)) {
            const LAS char* Kt = K_lds + (j & 1) * 16384;
            f32x16 p0 = {}, p1 = {};
#pragma unroll
            for (int d0 = 0; d0 < ND0; ++d0) { const int cb = (d0 * 16 + hi * 8) * 2;
                const bf16x8 b0 = *(const LAS bf16x8*)(Kt + (DQK == 128 ? KSWZ128(r32, cb) : KSWZ64(r32, cb)));
                const bf16x8 b1 = *(const LAS bf16x8*)(Kt + (DQK == 128 ? KSWZ128(32 + r32, cb) : KSWZ64(32 + r32, cb)));
                p0 = __builtin_amdgcn_mfma_f32_32x32x16_bf16(b0, qr[d0], p0, 0, 0, 0);
                p1 = __builtin_amdgcn_mfma_f32_32x32x16_bf16(b1, qr[d0], p1, 0, 0, 0); }
            if (SHADOW) { SBAR(); BG_STEP(); SBAR(); }
            unsigned vmask = 0xffffffffu;
            if (BAND) { vmask = 0u; const int kb = key0 + 64 * j;
#pragma unroll
                for (int r = 0; r < 16; ++r) { const int k0p = kb + crow(r, hi), k1p = k0p + 32; const int d0p = qpos - k0p, d1p = qpos - k1p;
                    const bool v0 = (d0p <= 64) && (d0p >= -64) && (k0p >= 0) && (k0p < L), v1 = (d1p <= 64) && (d1p >= -64) && (k1p >= 0) && (k1p < L);
                    vmask |= (v0 ? 1u : 0u) << r; vmask |= (v1 ? 1u : 0u) << (16 + r);
                    p0[r] = v0 ? p0[r] : -1e30f; p1[r] = v1 ? p1[r] : -1e30f; } }
            float pmax = p0[0];
#pragma unroll
            for (int r = 1; r < 16; ++r) pmax = fmaxf(pmax, p0[r]);
#pragma unroll
            for (int r = 0; r < 16; ++r) pmax = fmaxf(pmax, p1[r]);
            { auto rr = __builtin_amdgcn_permlane32_swap(__float_as_uint(pmax), __float_as_uint(pmax), false, false); pmax = fmaxf(__uint_as_float(rr[0]), __uint_as_float(rr[1])); }
            float mn, alpha;
            if (__all(pmax - m_reg <= THR / SCALE)) { mn = m_reg; alpha = 1.f; }
            else { mn = fmaxf(m_reg, pmax); alpha = __builtin_amdgcn_exp2f((m_reg - mn) * C); m_reg = mn; }
            const float mnC = -mn * C;
#pragma unroll
            for (int r = 0; r < 16; ++r) { p0[r] = __builtin_amdgcn_exp2f(fmaf(p0[r], C, mnC)); p1[r] = __builtin_amdgcn_exp2f(fmaf(p1[r], C, mnC)); }
            if (BAND) {
#pragma unroll
                for (int r = 0; r < 16; ++r) { p0[r] = ((vmask >> r) & 1u) ? p0[r] : 0.f; p1[r] = ((vmask >> (16 + r)) & 1u) ? p1[r] : 0.f; } }
            float ps = 0.f;
#pragma unroll
            for (int r = 0; r < 16; ++r) ps += p0[r];
#pragma unroll
            for (int r = 0; r < 16; ++r) ps += p1[r];
            { auto rr = __builtin_amdgcn_permlane32_swap(__float_as_uint(ps), __float_as_uint(ps), false, false); ps = __uint_as_float(rr[0]) + __uint_as_float(rr[1]); }
            l_reg = l_reg * alpha + ps;
            bf16x8 pa0, pa1, pa2, pa3;
#define PK4(P, BASE, OUT) do { unsigned a0 = cvt_pk_bf16(P[BASE + 0], P[BASE + 1]), a1 = cvt_pk_bf16(P[BASE + 2], P[BASE + 3]); \
        unsigned b0 = cvt_pk_bf16(P[BASE + 4], P[BASE + 5]), b1 = cvt_pk_bf16(P[BASE + 6], P[BASE + 7]); \
        auto r0 = __builtin_amdgcn_permlane32_swap(a0, b0, false, false); auto r1 = __builtin_amdgcn_permlane32_swap(a1, b1, false, false); \
        u32x4 w = {r0[0], r1[0], r0[1], r1[1]}; OUT = *reinterpret_cast<bf16x8*>(&w); } while (0)
            PK4(p0, 0, pa0); PK4(p0, 8, pa1); PK4(p1, 0, pa2); PK4(p1, 8, pa3);
#undef PK4
            if (__any(alpha < 1.f)) {
                if (hi == 0) al_l[r32] = alpha;
                LDS_WAIT();
#pragma unroll
                for (int r = 0; r < 16; ++r) { const float a = al_l[crow(r, hi)];
#pragma unroll
                    for (int d = 0; d < 4; ++d) o[d][r] *= a; }
            }
            const int vb = vb0 + (j & 1) * 16384;
            pv_one<0>(o[0], vb, pa0, pa1, pa2, pa3); pv_one<1>(o[1], vb, pa0, pa1, pa2, pa3); pv_one<2>(o[2], vb, pa0, pa1, pa2, pa3); pv_one<3>(o[3], vb, pa0, pa1, pa2, pa3);
        }
        if (j + 1 < ntiles) SWRITE((j + 1) & 1);
    }
#undef BG_STEP
#undef KPOS
#undef SLOAD
#undef SWRITE
}
}

__device__ __forceinline__ void transpose_item(const float* __restrict__ src, int N, bf16_t* __restrict__ dst, int dK, LAS float* scr, int lane) {
#pragma unroll 8
    for (int i = 0; i < 32; ++i) { const int kk = 2 * i + (lane >> 5); scr[kk * 33 + (lane & 31)] = src[(size_t)kk * N + (lane & 31)]; }
    LDS_WAIT();
    const int c = lane & 7;
#pragma unroll
    for (int j = 0; j < 4; ++j) { const int n = (lane >> 3) + 8 * j; const LAS float* s = scr + (8 * c) * 33 + n;
        u32x4 o; o.x = cvt_pk_bf16(s[0 * 33], s[1 * 33]); o.y = cvt_pk_bf16(s[2 * 33], s[3 * 33]); o.z = cvt_pk_bf16(s[4 * 33], s[5 * 33]); o.w = cvt_pk_bf16(s[6 * 33], s[7 * 33]);
        *(u32x4*)(dst + (size_t)n * dK + 8 * c) = o; }
    LDS_WAIT();
}

__device__ __forceinline__ void transpose_item_fp8(const float* __restrict__ src, int N, unsigned char* __restrict__ dst, int dK, float sc, LAS float* scr, int lane) {
#pragma unroll 8
    for (int i = 0; i < 32; ++i) { const int kk = 2 * i + (lane >> 5); scr[kk * 33 + (lane & 31)] = src[(size_t)kk * N + (lane & 31)]; }
    LDS_WAIT();
    const int c = lane & 7;
#pragma unroll
    for (int j = 0; j < 4; ++j) { const int n = (lane >> 3) + 8 * j; const LAS float* s = scr + (8 * c) * 33 + n;
        u32x2 o; o.x = cvt_pk4_fp8(s[0 * 33] * sc, s[1 * 33] * sc, s[2 * 33] * sc, s[3 * 33] * sc); o.y = cvt_pk4_fp8(s[4 * 33] * sc, s[5 * 33] * sc, s[6 * 33] * sc, s[7 * 33] * sc);
        *(u32x2*)(dst + (size_t)n * dK + 8 * c) = o; }
    LDS_WAIT();
}

__device__ __forceinline__ void phase0(const Params& p, LAS unsigned char* lds, int vcu, int G) {
    unsigned char* ws = p.ws;
    const int tid = fresh_tid(), wave = tid >> 6, lane = tid & 63;
    const int gw = vcu * 8 + wave, NGW = G * 8;
    LAS float* scr = (LAS float*)(lds + wave * 8448);
    { const float* x = p.in[0]; bf16_t* xb = (bf16_t*)(ws + WS_XB); const size_t n8 = (size_t)T_TOK * DM / 8;
      for (size_t i = (size_t)blockIdx.x * NTHREADS + tid; i < n8; i += (size_t)G * NTHREADS) {
          const f32x4 a = *(const f32x4*)(x + i * 8), b = *(const f32x4*)(x + i * 8 + 4);
          u32x4 o; o.x = cvt_pk_bf16(a[0], a[1]); o.y = cvt_pk_bf16(a[2], a[3]); o.z = cvt_pk_bf16(b[0], b[1]); o.w = cvt_pk_bf16(b[2], b[3]);
          *(u32x4*)(xb + i * 8) = o;
          u32x2 o8; o8.x = cvt_pk4_fp8(a[0] * SX8, a[1] * SX8, a[2] * SX8, a[3] * SX8); o8.y = cvt_pk4_fp8(b[0] * SX8, b[1] * SX8, b[2] * SX8, b[3] * SX8);
          *(u32x2*)(ws + WS_X8 + i * 8) = o8; } }
    { const float* w_in = p.in[1]; const float* w_br = p.in[7]; const float* w_out = p.in[8];
      bf16_t* WINT = (bf16_t*)(ws + WS_WINT); bf16_t* WBT = (bf16_t*)(ws + WS_WBT); bf16_t* WOT = (bf16_t*)(ws + WS_WOT);
      for (int it = gw; it < 10240 + 1024 + 2048; it += NGW) {
          int r = it;
          if (r < 10240) { const int kb = r / 320, nb = r % 320;
              if (nb >= 144 && nb < 192) transpose_item(w_in + (size_t)(64 * kb) * ZC + 32 * nb, ZC, WINT + (size_t)(32 * nb) * DM + 64 * kb, DM, scr, lane);
              else transpose_item_fp8(w_in + (size_t)(64 * kb) * ZC + 32 * nb, ZC, ws + WS_WING8 + (size_t)(32 * (nb < 144 ? nb : nb - 48)) * DM + 64 * kb, DM, SWG8, scr, lane);
              continue; }
          r -= 10240;
          if (r < 1024) { const int g = r >> 9, r2 = r & 511, kb = r2 >> 6, nb = r2 & 63; transpose_item(w_br + ((size_t)g * 512 + 64 * kb) * DM + 32 * nb, DM, WBT + (size_t)(32 * nb) * 1024 + g * 512 + 64 * kb, 1024, scr, lane); continue; }
          r -= 1024;
          { const int kb = r >> 6, nb = r & 63; transpose_item(w_out + (size_t)(64 * kb) * DM + 32 * nb, DM, WOT + (size_t)(32 * nb) * DM + 64 * kb, DM, scr, lane); }
      } }
    { float* cosA = (float*)(ws + WS_COSA); float* sinA = (float*)(ws + WS_SINA); float* cosB = (float*)(ws + WS_COSB); float* sinB = (float*)(ws + WS_SINB);
      const int gt = blockIdx.x * NTHREADS + tid, NGT = G * NTHREADS;
      for (int i = gt; i < SEQ * 16; i += NGT) { const int pos = i >> 4, k = i & 15; const float inv = (float)pow(500000.0, -(double)k / 16.0); const float ang = (float)pos * inv; cosA[i] = cosf(ang); sinA[i] = sinf(ang); }
      for (int i = gt; i < SEQ * 8; i += NGT) { const int pos = i >> 3, k = i & 7; const float inv = (float)pow(500000.0, -(double)k / 8.0); const float ang = (float)pos * inv; cosB[i] = cosf(ang); sinB[i] = sinf(ang); }
      const float* wr = p.in[11]; float* wrt = (float*)(ws + WS_WRT);
      for (int i = gt; i < NE * DM; i += NGT) { const int e = i >> 11, d = i & (DM - 1); wrt[i] = wr[d * NE + e]; } }
}

__device__ __forceinline__ void moe_weight_convert(LAS unsigned char* lds, const BgConv bg, BgState& bs) {
    const int tid = fresh_tid(), wave = __builtin_amdgcn_readfirstlane(tid >> 6), lane = tid & 63;
    LAS unsigned char* scr = lds + LDS_BG + wave * 8448;
    for (;;) { bg_finish(bg, bs.pend, bs.par, scr, lane); if (bs.it >= BG_ITEMS) break; bg_issue(bg, bs.it, bs.pend, bs.par, scr, lane); }
}
__device__ __forceinline__ void bg_drain(LAS unsigned char* lds, const BgConv bg, BgState& bs) {
    const int tid = fresh_tid(), wave = __builtin_amdgcn_readfirstlane(tid >> 6), lane = tid & 63;
    bg_finish(bg, bs.pend, bs.par, lds + LDS_BG + wave * 8448, lane);
}

__device__ __forceinline__ void dil_item(const Params& p, LAS unsigned char* lds, int idx, const BgConv bg, BgState& bs) {
    using namespace att;
    unsigned char* ws = p.ws;
    const bf16_t* Z = (const bf16_t*)(ws + WS_Z); bf16_t* OG = (bf16_t*)(ws + WS_OG); float* LSEG = (float*)(ws + WS_LSEG);
    const int tid = fresh_tid(), wid = __builtin_amdgcn_readfirstlane(tid >> 6), lane = tid & 63, r32 = lane & 31, hi = lane >> 5;
    const int sub = idx & 15, h = (idx >> 4) & 3, bgi = idx >> 6, g = bgi % 3, b = bgi / 3;
    const int lr = g * 2, r = 1 << lr, L = SEQ >> lr, phase = sub & (r - 1), qb = sub >> lr;
    const int head = g * 4 + h;
    const int qpos = qb * 256 + wid * 32 + r32;
    const size_t tokq = (size_t)b * SEQ + phase + (size_t)r * qpos;
    const bf16_t* Qw = Z + tokq * ZC + head * 128 + hi * 8;
    const bf16_t* Kb = Z + ((size_t)b * SEQ + phase) * ZC + 1536 + head * 128;
    const bf16_t* Vb = Z + ((size_t)b * SEQ + phase) * ZC + 3072 + head * 128;
    f32x16 o[4] = {}; float m_reg = -1e30f, l_reg = 0.f;
    attn_pass<128, true>(Qw, Kb, Vb, (size_t)r * ZC, 6, qb * 256 - 64, L, qpos, wid >> 1, (wid >> 1) + 2, (LAS char*)lds, o, m_reg, l_reg, bg, bs);
    LAS float* li_l = (LAS float*)(lds + 65536) + wid * 64 + 32;
    int r32e = r32, hie = hi; asm volatile("" : "+v"(r32e), "+v"(hie));
    if (hie == 0) { li_l[r32e] = l_reg; const size_t tq = (size_t)b * SEQ + phase + (size_t)r * (qb * 256 + wid * 32 + r32e); LSEG[((size_t)g * T_TOK + tq) * 4 + h] = m_reg * 0.08838834764831845f + __logf(l_reg); }
    LDS_WAIT();
#pragma unroll
    for (int rr = 0; rr < 16; ++rr) { const int row = crow(rr, hie); const float rl = 1.f / li_l[row];
        const size_t tok = (size_t)b * SEQ + phase + (size_t)r * (qb * 256 + wid * 32 + row);
        bf16_t* op = OG + ((size_t)g * T_TOK + tok) * 512 + h * 128 + r32e;
#pragma unroll
        for (int d0 = 0; d0 < 4; ++d0) op[d0 * 32] = f2bf(o[d0][rr] * rl);
        asm volatile("" ::: "memory"); }
    LDS_WAIT();
}

__device__ __forceinline__ void diff_item(const Params& p, LAS unsigned char* lds, int item, const BgConv bg, BgState& bs) {
    using namespace att;
    unsigned char* ws = p.ws;
    const bf16_t* Z = (const bf16_t*)(ws + WS_Z); float* O0 = (float*)(ws + WS_O0); bf16_t* BR = (bf16_t*)(ws + WS_BR);
    const int tid = fresh_tid(), wid = __builtin_amdgcn_readfirstlane(tid >> 6), lane = tid & 63, r32 = lane & 31, hi = lane >> 5;
    const int b = item >> 6, h = (item >> 4) & 3, qb = item & 15;
    const size_t tok0 = (size_t)b * SEQ + qb * 256 + wid * 32;
    LAS float* li_l = (LAS float*)(lds + 65536) + wid * 64 + 32;
    for (int c = 0; c < 2; ++c) {
        const bf16_t* Qw = Z + (tok0 + r32) * ZC + 4608 + h * 128 + c * 64 + hi * 8;
        const bf16_t* Kb = Z + ((size_t)b * SEQ) * ZC + 5120 + h * 128 + c * 64;
        const bf16_t* Vb = Z + ((size_t)b * SEQ) * ZC + 5632 + h * 128;
        f32x16 o[4] = {}; float m_reg = -1e30f, l_reg = 0.f;
        attn_pass<64, false>(Qw, Kb, Vb, (size_t)ZC, SEQ / 64, 0, SEQ, 0, 0, SEQ / 64 - 1, (LAS char*)lds, o, m_reg, l_reg, bg, bs);
        int r32e = r32, hie = hi, lanee = lane; asm volatile("" : "+v"(r32e), "+v"(hie), "+v"(lanee));
        if (hie == 0) li_l[r32e] = l_reg;
        LDS_WAIT();
        if (c == 0) {
#pragma unroll
            for (int rr = 0; rr < 16; ++rr) { const int row = crow(rr, hie); const float rl = 1.f / li_l[row];
                float* op = O0 + (tok0 + row) * 512 + h * 128 + r32e;
#pragma unroll
                for (int d0 = 0; d0 < 4; ++d0) op[d0 * 32] = o[d0][rr] * rl;
                asm volatile("" ::: "memory"); }
        } else {
            const float s1 = wave_sum(p.in[2][lanee] * p.in[3][lanee]), s2 = wave_sum(p.in[4][lanee] * p.in[5][lanee]);
            const float lam = __expf(s1) - __expf(s2) + 0.2f;
            const float* nw = p.in[6];
            float nwv[4];
#pragma unroll
            for (int d0 = 0; d0 < 4; ++d0) nwv[d0] = nw[d0 * 32 + r32e] * 0.8f;
#pragma unroll
            for (int rr = 0; rr < 16; ++rr) { const int row = crow(rr, hie); const float rl = 1.f / li_l[row];
                const float* ip = O0 + (tok0 + row) * 512 + h * 128 + r32e;
                float v[4], ss = 0.f;
#pragma unroll
                for (int d0 = 0; d0 < 4; ++d0) { v[d0] = ip[d0 * 32] - lam * (o[d0][rr] * rl); ss += v[d0] * v[d0]; }
                ss = half_sum(ss);
                const float rinv = rsqrtf(ss * (1.f / 128.f) + 1e-5f);
                bf16_t* op = BR + (tok0 + row) * 1024 + 512 + h * 128 + r32e;
#pragma unroll
                for (int d0 = 0; d0 < 4; ++d0) op[d0 * 32] = f2bf(v[d0] * rinv * nwv[d0]);
                asm volatile("" ::: "memory"); }
        }
        LDS_WAIT();
    }
}

__device__ __forceinline__ void combine_rows(const Params& p, int vcu, int G) {
    unsigned char* ws = p.ws;
    const bf16_t* OG = (const bf16_t*)(ws + WS_OG); const float* LSEG = (const float*)(ws + WS_LSEG); bf16_t* BR = (bf16_t*)(ws + WS_BR);
    const int tid = fresh_tid(), wave = tid >> 6, lane = tid & 63;
    const int h = lane >> 4;
    for (int t = vcu * 8 + wave; t < T_TOK; t += G * 8) {
        const float l0 = LSEG[((size_t)0 * T_TOK + t) * 4 + h], l1 = LSEG[((size_t)1 * T_TOK + t) * 4 + h], l2 = LSEG[((size_t)2 * T_TOK + t) * 4 + h];
        const float mx = fmaxf(l0, fmaxf(l1, l2)); float w0 = __expf(l0 - mx), w1 = __expf(l1 - mx), w2 = __expf(l2 - mx); const float inv = 1.f / (w0 + w1 + w2); w0 *= inv; w1 *= inv; w2 *= inv;
        const u32x4 a = *(const u32x4*)(OG + ((size_t)0 * T_TOK + t) * 512 + lane * 8), bq = *(const u32x4*)(OG + ((size_t)1 * T_TOK + t) * 512 + lane * 8), cq = *(const u32x4*)(OG + ((size_t)2 * T_TOK + t) * 512 + lane * 8);
        u32x4 o;
#pragma unroll
        for (int k = 0; k < 4; ++k) { const float lo = w0 * bf_lo(a[k]) + w1 * bf_lo(bq[k]) + w2 * bf_lo(cq[k]), hi2 = w0 * bf_hi(a[k]) + w1 * bf_hi(bq[k]) + w2 * bf_hi(cq[k]); o[k] = cvt_pk_bf16(lo, hi2); }
        *(u32x4*)(BR + (size_t)t * 1024 + lane * 8) = o;
    }
}

__device__ __forceinline__ void ln1_router(const Params& p, LAS unsigned char* lds, int vcu, int G) {
    unsigned char* ws = p.ws;
    const float* V1 = p.in[0]; const bf16_t* MIX = (const bf16_t*)(ws + WS_MIX); unsigned char* X1B = ws + WS_X1B;     const float* wrt = (const float*)(ws + WS_WRT); float* AFFT = (float*)(ws + WS_AFFT);
    const float* g1 = p.in[9]; const float* b1 = p.in[10];
    const int tid = fresh_tid(), wave = tid >> 6, lane = tid & 63;
    __syncthreads();
    for (int i = tid; i < NE * DM / 4; i += NTHREADS) ((LAS f32x4*)lds)[i] = ((const f32x4*)wrt)[i];
    __syncthreads();
    for (int rp = vcu * 8 + wave; rp < T_TOK / 4; rp += G * 8) {
        const int t0 = rp * 4;
        f32x4 v[4][8];
#pragma unroll
        for (int q = 0; q < 4; ++q) {
            const float* xr = V1 + (size_t)(t0 + q) * DM + lane * 4; const bf16_t* mr = MIX + (size_t)(t0 + q) * DM + lane * 4; float s = 0.f;
#pragma unroll
            for (int j = 0; j < 8; ++j) { v[q][j] = *(const f32x4*)(xr + 256 * j) * ALPHA + pg8::ld_bf16x4(mr + 256 * j); s += (v[q][j][0] + v[q][j][1]) + (v[q][j][2] + v[q][j][3]); }
            const float mean = wave_sum(s) * (1.f / DM); float s2 = 0.f;
#pragma unroll
            for (int j = 0; j < 8; ++j) { v[q][j] = v[q][j] - mean; s2 += (v[q][j][0] * v[q][j][0] + v[q][j][1] * v[q][j][1]) + (v[q][j][2] * v[q][j][2] + v[q][j][3] * v[q][j][3]); }
            const float rstd = rsqrtf(wave_sum(s2) * (1.f / DM) + LN_EPS);
            unsigned char* xbo = X1B + (size_t)(t0 + q) * DM + lane * 4;
#pragma unroll
            for (int j = 0; j < 8; ++j) { const f32x4 gg = *(const f32x4*)(g1 + lane * 4 + 256 * j), bb = *(const f32x4*)(b1 + lane * 4 + 256 * j);
                v[q][j] = v[q][j] * rstd * gg + bb; *(unsigned*)(xbo + 256 * j) = cvt_pk4_fp8(v[q][j][0] * SX8, v[q][j][1] * SX8, v[q][j][2] * SX8, v[q][j][3] * SX8); }
            asm volatile("" ::: "memory");
        }
        float lg[4] = {0.f, 0.f, 0.f, 0.f};
        const LAS float* wl = (const LAS float*)lds + lane * 4;
#pragma unroll 1
        for (int e = 0; e < NE; ++e) {
            f32x4 W[8];
#pragma unroll
            for (int j = 0; j < 8; ++j) W[j] = *(const LAS f32x4*)(wl + e * DM + 256 * j);
#pragma unroll
            for (int q = 0; q < 4; ++q) { float a = 0.f;
#pragma unroll
                for (int j = 0; j < 8; ++j) a += (v[q][j][0] * W[j][0] + v[q][j][1] * W[j][1]) + (v[q][j][2] * W[j][2] + v[q][j][3] * W[j][3]);
                a = wave_sum(a); lg[q] = (lane == e) ? a : lg[q]; }
        }
#pragma unroll
        for (int q = 0; q < 4; ++q) {
            float mx = lg[q];
            mx = fmaxf(mx, swz_xor<1>(mx)); mx = fmaxf(mx, swz_xor<2>(mx)); mx = fmaxf(mx, swz_xor<4>(mx)); mx = fmaxf(mx, swz_xor<8>(mx));
            const float ex = expf(lg[q] - mx); float sum = ex;
            sum += swz_xor<1>(sum); sum += swz_xor<2>(sum); sum += swz_xor<4>(sum); sum += swz_xor<8>(sum);
            const int t = t0 + q, bb = t >> 12, s = t & (SEQ - 1);
            if (lane < NE) AFFT[((size_t)bb * NE + lane) * SEQ + s] = ex / sum;
        }
    }
}

__device__ __forceinline__ void topk_gather(const Params& p, LAS unsigned char* lds, int G) {
    unsigned char* ws = p.ws;
    const float* AFFT = (const float*)(ws + WS_AFFT); int* SLOT = (int*)(ws + WS_SLOT); float* GATE = (float*)(ws + WS_GATE);
    const unsigned char* X1B = ws + WS_X1B; unsigned char* XG = ws + WS_XG;
    const int tid = fresh_tid(), wave = tid >> 6, lane = tid & 63;
    LAS unsigned* hist = (LAS unsigned*)lds;
    LAS unsigned* ctl = hist + 256;
    LAS unsigned* wtot = hist + 272;
    LAS int* rows = (LAS int*)(hist + 288);
    for (int item = blockIdx.x; item < NB * NE * 4; item += G) {
        const int qd = item & 3, be = item >> 2, b = be >> 4, e = be & 15;
        const float* ap = AFFT + (size_t)be * SEQ + tid * 8;
        const f32x4 fa = *(const f32x4*)ap, fb = *(const f32x4*)(ap + 4);
        float av[8] = {fa[0], fa[1], fa[2], fa[3], fb[0], fb[1], fb[2], fb[3]};
        unsigned key[8];
#pragma unroll
        for (int i = 0; i < 8; ++i) key[i] = __float_as_uint(av[i]);
        unsigned prefix = 0u, mask = 0u, remaining = CAP;
        for (int pass = 0; pass < 4; ++pass) {
            const int shift = 24 - 8 * pass;
            __syncthreads();
            if (tid < 256) hist[tid] = 0u;
            __syncthreads();
#pragma unroll
            for (int i = 0; i < 8; ++i) if ((key[i] & mask) == prefix) atomicAdd((unsigned*)&hist[(key[i] >> shift) & 255u], 1u);
            __syncthreads();
            if (wave == 0) {
                unsigned c0 = hist[4 * lane], c1 = hist[4 * lane + 1], c2 = hist[4 * lane + 2], c3 = hist[4 * lane + 3];
                const unsigned t = c0 + c1 + c2 + c3; unsigned v = t;
#pragma unroll
                for (int of = 1; of < 64; of <<= 1) { const unsigned u = __shfl_down(v, of); if (lane + of < 64) v += u; }
                unsigned cum = v - t;
                unsigned cs[4] = {c0, c1, c2, c3};
#pragma unroll
                for (int k = 3; k >= 0; --k) { if (cum < remaining && cum + cs[k] >= remaining) { ctl[0] = 4 * lane + k; ctl[1] = remaining - cum; } cum += cs[k]; }
            }
            __syncthreads();
            prefix |= ctl[0] << shift; mask |= 0xFFu << shift; remaining = ctl[1];
        }
        const unsigned Tk = prefix, need_eq = remaining, cnt_gt_total = CAP - need_eq;
        unsigned ngt = 0, neq = 0;
#pragma unroll
        for (int i = 0; i < 8; ++i) { ngt += key[i] > Tk ? 1u : 0u; neq += key[i] == Tk ? 1u : 0u; }
        const unsigned packed = ngt | (neq << 16); unsigned incl = packed;
#pragma unroll
        for (int of = 1; of < 64; of <<= 1) { const unsigned u = __shfl_up(incl, of); if (lane >= of) incl += u; }
        __syncthreads();
        if (lane == 63) wtot[wave] = incl;
        __syncthreads();
        unsigned base = 0;
        for (int w = 0; w < wave; ++w) base += wtot[w];
        unsigned excl = base + incl - packed; unsigned rgt = excl & 0xffffu, req = excl >> 16;
        int slots[8];
#pragma unroll
        for (int i = 0; i < 8; ++i) { int sl = -1;
            if (key[i] > Tk) { sl = (int)rgt; ++rgt; } else if (key[i] == Tk) { if (req < need_eq) sl = (int)(cnt_gt_total + req); ++req; }
            slots[i] = sl;
            if (sl >= 0) { if ((sl >> 7) == qd) rows[sl & 127] = tid * 8 + i; if (qd == 0) GATE[(size_t)e * 2048 + b * CAP + sl] = av[i]; } }
        if (qd == 0) { int* sp = SLOT + (size_t)be * SEQ + tid * 8; *(int4*)sp = make_int4(slots[0], slots[1], slots[2], slots[3]); *(int4*)(sp + 4) = make_int4(slots[4], slots[5], slots[6], slots[7]); }
        __syncthreads();
        for (int r = wave; r < 128; r += 8) {
            const int s = rows[r];
            const u32x4* src = (const u32x4*)(X1B + ((size_t)b * SEQ + s) * DM); u32x4* dst = (u32x4*)(XG + ((size_t)e * 2048 + b * CAP + qd * 128 + r) * DM);
#pragma unroll
            for (int j = 0; j < 2; ++j) dst[lane + 64 * j] = src[lane + 64 * j];
        }
    }
}

__device__ __forceinline__ void ln2_rows(const Params& p, int vcu, int G) {
    unsigned char* ws = p.ws;
    const bf16_t* YS = (const bf16_t*)(ws + WS_YS); const int* SLOT = (const int*)(ws + WS_SLOT);
    const float* g2 = p.in[15]; const float* b2 = p.in[16]; float* out = p.out;
    const int tid = fresh_tid(), wave = tid >> 6, lane = tid & 63;
    for (int t = vcu * 8 + wave; t < T_TOK; t += G * 8) {
        const int b = t >> 12, s = t & (SEQ - 1);
        const int myslot = lane < NE ? SLOT[((size_t)b * NE + lane) * SEQ + s] : -1;
        f32x4 v[8];
        const float* xr = p.in[0] + (size_t)t * DM + lane * 4; const bf16_t* mr = (const bf16_t*)(ws + WS_MIX) + (size_t)t * DM + lane * 4;
        { float s0 = 0.f;
#pragma unroll
          for (int j = 0; j < 8; ++j) { v[j] = *(const f32x4*)(xr + 256 * j) * ALPHA + pg8::ld_bf16x4(mr + 256 * j); s0 += (v[j][0] + v[j][1]) + (v[j][2] + v[j][3]); }
          const float mean1 = wave_sum(s0) * (1.f / DM); float q1 = 0.f;
#pragma unroll
          for (int j = 0; j < 8; ++j) { v[j] = v[j] - mean1; q1 += (v[j][0] * v[j][0] + v[j][1] * v[j][1]) + (v[j][2] * v[j][2] + v[j][3] * v[j][3]); }
          const float rstd1 = rsqrtf(wave_sum(q1) * (1.f / DM) + LN_EPS);
#pragma unroll
          for (int j = 0; j < 8; ++j) { const f32x4 gg = *(const f32x4*)(p.in[9] + lane * 4 + 256 * j), bb = *(const f32x4*)(p.in[10] + lane * 4 + 256 * j); v[j] = (v[j] * rstd1 * gg + bb) * ALPHA; } }
        for (int e = 0; e < NE; ++e) {
            const int sl = __builtin_amdgcn_readlane(myslot, e);
            if (sl >= 0) { const bf16_t* yr = YS + ((size_t)e * 2048 + b * CAP + sl) * DM + lane * 4;
#pragma unroll
                for (int j = 0; j < 8; ++j) v[j] += pg8::ld_bf16x4(yr + 256 * j); }
        }
        float sm = 0.f;
#pragma unroll
        for (int j = 0; j < 8; ++j) sm += (v[j][0] + v[j][1]) + (v[j][2] + v[j][3]);
        const float mean = wave_sum(sm) * (1.f / DM); float s2 = 0.f;
#pragma unroll
        for (int j = 0; j < 8; ++j) { v[j] = v[j] - mean; s2 += (v[j][0] * v[j][0] + v[j][1] * v[j][1]) + (v[j][2] * v[j][2] + v[j][3] * v[j][3]); }
        const float rstd = rsqrtf(wave_sum(s2) * (1.f / DM) + LN_EPS);
        float* orow = out + (size_t)t * DM + lane * 4;
#pragma unroll
        for (int j = 0; j < 8; ++j) { const f32x4 gg = *(const f32x4*)(g2 + lane * 4 + 256 * j), bb = *(const f32x4*)(b2 + lane * 4 + 256 * j); *(f32x4*)(orow + 256 * j) = v[j] * rstd * gg + bb; }
    }
}

__global__ void __launch_bounds__(NTHREADS, 2) mega(Params p) {
    extern __shared__ __attribute__((aligned(16))) unsigned char shm[];
    LAS unsigned char* lds = (LAS unsigned char*)shm;
    cg::grid_group grid = cg::this_grid();
    const int G = gridDim.x, bx = blockIdx.x;
    const int vcu = (G % 8 == 0) ? (bx % 8) * (G / 8) + bx / 8 : bx;
    unsigned char* ws = p.ws;
    if (fresh_tid() < 16) ((LAS unsigned*)(lds + LDS_BARW))[fresh_tid()] = 0u;
    __syncthreads();
    const XcdBarrier xb = xcd_barrier_post((unsigned*)(ws + WS_BARW), (volatile LAS unsigned*)(lds + LDS_BARW));

    const BgConv bg{p.in[12], p.in[13], p.in[14], ws + WS_WGUT, ws + WS_WDT, G * 8, 0};
    BgState bs; bs.it = vcu * 8 + __builtin_amdgcn_readfirstlane(fresh_tid() >> 6); bs.pend = -1; bs.par = 0; bs.tick = 0;
    if (PHASE_MASK & 1) REPS(0) phase0(p, lds, vcu, G);
    if (p.ws == nullptr) grid.sync();
    xcd_barrier(xb);
    if (PHASE_MASK & 2) REPS(1) {
      { pg8::Gemm g{(const bf16_t*)(ws + WS_XB), (const bf16_t*)(ws + WS_WINT) + (size_t)4608 * DM, T_TOK, 1536, DM}; pg8::InBf16Order S{G, bx};
        pg8::EpiZ E{(bf16_t*)(ws + WS_Z), (const float*)(ws + WS_COSA), (const float*)(ws + WS_SINA), (const float*)(ws + WS_COSB), (const float*)(ws + WS_SINB), 18, 1.f};
        pg8::gemm_phase(lds, g, S, E); }
      { pg8::Gemm g{(const bf16_t*)(ws + WS_X8), (const bf16_t*)(ws + WS_WING8), T_TOK, 8704, DM}; pg8::InFp8Order S{G, bx};
        pg8::EpiInFp8 E{pg8::EpiZ{(bf16_t*)(ws + WS_Z), (const float*)(ws + WS_COSA), (const float*)(ws + WS_SINA), (const float*)(ws + WS_COSB), (const float*)(ws + WS_SINB), 0, 1.f / (SX8 * SWG8)}, pg8::EpiGate{ws + WS_GF}};
        pg8::gemm_phase<pg8::EpiInFp8, pg8::InFp8Order, true>(lds, g, S, E); } }
    xcd_barrier(xb);
    if (PHASE_MASK & 4) REPS(2) for (int it = vcu; it < 768; it += G) dil_item(p, lds, it, bg, bs);
    bg_drain(lds, bg, bs);
    xcd_barrier(xb);
    if (PHASE_MASK & 8) REPS(3) combine_rows(p, vcu, G);
    if (PHASE_MASK & 16) REPS(4) for (int it = vcu; it < 256; it += G) diff_item(p, lds, it, bg, bs);
    bg_drain(lds, bg, bs);
    xcd_barrier(xb);
    if (PHASE_MASK & 32) REPS(5) { pg8::Gemm g{(const bf16_t*)(ws + WS_BR), (const bf16_t*)(ws + WS_WBT), T_TOK, DM, 1024}; pg8::StaticOrder S; S.init(T_TOK, DM, G, bx);
      pg8::EpiBranch E{(bf16_t*)(ws + WS_MERGED), ws + WS_GF};
      pg8::gemm_phase(lds, g, S, E); }
    xcd_barrier(xb);
    if (PHASE_MASK & 64) REPS(6) { pg8::Gemm g{(const bf16_t*)(ws + WS_MERGED), (const bf16_t*)(ws + WS_WOT), T_TOK, DM, DM}; pg8::StaticOrder S; S.init(T_TOK, DM, G, bx);
      pg8::EpiOut E{(bf16_t*)(ws + WS_MIX)};
      pg8::gemm_phase(lds, g, S, E); }
    xcd_barrier(xb);
    if (PHASE_MASK & 128) moe_weight_convert(lds, bg, bs);
    if (PHASE_MASK & 256) REPS(8) ln1_router(p, lds, vcu, G);
    xcd_barrier(xb);
    if (PHASE_MASK & 512) REPS(9) topk_gather(p, lds, G);
    xcd_barrier(xb);
    if (PHASE_MASK & 1024) REPS(10) { pg8::Gemm g{(const bf16_t*)(ws + WS_XG), (const bf16_t*)(ws + WS_WGUT), NE * 2048, NE * 4096, DM}; pg8::UpOrder S{G, bx};
      pg8::EpiUp E{ws + WS_H};
      pg8::gemm_phase<pg8::EpiUp, pg8::UpOrder, true>(lds, g, S, E); }
    xcd_barrier(xb);
    if (PHASE_MASK & 2048) REPS(11) { pg8::Gemm g{(const bf16_t*)(ws + WS_H), (const bf16_t*)(ws + WS_WDT), NE * 2048, NE * 2048, DM}; pg8::DownOrder S{G, bx};
      pg8::EpiDown E{(bf16_t*)(ws + WS_YS), (const float*)(ws + WS_GATE)};
      pg8::gemm_phase<pg8::EpiDown, pg8::DownOrder, true>(lds, g, S, E); }
    xcd_barrier(xb);
    if (PHASE_MASK & 4096) REPS(12) ln2_rows(p, vcu, G);
}

extern "C" void kernel_launch(void* const* d_in, const int* in_sizes, int n_in, void* d_out, int out_size, void* d_ws, size_t ws_size, hipStream_t stream) {
    static int grid = 0;
    if (grid == 0) {
        if (n_in != 17 || out_size != T_TOK * DM || ws_size < WS_END) { fprintf(stderr, "kernel_launch: unexpected shapes (n_in %d out %d ws %zu, need ws >= %zu)\n", n_in, out_size, ws_size, (size_t)WS_END); grid = -1; return; }
        int dev = 0, cus = 0, per_cu = 0;
        hipGetDevice(&dev); hipDeviceGetAttribute(&cus, hipDeviceAttributeMultiprocessorCount, dev);
        if (hipFuncSetAttribute((const void*)mega, hipFuncAttributeMaxDynamicSharedMemorySize, LDS_BYTES) != hipSuccess) { fprintf(stderr, "kernel_launch: hipFuncSetAttribute failed\n"); grid = -1; return; }
        if (hipOccupancyMaxActiveBlocksPerMultiprocessor(&per_cu, (const void*)mega, NTHREADS, LDS_BYTES) != hipSuccess || per_cu < 1) { fprintf(stderr, "kernel_launch: occupancy query gave %d\n", per_cu); per_cu = 1; }
        (void)hipGetLastError();
        grid = cus * per_cu;
    }
    if (grid < 0) return;
    Params p{};
    for (int i = 0; i < 17; ++i) p.in[i] = (const float*)d_in[i];
    p.out = (float*)d_out; p.ws = (unsigned char*)d_ws;
    void* args[] = {&p};
    if (hipMemsetAsync((char*)d_ws + WS_BARW, 0, XCD_BAR_WORDS * 4, stream) != hipSuccess) { fprintf(stderr, "kernel_launch: memset of the barrier words failed\n"); return; }
    hipError_t e = hipLaunchCooperativeKernel((void*)mega, dim3(grid), dim3(NTHREADS), args, LDS_BYTES, stream);
    if (e != hipSuccess) fprintf(stderr, "cooperative launch failed: %s (grid %d)\n", hipGetErrorString(e), grid);
}
```

```cpp
#include <hip/hip_runtime.h>
#include <hip/hip_cooperative_groups.h>
#include <cstdio>
#include <cstdint>
namespace cg = cooperative_groups;

#define LAS __attribute__((address_space(3)))
typedef unsigned short bf16_t;
typedef short bf16x8 __attribute__((ext_vector_type(8)));
typedef short s16x4 __attribute__((ext_vector_type(4)));
typedef float f32x4 __attribute__((ext_vector_type(4)));
typedef float f32x16 __attribute__((ext_vector_type(16)));
typedef unsigned u32x4 __attribute__((ext_vector_type(4)));
typedef unsigned u32x2 __attribute__((ext_vector_type(2)));
typedef int i32x4 __attribute__((ext_vector_type(4)));
typedef int i32x8 __attribute__((ext_vector_type(8)));

constexpr int T_TOK = 16384, DM = 2048, SEQ = 4096, NB = 4, ZC = 10240, NE = 16, CAP = 512;
constexpr float ALPHA = 1.189207115002721f;
constexpr float LN_EPS = 1e-5f;
constexpr float SX8 = 8.f, SW8 = 64.f, SH8 = 16.f, SWG8 = 32.f;
constexpr int LDS_BG = 100352, LDS_BGW = 4224, LDS_BARW = 135168;
constexpr int LDS_BYTES = LDS_BARW + 64;
constexpr int NTHREADS = 512;
#ifndef PHASE_MASK
#define PHASE_MASK 0xFFFF
#endif
#ifndef REP_MASK
#define REP_MASK 0
#endif
#define REPS(k) for (int rep_ = 0; rep_ < 1 + ((REP_MASK >> (k)) & 1); ++rep_)

constexpr size_t MiB = (size_t)1 << 20;
constexpr size_t WS_WGUT = 0, WS_WDT = 128 * MiB;
constexpr size_t WS_XB = 384 * MiB, WS_WINT = 448 * MiB, WS_Z = 488 * MiB;
constexpr size_t WS_XG = 384 * MiB, WS_YS = 384 * MiB, WS_H = 512 * MiB;
constexpr size_t WS_WBT = 808 * MiB, WS_WOT = 812 * MiB, WS_COSA = 820 * MiB, WS_SINA = WS_COSA + 256 * 1024,
                 WS_COSB = WS_SINA + 256 * 1024, WS_SINB = WS_COSB + 128 * 1024, WS_WRT = 821 * MiB,
                 WS_AFFT = 822 * MiB, WS_SLOT = 823 * MiB, WS_GATE = 824 * MiB, WS_LSEG = 825 * MiB;
constexpr size_t WS_BR = 826 * MiB, WS_MERGED = 858 * MiB, WS_OG = 922 * MiB, WS_O0 = 970 * MiB;
constexpr size_t WS_X1B = 922 * MiB;
constexpr size_t WS_GF = 192 * MiB;
constexpr size_t WS_MIX = 576 * MiB;
constexpr size_t WS_X8 = 320 * MiB, WS_WING8 = 352 * MiB;
constexpr size_t WS_BARW = 1002 * MiB, WS_END = 1002 * MiB + 16384;

struct Params { const float* in[17]; float* out; unsigned char* ws; };

typedef __bf16 bf16x2_t __attribute__((ext_vector_type(2)));
typedef float f32x2_t __attribute__((ext_vector_type(2)));
__device__ __forceinline__ unsigned cvt_pk_bf16(float lo, float hi) { const f32x2_t v = {lo, hi}; const bf16x2_t b = __builtin_convertvector(v, bf16x2_t); return __builtin_bit_cast(unsigned, b); }
__device__ __forceinline__ unsigned cvt_pk4_fp8(float a, float b, float c, float d) { int w = __builtin_amdgcn_cvt_pk_fp8_f32(a, b, 0, false); w = __builtin_amdgcn_cvt_pk_fp8_f32(c, d, w, true); return (unsigned)w; }
__device__ __forceinline__ float bf_lo(unsigned w) { return __uint_as_float(w << 16); }
__device__ __forceinline__ float bf_hi(unsigned w) { return __uint_as_float(w & 0xffff0000u); }
__device__ __forceinline__ bf16_t f2bf(float f) { unsigned u = __float_as_uint(f); u += 0x7FFFu + ((u >> 16) & 1u); return (bf16_t)(u >> 16); }
template <int K> __device__ __forceinline__ float swz_xor(float v) { return __int_as_float(__builtin_amdgcn_ds_swizzle(__float_as_int(v), (K << 10) | 0x1f)); }
__device__ __forceinline__ float half_sum(float v) { v += swz_xor<1>(v); v += swz_xor<2>(v); v += swz_xor<4>(v); v += swz_xor<8>(v); v += swz_xor<16>(v); return v; }
__device__ __forceinline__ float wave_sum(float v) {
    v = half_sum(v);
    auto rr = __builtin_amdgcn_permlane32_swap(__float_as_uint(v), __float_as_uint(v), false, false);
    return __uint_as_float(rr[0]) + __uint_as_float(rr[1]);
}
__device__ __forceinline__ int fresh_tid() { int t = __builtin_amdgcn_workitem_id_x(); asm volatile("" : "+v"(t)); return t; }
#define LDS_WAIT() asm volatile("s_waitcnt lgkmcnt(0)" ::: "memory")


#define XB_TMO      128
#define XB_XCNT(j)  (256  + 64 * (j))
#define XB_XSUB(j)  (1280 + 64 * (j))
#define XB_XGEN(j)  (2304 + 64 * (j))
#define XB_TOP      3328
#define XB_TOPGEN   3392
#define XCD_BAR_WORDS 3456
#define XB_SPIN_CAP (1u << 18)
__device__ __forceinline__ unsigned xb_ld(unsigned* p)              { return __hip_atomic_load(p, __ATOMIC_RELAXED, __HIP_MEMORY_SCOPE_AGENT); }
__device__ __forceinline__ unsigned xb_add(unsigned* p, unsigned v) { return __hip_atomic_fetch_add(p, v, __ATOMIC_RELAXED, __HIP_MEMORY_SCOPE_AGENT); }
__device__ __forceinline__ unsigned xb_xcc_id() { return (unsigned)__builtin_amdgcn_s_getreg((3 << 11) | 20) & 0xFu; }
#define XB_SPIN(cond, bar) do { unsigned _sp = 0; while (cond) { __builtin_amdgcn_s_sleep(1); \
    if ((++_sp & 255u) == 0u) { if (xb_ld(&(bar)[XB_TMO])) break; if (_sp > XB_SPIN_CAP) { atomicAdd(&(bar)[XB_TMO], 1u); break; } } } } while (0)
struct XcdBarrier { unsigned* bar; unsigned x; volatile LAS unsigned* st; };
__device__ __forceinline__ XcdBarrier xcd_barrier_post(unsigned* bar, volatile LAS unsigned* st) {
    XcdBarrier b; b.bar = bar; b.x = xb_xcc_id(); b.st = st;
    if (fresh_tid() == 0) (void)xb_add(&bar[XB_XCNT(b.x)], 1u);
    return b;
}
__device__ __forceinline__ void xcd_barrier_complete(unsigned* bar, unsigned x, unsigned& nloc, unsigned& nx) {
    const unsigned G = gridDim.x * gridDim.y * gridDim.z;
    unsigned sum, cnt, mine, sp = 0u;
    for (;;) {
        sum = 0u; cnt = 0u; mine = 0u;
#pragma unroll
        for (unsigned j = 0; j < 16; ++j) { const unsigned c = xb_ld(&bar[XB_XCNT(j)]); sum += c; cnt += (c > 0u) ? 1u : 0u; mine = (j == x) ? c : mine; }
        if (sum == G) break;
        __builtin_amdgcn_s_sleep(1);
        if ((++sp & 255u) == 0u) { if (xb_ld(&bar[XB_TMO])) break; if (sp > XB_SPIN_CAP) { atomicAdd(&bar[XB_TMO], 1u); break; } }
    }
    nloc = mine > 0u ? mine : 1u; nx = cnt > 0u ? cnt : 1u;
}
__device__ __forceinline__ void xcd_barrier(const XcdBarrier& b) {
    asm volatile("s_waitcnt vmcnt(0)" ::: "memory");
    __syncthreads();
    if (fresh_tid() == 0) {
        unsigned* bar = b.bar;
        __builtin_amdgcn_s_waitcnt(0);
        unsigned nloc = b.st[0], nx = b.st[1];
        if (nloc == 0u) { xcd_barrier_complete(bar, b.x, nloc, nx); b.st[0] = nloc; b.st[1] = nx; }
        const unsigned old = xb_add(&bar[XB_XSUB(b.x)], 1u);
        const unsigned gen = old / nloc;
        if (old + 1u == (gen + 1u) * nloc) {
            __builtin_amdgcn_fence(__ATOMIC_RELEASE, "agent");
            asm volatile("s_waitcnt vmcnt(0)" ::: "memory");
            const unsigned og = xb_add(&bar[XB_TOP], 1u);
            const unsigned tg = og / nx;
            if (og + 1u == (tg + 1u) * nx) xb_add(&bar[XB_TOPGEN], 1u);
            else XB_SPIN(xb_ld(&bar[XB_TOPGEN]) == tg, bar);
            __builtin_amdgcn_fence(__ATOMIC_ACQUIRE, "agent");
            xb_add(&bar[XB_XGEN(b.x)], 1u);
            asm volatile("s_waitcnt vmcnt(0)" ::: "memory");
        } else {
            XB_SPIN(xb_ld(&bar[XB_XGEN(b.x)]) == gen, bar);
            __builtin_amdgcn_fence(__ATOMIC_ACQUIRE, "agent");
            asm volatile("s_waitcnt vmcnt(0)" ::: "memory");
        }
    }
    __syncthreads();
}

namespace pg8 {
constexpr int BM = 256, BK = 64, HALF = 128, HTB = HALF * BK * 2, STAGE_BYTES = 8 * HTB, NXCD = 8, WGM = 8;
__host__ __device__ __forceinline__ int lds_byte(int r, int c) { const int st = (r >> 4) * 2 + (c >> 5), rr = r & 15, cc = c & 31, ob = rr * 64 + cc * 2; return st * 1024 + (ob ^ (((ob >> 9) & 1) << 5)); }
__host__ __device__ __forceinline__ void stage_rc(int b, int& R, int& C) { const int st = b / 1024, sb = b % 1024, swz = sb ^ (((sb >> 9) & 1) << 5); R = (st >> 1) * 16 + swz / 64; C = (st & 1) * 32 + (swz % 64) / 2; }
__host__ __device__ __forceinline__ int perm32(int rho) { const int n = rho >> 4, i = rho & 15; return 8 * (i >> 2) + 4 * n + (i & 3); }
struct Unit { int pm, pn; };
struct Gemm { const bf16_t* A; const bf16_t* Bt; int M, N, K; };

__device__ __forceinline__ void static_map(int L, int nM, int nN, int& pm, int& pn) {
    const int nwg = nM * nN; int wgid = L;
    { const int q = nwg / NXCD, r = nwg % NXCD, xcd = wgid % NXCD, off = wgid / NXCD; wgid = (xcd < r ? xcd * (q + 1) : r * (q + 1) + (xcd - r) * q) + off; }
    const int nig = WGM * nN, gid = wgid / nig, fm = gid * WGM, gsz = (nM - fm) < WGM ? (nM - fm) : WGM;
    pm = fm + ((wgid % nig) % gsz); pn = (wgid % nig) / gsz;
}
struct StaticOrder {
    int nM, nN, nwg, G, c;
    __device__ void init(int M, int N, int G_, int c_) { nM = M / BM; nN = N / BM; nwg = nM * nN; G = G_; c = c_; }
    __device__ bool next(int i, Unit& u) const { const long L = (long)i * G + c; if (L >= nwg) return false; static_map((int)L, nM, nN, u.pm, u.pn); return true; }
    __device__ __forceinline__ void a_ready(const Unit&) const {}
    __device__ __forceinline__ void done(const Unit&) const {}
};
struct BranchOrder {
    int G, c;
    __device__ bool next(int i, Unit& u) const { const long L = (long)(i >> 1) * G + c; if (L >= 512) return false; int pm, pn; static_map((int)L, 64, 8, pm, pn); const int g = i & 1; u.pm = g * 64 + pm; u.pn = g * 8 + pn; return true; }
    __device__ __forceinline__ void a_ready(const Unit&) const {}
    __device__ __forceinline__ void done(const Unit&) const {}
};
struct InFp8Order {
    int G, c;
    __device__ bool next(int i, Unit& u) const { long L; if (G != 256) L = (long)i * G + c; else if (i < 8) L = (long)i * G + c; else if (i == 8 && c >= G / 2) L = 8L * G + (c - G / 2); else return false; if (L >= 2176) return false; static_map((int)L, 64, 34, u.pm, u.pn); return true; }
    __device__ __forceinline__ void a_ready(const Unit&) const {}
    __device__ __forceinline__ void done(const Unit&) const {}
};
struct InBf16Order {
    int G, c;
    __device__ bool next(int i, Unit& u) const { long L; if (G != 256) L = (long)i * G + c; else if (i == 0) L = c; else if (i == 1 && c < G / 2) L = (long)G + c; else return false; if (L >= 384) return false; static_map((int)L, 64, 6, u.pm, u.pn); return true; }
    __device__ __forceinline__ void a_ready(const Unit&) const {}
    __device__ __forceinline__ void done(const Unit&) const {}
};
struct UpOrder {
    int G, c;
    __device__ bool next(int i, Unit& u) const { const long L = (long)i * G + c; if (L >= 2048) return false; const int rd = (int)L >> 8, cc = (int)L & 255, x = cc & 7, k = cc >> 3;
        const int e = 2 * rd + (x >> 2), pn0 = (x & 3) * 4 + (k >> 3), pm0 = k & 7; u.pm = e * 8 + pm0; u.pn = e * 16 + pn0; return true; }
    __device__ __forceinline__ void a_ready(const Unit&) const {}
    __device__ __forceinline__ void done(const Unit&) const {}
};
struct DownOrder {
    int G, c;
    __device__ bool next(int i, Unit& u) const { const long L = (long)i * G + c; if (L >= 1024) return false; const int rd = (int)L >> 8, cc = (int)L & 255, x = cc & 7, k = cc >> 3;
        const int e = 4 * rd + (x >> 1), pn0 = (x & 1) * 4 + (k >> 3), pm0 = k & 7; u.pm = e * 8 + pm0; u.pn = e * 8 + pn0; return true; }
    __device__ __forceinline__ void a_ready(const Unit&) const {}
    __device__ __forceinline__ void done(const Unit&) const {}
};

template <class Epi, class Sched, bool FP8 = false>
__device__ __forceinline__ void gemm_phase(LAS unsigned char* lds, const Gemm g, const Sched& S, const Epi& E) {
    const int tid = fresh_tid(), wid = __builtin_amdgcn_readfirstlane(tid >> 6), lane = tid & 63, wr = wid >> 2, wc = wid & 3, fr = lane & 15, fq = lane >> 4;
    const int K = g.K, nt = FP8 ? K / 128 : K / BK, pitch = FP8 ? K : 2 * K;
    unsigned voffA[2], voffB[2];
#pragma unroll
    for (int i = 0; i < 2; ++i) { int R, C; stage_rc(tid * 16 + i * 8192, R, C); const int Rb = Epi::PERM ? ((R & ~31) + perm32(R & 31)) : R; voffA[i] = (unsigned)(R * pitch + C * 2); voffB[i] = (unsigned)(Rb * pitch + C * 2); }
    const size_t kstep = (size_t)(BK * 2);
    const size_t hstep = (size_t)HALF * pitch;
    const size_t tstep = 2 * hstep;
    const unsigned ldsw = (unsigned)wid * 1024u;
    const int aoff = lds_byte(wr * 64 + fr, fq * 8), boff = lds_byte(wc * 32 + fr, fq * 8);
#define PG8_SA(b, h) (((b) * 2 + (h)) * HTB)
#define PG8_SB(b, h) ((4 + (b) * 2 + (h)) * HTB)
#define PG8_STAGE(bufoff, gbase, voff) do { _Pragma("unroll") for (int _i = 0; _i < 2; ++_i) \
        __builtin_amdgcn_global_load_lds((const unsigned*)((const char*)(gbase) + (voff)[_i]), (LAS unsigned*)(lds + (bufoff) + ldsw + _i * 8192), 16, 0, 0); } while (0)
#define PG8_RD8(addr) __builtin_shufflevector(*(const LAS i32x4*)(addr), *(const LAS i32x4*)((addr) + 1024), 0, 1, 2, 3, 4, 5, 6, 7)
#define PG8_LDA(dst, b, h) do { _Pragma("unroll") for (int m = 0; m < 4; ++m) { if constexpr (FP8) dst##8[m] = PG8_RD8(lds + PG8_SA(b, h) + aoff + m * 2048); \
        else { _Pragma("unroll") for (int k = 0; k < 2; ++k) dst[m][k] = *(const LAS bf16x8*)(lds + PG8_SA(b, h) + aoff + m * 2048 + k * 1024); } } } while (0)
#define PG8_LDB(dst, b, h) do { _Pragma("unroll") for (int n = 0; n < 2; ++n) { if constexpr (FP8) dst##8[n] = PG8_RD8(lds + PG8_SB(b, h) + boff + n * 2048); \
        else { _Pragma("unroll") for (int k = 0; k < 2; ++k) dst[n][k] = *(const LAS bf16x8*)(lds + PG8_SB(b, h) + boff + n * 2048 + k * 1024); } } } while (0)
#define PG8_CAT(v) __builtin_shufflevector(__builtin_bit_cast(i32x4, v[0]), __builtin_bit_cast(i32x4, v[1]), 0, 1, 2, 3, 4, 5, 6, 7)
#define PG8_MMA(ai, bj, At, Bt) do { __builtin_amdgcn_s_setprio(1); _Pragma("unroll") for (int m = 0; m < 4; ++m) _Pragma("unroll") for (int n = 0; n < 2; ++n) { \
        if constexpr (FP8) asm volatile("v_mfma_f32_16x16x128_f8f6f4 %0, %1, %2, %0" : "+v"(acc[ai][bj][m][n]) : "v"(Bt##8[n]), "v"(At##8[m]));   \
        else { _Pragma("unroll") for (int k = 0; k < 2; ++k) acc[ai][bj][m][n] = __builtin_amdgcn_mfma_f32_16x16x32_bf16(Bt[n][k], At[m][k], acc[ai][bj][m][n], 0, 0, 0); } } \
        __builtin_amdgcn_s_setprio(0); } while (0)
#define PG8_WAIT_V(n) asm volatile("s_waitcnt vmcnt(" #n ")" ::: "memory")
#define PG8_WAIT_L(n) asm volatile("s_waitcnt lgkmcnt(" #n ")" ::: "memory")
#define PG8_BAR __builtin_amdgcn_s_barrier()
#define PG8_SCHED __builtin_amdgcn_sched_barrier(0)
    Unit cur, nxt; int ui = 0;
    if (!S.next(0, cur)) return;
    f32x4 acc[2][2][4][2];
#pragma unroll
    for (int a = 0; a < 2; ++a)
#pragma unroll
        for (int b = 0; b < 2; ++b)
#pragma unroll
            for (int m = 0; m < 4; ++m)
#pragma unroll
                for (int n = 0; n < 2; ++n) acc[a][b][m][n] = (f32x4){0.f, 0.f, 0.f, 0.f};
    bf16x8 At[4][2], B0[2][2], B1[2][2]; i32x8 At8[4], B08[2], B18[2];
    const char* cA = (const char*)g.A + (size_t)cur.pm * tstep; const char* cB = (const char*)g.Bt + (size_t)cur.pn * tstep;
    S.a_ready(cur);
    PG8_STAGE(PG8_SB(0, 0), cB, voffB); PG8_STAGE(PG8_SA(0, 0), cA, voffA); PG8_STAGE(PG8_SB(0, 1), cB + hstep, voffB); PG8_STAGE(PG8_SA(0, 1), cA + hstep, voffA);
    if (wr == 1) PG8_BAR;
    PG8_WAIT_V(4); PG8_BAR;
    PG8_STAGE(PG8_SB(1, 0), cB + kstep, voffB); PG8_STAGE(PG8_SA(1, 0), cA + kstep, voffA); PG8_STAGE(PG8_SB(1, 1), cB + hstep + kstep, voffB);
    PG8_WAIT_V(6); PG8_BAR;
    for (;;) {
        const bool has_next = S.next(ui + 1, nxt);
        const char* nA = has_next ? (const char*)g.A + (size_t)nxt.pm * tstep : cA; const char* nB = has_next ? (const char*)g.Bt + (size_t)nxt.pn * tstep : cB;
        for (int t = 0; t < nt; t += 2) {
            const bool last = (t == nt - 2);
            const char* a1 = cA + (size_t)(t + 1) * kstep;
            const char* a2 = last ? nA : cA + (size_t)(t + 2) * kstep; const char* b2 = last ? nB : cB + (size_t)(t + 2) * kstep;
            const char* a3 = a2 + kstep; const char* b3 = b2 + kstep;
            if (last && has_next) S.a_ready(nxt);
            if constexpr (Epi::MID_T > 0) { if (t == Epi::MID_T) { PG8_SCHED; E.mid(acc, cur, wr, wc, fr, fq); PG8_SCHED; } }
            PG8_LDB(B0, 0, 0); PG8_SCHED; PG8_LDA(At, 0, 0); PG8_STAGE(PG8_SA(1, 1), a1 + hstep, voffA);
            PG8_WAIT_L(8); PG8_BAR; PG8_WAIT_L(0); PG8_MMA(0, 0, At, B0); PG8_BAR; PG8_SCHED;
            PG8_LDB(B1, 0, 1); PG8_STAGE(PG8_SB(0, 0), b2, voffB);
            PG8_BAR; PG8_WAIT_L(0); PG8_MMA(0, 1, At, B1); PG8_BAR;
            PG8_LDA(At, 0, 1); PG8_STAGE(PG8_SA(0, 0), a2, voffA);
            PG8_BAR; PG8_WAIT_L(0); PG8_MMA(1, 0, At, B0); PG8_BAR; PG8_SCHED;
            PG8_STAGE(PG8_SB(0, 1), b2 + hstep, voffB);
            PG8_WAIT_V(6); PG8_BAR; PG8_MMA(1, 1, At, B1); PG8_BAR;
            PG8_LDB(B0, 1, 0); PG8_SCHED; PG8_LDA(At, 1, 0); PG8_STAGE(PG8_SA(0, 1), a2 + hstep, voffA);
            PG8_WAIT_L(8); PG8_BAR; PG8_WAIT_L(0); PG8_MMA(0, 0, At, B0); PG8_BAR; PG8_SCHED;
            PG8_LDB(B1, 1, 1); PG8_STAGE(PG8_SB(1, 0), b3, voffB);
            PG8_BAR; PG8_WAIT_L(0); PG8_MMA(0, 1, At, B1); PG8_BAR;
            PG8_LDA(At, 1, 1); PG8_STAGE(PG8_SA(1, 0), a3, voffA);
            PG8_BAR; PG8_WAIT_L(0); PG8_MMA(1, 0, At, B0); PG8_BAR; PG8_SCHED;
            PG8_STAGE(PG8_SB(1, 1), b3 + hstep, voffB);
            PG8_WAIT_V(6); PG8_BAR; PG8_MMA(1, 1, At, B1); PG8_BAR;
        }
        if constexpr (FP8) {
            asm volatile("s_nop 15\n\ts_nop 15\n\ts_nop 15" ::: "memory");
#pragma unroll
            for (int a = 0; a < 2; ++a)
#pragma unroll
                for (int b = 0; b < 2; ++b)
#pragma unroll
                    for (int m = 0; m < 4; ++m)
#pragma unroll
                        for (int n = 0; n < 2; ++n) asm volatile("" : "+v"(acc[a][b][m][n]));
        }
        E(acc, cur, wr, wc, fr, fq); S.done(cur);
        if (!has_next) break;
#pragma unroll
        for (int a = 0; a < 2; ++a)
#pragma unroll
            for (int b = 0; b < 2; ++b)
#pragma unroll
                for (int m = 0; m < 4; ++m)
#pragma unroll
                    for (int n = 0; n < 2; ++n) acc[a][b][m][n] = (f32x4){0.f, 0.f, 0.f, 0.f};
        cur = nxt; cA = nA; cB = nB; ++ui;
    }
    PG8_WAIT_V(0);
    if (wr == 0) PG8_BAR;
    PG8_BAR;
#undef PG8_SA
#undef PG8_SB
#undef PG8_STAGE
#undef PG8_LDA
#undef PG8_RD8
#undef PG8_LDB
#undef PG8_MMA
#undef PG8_CAT
#undef PG8_WAIT_V
#undef PG8_WAIT_L
#undef PG8_BAR
#undef PG8_SCHED
}

__device__ __forceinline__ void st_bf16x4(bf16_t* p, f32x4 v) { u32x2 w; w.x = cvt_pk_bf16(v[0], v[1]); w.y = cvt_pk_bf16(v[2], v[3]); *(u32x2*)p = w; }
__device__ __forceinline__ f32x4 ld_bf16x4(const bf16_t* p) { const u32x2 w = *(const u32x2*)p; return (f32x4){bf_lo(w.x), bf_hi(w.x), bf_lo(w.y), bf_hi(w.y)}; }

__device__ __forceinline__ size_t gf_off(int tile, int wid, int ai, int m, int bj, int lane) { return (size_t)tile * 131072 + wid * 16384 + (ai * 4 + m) * 2048 + bj * 1024 + lane * 16; }
struct EpiZ {
    static constexpr int MID_T = 0; static constexpr bool PERM = true;
    bf16_t* Z; const float* cosA; const float* sinA; const float* cosB; const float* sinB; int pn_off; float sc;
    __device__ __forceinline__ void operator()(const f32x4 (&acc)[2][2][4][2], const Unit& u, int wr, int wc, int fr, int fq) const {
        asm volatile("" : "+v"(fr), "+v"(fq));
        const int pn = u.pn + pn_off;
        const int type = pn < 12 ? 1 : pn < 18 ? 0 : pn < 22 ? 2 : 0;
        const int row0 = u.pm * BM + wr * 64 + fr, col0 = pn * BM + wc * 32 + 8 * fq;
#pragma unroll
        for (int ai = 0; ai < 2; ++ai)
#pragma unroll
            for (int m = 0; m < 4; ++m) {
                const int row = row0 + ai * HALF + m * 16, pos = row & (SEQ - 1);
                f32x4 c0 = {1.f, 1.f, 1.f, 1.f}, s0 = {0.f, 0.f, 0.f, 0.f}, c1 = c0, s1 = s0;
                if (type == 1 && wc == 0) { const float* cp = cosA + pos * 16 + 8 * (fq & 1); const float* sp = sinA + pos * 16 + 8 * (fq & 1);
                    c0 = *(const f32x4*)cp; c1 = *(const f32x4*)(cp + 4); s0 = *(const f32x4*)sp; s1 = *(const f32x4*)(sp + 4); }
                if (type == 2 && (wc & 1) == 0) { const float* cp = cosB + pos * 8; const float* sp = sinB + pos * 8;
                    c0 = *(const f32x4*)cp; c1 = *(const f32x4*)(cp + 4); s0 = *(const f32x4*)sp; s1 = *(const f32x4*)(sp + 4); }
                bf16_t* rowp = Z + (size_t)row * ZC + col0;
#pragma unroll
                for (int bj = 0; bj < 2; ++bj) {
                    f32x4 v0 = acc[ai][bj][m][0] * sc, v1 = acc[ai][bj][m][1] * sc;
                    if (type == 1 && wc == 0) {
                        f32x4 p0, p1;
#pragma unroll
                        for (int j = 0; j < 4; ++j) { p0[j] = __shfl_xor(v0[j], 32); p1[j] = __shfl_xor(v1[j], 32); }
                        if (fq < 2) { v0 = v0 * c0 - p0 * s0; v1 = v1 * c1 - p1 * s1; } else { v0 = v0 * c0 + p0 * s0; v1 = v1 * c1 + p1 * s1; }
                    }
                    if (type == 2 && (wc & 1) == 0) {
                        f32x4 p0, p1;
#pragma unroll
                        for (int j = 0; j < 4; ++j) { p0[j] = swz_xor<16>(v0[j]); p1[j] = swz_xor<16>(v1[j]); }
                        if (fq == 0) { v0 = v0 * c0 - p0 * s0; v1 = v1 * c1 - p1 * s1; } else if (fq == 1) { v0 = v0 * c0 + p0 * s0; v1 = v1 * c1 + p1 * s1; }
                    }
                    u32x4 w; w.x = cvt_pk_bf16(v0[0], v0[1]); w.y = cvt_pk_bf16(v0[2], v0[3]); w.z = cvt_pk_bf16(v1[0], v1[1]); w.w = cvt_pk_bf16(v1[2], v1[3]);
                    *(u32x4*)(rowp + bj * HALF) = w;
                }
            }
    }
};
struct EpiGate {
    static constexpr int MID_T = 0; static constexpr bool PERM = true;
    unsigned char* GF;
    __device__ __forceinline__ void operator()(const f32x4 (&acc)[2][2][4][2], const Unit& u, int wr, int wc, int fr, int fq) const {
        asm volatile("" : "+v"(fr), "+v"(fq));
        const int tile = ((u.pn >> 3) * 64 + u.pm) * 8 + (u.pn & 7), wid = wr * 4 + wc, lane = fq * 16 + fr;
        constexpr float SC = -1.f / (SX8 * SWG8);
#pragma unroll
        for (int ai = 0; ai < 2; ++ai)
#pragma unroll
            for (int m = 0; m < 4; ++m)
#pragma unroll
                for (int bj = 0; bj < 2; ++bj) {
                    f32x4 v0 = acc[ai][bj][m][0], v1 = acc[ai][bj][m][1];
#pragma unroll
                    for (int j = 0; j < 4; ++j) { v0[j] = __builtin_amdgcn_rcpf(1.f + __expf(v0[j] * SC)); v1[j] = __builtin_amdgcn_rcpf(1.f + __expf(v1[j] * SC)); }
                    u32x4 w; w.x = cvt_pk_bf16(v0[0], v0[1]); w.y = cvt_pk_bf16(v0[2], v0[3]); w.z = cvt_pk_bf16(v1[0], v1[1]); w.w = cvt_pk_bf16(v1[2], v1[3]);
                    *(u32x4*)(GF + gf_off(tile, wid, ai, m, bj, lane)) = w;
                }
    }
};
struct EpiInFp8 {
    static constexpr int MID_T = 0; static constexpr bool PERM = true;
    EpiZ z; EpiGate g;
    __device__ __forceinline__ void operator()(const f32x4 (&acc)[2][2][4][2], const Unit& u, int wr, int wc, int fr, int fq) const {
        if (u.pn < 18) z(acc, u, wr, wc, fr, fq);
        else { Unit u2; u2.pm = u.pm; u2.pn = u.pn - 18; g(acc, u2, wr, wc, fr, fq); }
    }
};
struct EpiBranch {
    static constexpr int MID_T = 8; static constexpr bool PERM = true;
    bf16_t* merged; const unsigned char* GF;
    __device__ __forceinline__ void mid(f32x4 (&acc)[2][2][4][2], const Unit& u, int wr, int wc, int fr, int fq) const {
        asm volatile("" : "+v"(fr), "+v"(fq));
        const int t0 = u.pm * 8 + u.pn, wid = wr * 4 + wc, lane = fq * 16 + fr;
#pragma unroll
        for (int ai = 0; ai < 2; ++ai) {
#pragma unroll
            for (int m = 0; m < 4; ++m)
#pragma unroll
                for (int bj = 0; bj < 2; ++bj) {
                    const u32x4 a = *(const u32x4*)(GF + gf_off(t0, wid, ai, m, bj, lane)), b = *(const u32x4*)(GF + gf_off(512 + t0, wid, ai, m, bj, lane));
                    const f32x4 g00 = {bf_lo(a.x), bf_hi(a.x), bf_lo(a.y), bf_hi(a.y)}, g01 = {bf_lo(a.z), bf_hi(a.z), bf_lo(a.w), bf_hi(a.w)};
                    const f32x4 g10 = {bf_lo(b.x), bf_hi(b.x), bf_lo(b.y), bf_hi(b.y)}, g11 = {bf_lo(b.z), bf_hi(b.z), bf_lo(b.w), bf_hi(b.w)};
#pragma unroll
                    for (int j = 0; j < 4; ++j) { acc[ai][bj][m][0][j] *= g00[j] * __builtin_amdgcn_rcpf(g10[j]); acc[ai][bj][m][1][j] *= g01[j] * __builtin_amdgcn_rcpf(g11[j]); }
                }
            asm volatile("" ::: "memory");
        }
    }
    __device__ __forceinline__ void operator()(const f32x4 (&acc)[2][2][4][2], const Unit& u, int wr, int wc, int fr, int fq) const {
        asm volatile("" : "+v"(fr), "+v"(fq));
        const int t1 = 512 + u.pm * 8 + u.pn, wid = wr * 4 + wc, lane = fq * 16 + fr;
        const int row0 = u.pm * BM + wr * 64 + fr, col0 = u.pn * BM + wc * 32 + 8 * fq;
#pragma unroll
        for (int ai = 0; ai < 2; ++ai)
#pragma unroll
            for (int m = 0; m < 4; ++m) {
                bf16_t* mp = merged + (size_t)(row0 + ai * HALF + m * 16) * DM + col0;
#pragma unroll
                for (int bj = 0; bj < 2; ++bj) {
                    const u32x4 b = *(const u32x4*)(GF + gf_off(t1, wid, ai, m, bj, lane));
                    const f32x4 g10 = {bf_lo(b.x), bf_hi(b.x), bf_lo(b.y), bf_hi(b.y)}, g11 = {bf_lo(b.z), bf_hi(b.z), bf_lo(b.w), bf_hi(b.w)};
                    const f32x4 y0 = acc[ai][bj][m][0] * g10, y1 = acc[ai][bj][m][1] * g11;
                    u32x4 w; w.x = cvt_pk_bf16(y0[0], y0[1]); w.y = cvt_pk_bf16(y0[2], y0[3]); w.z = cvt_pk_bf16(y1[0], y1[1]); w.w = cvt_pk_bf16(y1[2], y1[3]);
                    *(u32x4*)(mp + bj * HALF) = w;
                }
            }
    }
};
struct EpiOut {
    static constexpr int MID_T = 0; static constexpr bool PERM = true;
    bf16_t* MIX;
    __device__ __forceinline__ void operator()(const f32x4 (&acc)[2][2][4][2], const Unit& u, int wr, int wc, int fr, int fq) const {
        asm volatile("" : "+v"(fr), "+v"(fq));
        const int row0 = u.pm * BM + wr * 64 + fr, col0 = u.pn * BM + wc * 32 + 8 * fq;
#pragma unroll
        for (int ai = 0; ai < 2; ++ai)
#pragma unroll
            for (int m = 0; m < 4; ++m) {
                bf16_t* rowp = MIX + (size_t)(row0 + ai * HALF + m * 16) * DM + col0;
#pragma unroll
                for (int bj = 0; bj < 2; ++bj) { const f32x4 y0 = acc[ai][bj][m][0], y1 = acc[ai][bj][m][1];
                    u32x4 w; w.x = cvt_pk_bf16(y0[0], y0[1]); w.y = cvt_pk_bf16(y0[2], y0[3]); w.z = cvt_pk_bf16(y1[0], y1[1]); w.w = cvt_pk_bf16(y1[2], y1[3]);
                    *(u32x4*)(rowp + bj * HALF) = w; }
            }
    }
};
struct EpiUp {
    static constexpr int MID_T = 0; static constexpr bool PERM = true;
    unsigned char* H8;
    __device__ __forceinline__ void operator()(const f32x4 (&acc)[2][2][4][2], const Unit& u, int wr, int wc, int fr, int fq) const {
        asm volatile("" : "+v"(fr), "+v"(fq));
        const int pn0 = u.pn & 15;
        const int row0 = u.pm * BM + wr * 64 + fr, col0 = pn0 * HALF + wc * 32 + 8 * fq;
        constexpr float SC = 1.f / (SX8 * SW8);
#pragma unroll
        for (int ai = 0; ai < 2; ++ai)
#pragma unroll
            for (int m = 0; m < 4; ++m) {
                unsigned char* rowp = H8 + (size_t)(row0 + ai * HALF + m * 16) * DM + col0;
                u32x2 w8;
#pragma unroll
                for (int n = 0; n < 2; ++n) {
                    const f32x4 gt = acc[ai][0][m][n] * SC, up = acc[ai][1][m][n] * (SC * SH8); f32x4 h;
#pragma unroll
                    for (int j = 0; j < 4; ++j) h[j] = gt[j] * __builtin_amdgcn_rcpf(1.f + __expf(-gt[j])) * up[j];
                    w8[n] = cvt_pk4_fp8(h[0], h[1], h[2], h[3]);
                }
                *(u32x2*)rowp = w8;
            }
    }
};
struct EpiDown {
    static constexpr int MID_T = 0; static constexpr bool PERM = true;
    bf16_t* YS; const float* gate;
    __device__ __forceinline__ void operator()(const f32x4 (&acc)[2][2][4][2], const Unit& u, int wr, int wc, int fr, int fq) const {
        asm volatile("" : "+v"(fr), "+v"(fq));
        const int pn0 = u.pn & 7;
        const int row0 = u.pm * BM + wr * 64 + fr, col0 = pn0 * BM + wc * 32 + 8 * fq;
#pragma unroll
        for (int ai = 0; ai < 2; ++ai)
#pragma unroll
            for (int m = 0; m < 4; ++m) {
                const int row = row0 + ai * HALF + m * 16; const float gt = gate[row] * (1.f / (SH8 * SW8));
                bf16_t* rowp = YS + (size_t)row * DM + col0;
#pragma unroll
                for (int bj = 0; bj < 2; ++bj) { const f32x4 y0 = acc[ai][bj][m][0] * gt, y1 = acc[ai][bj][m][1] * gt;
                    u32x4 w; w.x = cvt_pk_bf16(y0[0], y0[1]); w.y = cvt_pk_bf16(y0[2], y0[3]); w.z = cvt_pk_bf16(y1[0], y1[1]); w.w = cvt_pk_bf16(y1[2], y1[3]);
                    *(u32x4*)(rowp + bj * HALF) = w; }
            }
    }
};
}


struct BgConv { const float* w0; const float* w1; const float* w2; unsigned char* WGUT; unsigned char* WDT; int NGW; int pad; };
struct BgState { int it, pend, par, tick; };
constexpr int BG_ITEMS = 3 * 65536;
__device__ __forceinline__ void bg_decode(const BgConv bg, int it, const float*& src, unsigned char*& dst) {
    const int mat = it >> 16, r = it & 65535, e = r >> 12, r2 = r & 4095, kb = r2 >> 6, nb = r2 & 63, k0 = 32 * kb, n0 = 32 * nb;
    src = (mat == 0 ? bg.w0 : mat == 1 ? bg.w1 : bg.w2) + ((size_t)e * DM + k0) * DM + n0;
    if (mat == 2) dst = bg.WDT + ((size_t)e * DM + n0) * DM + k0;
    else dst = bg.WGUT + ((size_t)e * 4096 + (n0 >> 7) * 256 + mat * 128 + (n0 & 127)) * DM + k0;
}
template <bool WAIT = true> __device__ __forceinline__ void bg_finish(const BgConv bg, int& pend, int par, LAS unsigned char* scr, int lane) {
    if (pend < 0) return;
    const float* src; unsigned char* dst; bg_decode(bg, pend, src, dst);
    if (WAIT) asm volatile("s_waitcnt vmcnt(0)" ::: "memory");
    const int c = lane & 1, n = lane >> 1;
    const LAS float* s0 = (const LAS float*)(scr + (2 * c) * 1056) + n;
    const LAS float* s1 = (const LAS float*)(scr + (2 * c + 1) * 1056) + n;
    u32x4 o;
    o.x = cvt_pk4_fp8(s0[0 * 32] * SW8, s0[1 * 32] * SW8, s0[2 * 32] * SW8, s0[3 * 32] * SW8); o.y = cvt_pk4_fp8(s0[4 * 32] * SW8, s0[5 * 32] * SW8, s0[6 * 32] * SW8, s0[7 * 32] * SW8);
    o.z = cvt_pk4_fp8(s1[0 * 32] * SW8, s1[1 * 32] * SW8, s1[2 * 32] * SW8, s1[3 * 32] * SW8); o.w = cvt_pk4_fp8(s1[4 * 32] * SW8, s1[5 * 32] * SW8, s1[6 * 32] * SW8, s1[7 * 32] * SW8);
    *(u32x4*)(dst + (size_t)n * DM + 16 * c) = o;
    LDS_WAIT();
    pend = -1;
}
__device__ __forceinline__ void bg_issue(const BgConv bg, int& it, int& pend, int& par, LAS unsigned char* scr, int lane) {
    if (it >= BG_ITEMS) return;
    const float* src; unsigned char* dst; bg_decode(bg, it, src, dst);
    par ^= 1;
    const float* lp = src + (size_t)(lane >> 3) * DM + (lane & 7) * 4;
#pragma unroll
    for (int i = 0; i < 4; ++i) __builtin_amdgcn_global_load_lds((const unsigned*)(lp + (size_t)(8 * i) * DM), (LAS unsigned*)(scr + i * 1056), 16, 0, 0);
    pend = it; it += bg.NGW;
}

namespace att {
#define KSWZ128(row, colB) ((row) * 256 + ((colB) ^ (((row) & 7) << 4)))
#define KSWZ64(row, colB) ((row) * 128 + ((colB) ^ (((row) & 7) << 4)))
#define SBAR() __builtin_amdgcn_sched_barrier(0)
__device__ __forceinline__ int crow(int r, int hi) { return (r & 3) + 8 * (r >> 2) + 4 * hi; }
__device__ __forceinline__ int v_st(int k, int c) { const int kk = (k & ~0xC) | ((k & 4) << 1) | ((k & 8) >> 1); return ((kk >> 3) * 4 + (c >> 5)) * 512 + ((kk & 7) * 32 + (c & 31)) * 2; }
__device__ __forceinline__ int v_rd_base(int lane) { return ((lane & 3) << 3) | (((lane >> 2) & 3) << 6) | (((lane >> 4) & 1) << 5) | (((lane >> 5) & 1) << 8); }
constexpr int v_rd_off(int d0, int ks, int half) { return d0 * 512 + ks * 4096 + half * 2048; }
template <int OFF> __device__ __forceinline__ s16x4 tr_read(int vb) { s16x4 r; asm volatile("ds_read_b64_tr_b16 %0, %1 offset:%2" : "=&v"(r) : "v"(vb), "i"(OFF) : "memory"); return r; }
template <int D0> __device__ __forceinline__ void pv_one(f32x16& od, int vb, bf16x8 pa0, bf16x8 pa1, bf16x8 pa2, bf16x8 pa3) {
    const s16x4 l0 = tr_read<v_rd_off(D0, 0, 0)>(vb), h0 = tr_read<v_rd_off(D0, 0, 1)>(vb), l1 = tr_read<v_rd_off(D0, 1, 0)>(vb), h1 = tr_read<v_rd_off(D0, 1, 1)>(vb);
    const s16x4 l2 = tr_read<v_rd_off(D0, 2, 0)>(vb), h2 = tr_read<v_rd_off(D0, 2, 1)>(vb), l3 = tr_read<v_rd_off(D0, 3, 0)>(vb), h3 = tr_read<v_rd_off(D0, 3, 1)>(vb);
    asm volatile("s_waitcnt lgkmcnt(0)" ::: "memory"); SBAR();
#define PK(L, H) (bf16x8){L[0], L[1], L[2], L[3], H[0], H[1], H[2], H[3]}
    od = __builtin_amdgcn_mfma_f32_32x32x16_bf16(pa0, PK(l0, h0), od, 0, 0, 0);
    od = __builtin_amdgcn_mfma_f32_32x32x16_bf16(pa1, PK(l1, h1), od, 0, 0, 0);
    od = __builtin_amdgcn_mfma_f32_32x32x16_bf16(pa2, PK(l2, h2), od, 0, 0, 0);
    od = __builtin_amdgcn_mfma_f32_32x32x16_bf16(pa3, PK(l3, h3), od, 0, 0, 0);
#undef PK
}

template <int DQK, bool BAND>
__device__ __forceinline__ void attn_pass(const bf16_t* __restrict__ Qw, const bf16_t* __restrict__ Kb, const bf16_t* __restrict__ Vb, size_t kvs,
                                          int ntiles, int key0, int L, int qpos, int t_lo, int t_hi, LAS char* lds, f32x16 (&o)[4], float& m_reg, float& l_reg, const BgConv bg, BgState& bs) {
    constexpr float SCALE = DQK == 128 ? 0.08838834764831845f : 0.125f;
    constexpr float C = SCALE * 1.4426950408889634f;
    constexpr float THR = 8.f;
    constexpr int ND0 = DQK / 16;
    const int tid = fresh_tid(), wid = __builtin_amdgcn_readfirstlane(tid >> 6), lane = tid & 63, r32 = lane & 31, hi = lane >> 5;
    LAS char* V_lds = lds; LAS char* K_lds = lds + 32768;
    LAS float* al_l = (LAS float*)(lds + 65536) + wid * 64;
    LAS unsigned char* bgscr = (LAS unsigned char*)lds + LDS_BG + wid * LDS_BGW;
    bf16x8 qr[ND0];
#pragma unroll
    for (int d0 = 0; d0 < ND0; ++d0) qr[d0] = *(const bf16x8*)(Qw + d0 * 16);
    const int sr = tid >> 4, sc = (tid & 15) * 8, vst0 = v_st(sr, sc), vst1 = v_st(32 + sr, sc);
    const int kr64 = tid >> 3, kc64 = (tid & 7) * 8;
    const int vb0 = (int)(unsigned)(size_t)V_lds + v_rd_base(lane);
    bf16x8 vs0, vs1, ks0, ks1;
#define KPOS(j, row) ({ int _p = key0 + 64 * (j) + (row); if (BAND) { _p = _p < 0 ? 0 : (_p >= L ? L - 1 : _p); } (size_t)_p; })
#define SLOAD(j) do { const size_t _p0 = KPOS(j, sr) * kvs, _p1 = KPOS(j, 32 + sr) * kvs; \
        vs0 = *(const bf16x8*)(Vb + _p0 + sc); vs1 = *(const bf16x8*)(Vb + _p1 + sc); \
        if (DQK == 128) { ks0 = *(const bf16x8*)(Kb + _p0 + sc); ks1 = *(const bf16x8*)(Kb + _p1 + sc); } \
        else { ks0 = *(const bf16x8*)(Kb + KPOS(j, kr64) * kvs + kc64); } } while (0)
#define SWRITE(b) do { *(LAS bf16x8*)(V_lds + (b) * 16384 + vst0) = vs0; *(LAS bf16x8*)(V_lds + (b) * 16384 + vst1) = vs1; \
        if (DQK == 128) { *(LAS bf16x8*)(K_lds + (b) * 16384 + KSWZ128(sr, sc * 2)) = ks0; *(LAS bf16x8*)(K_lds + (b) * 16384 + KSWZ128(32 + sr, sc * 2)) = ks1; } \
        else { *(LAS bf16x8*)(K_lds + (b) * 16384 + KSWZ64(kr64, kc64 * 2)) = ks0; } } while (0)
    __syncthreads();
    SLOAD(0); SWRITE(0);
    for (int j = 0; j < ntiles; ++j) {
        __syncthreads();
        constexpr bool SHADOW = (DQK == 64);
        if (SHADOW) { if (bs.pend >= 0) asm volatile("s_waitcnt vmcnt(0)" ::: "memory"); }
        else bg_finish<true>(bg, bs.pend, bs.par, bgscr, lane);
        if (j + 1 < ntiles) SLOAD(j + 1);
#define BG_STEP() do { bg_finish<false>(bg, bs.pend, bs.par, bgscr, lane); if (bs.tick != 2) bg_issue(bg, bs.it, bs.pend, bs.par, bgscr, lane); bs.tick = bs.tick == 2 ? 0 : bs.tick + 1; } while (0)
        if (!SHADOW || (BAND && !(j >= t_lo && j <= t_hi))) BG_STEP();
        if (!BAND || (j >= t_lo && j <= t_hi)) {
            const LAS char* Kt = K_lds + (j & 1) * 16384;
            f32x16 p0 = {}, p1 = {};
#pragma unroll
            for (int d0 = 0; d0 < ND0; ++d0) { const int cb = (d0 * 16 + hi * 8) * 2;
                const bf16x8 b0 = *(const LAS bf16x8*)(Kt + (DQK == 128 ? KSWZ128(r32, cb) : KSWZ64(r32, cb)));
                const bf16x8 b1 = *(const LAS bf16x8*)(Kt + (DQK == 128 ? KSWZ128(32 + r32, cb) : KSWZ64(32 + r32, cb)));
                p0 = __builtin_amdgcn_mfma_f32_32x32x16_bf16(b0, qr[d0], p0, 0, 0, 0);
                p1 = __builtin_amdgcn_mfma_f32_32x32x16_bf16(b1, qr[d0], p1, 0, 0, 0); }
            if (SHADOW) { SBAR(); BG_STEP(); SBAR(); }
            unsigned vmask = 0xffffffffu;
            if (BAND) { vmask = 0u; const int kb = key0 + 64 * j;
#pragma unroll
                for (int r = 0; r < 16; ++r) { const int k0p = kb + crow(r, hi), k1p = k0p + 32; const int d0p = qpos - k0p, d1p = qpos - k1p;
                    const bool v0 = (d0p <= 64) && (d0p >= -64) && (k0p >= 0) && (k0p < L), v1 = (d1p <= 64) && (d1p >= -64) && (k1p >= 0) && (k1p < L);
                    vmask |= (v0 ? 1u : 0u) << r; vmask |= (v1 ? 1u : 0u) << (16 + r);
                    p0[r] = v0 ? p0[r] : -1e30f; p1[r] = v1 ? p1[r] : -1e30f; } }
            float pmax = p0[0];
#pragma unroll
            for (int r = 1; r < 16; ++r) pmax = fmaxf(pmax, p0[r]);
#pragma unroll
            for (int r = 0; r < 16; ++r) pmax = fmaxf(pmax, p1[r]);
            { auto rr = __builtin_amdgcn_permlane32_swap(__float_as_uint(pmax), __float_as_uint(pmax), false, false); pmax = fmaxf(__uint_as_float(rr[0]), __uint_as_float(rr[1])); }
            float mn, alpha;
            if (__all(pmax - m_reg <= THR / SCALE)) { mn = m_reg; alpha = 1.f; }
            else { mn = fmaxf(m_reg, pmax); alpha = __builtin_amdgcn_exp2f((m_reg - mn) * C); m_reg = mn; }
            const float mnC = -mn * C;
#pragma unroll
            for (int r = 0; r < 16; ++r) { p0[r] = __builtin_amdgcn_exp2f(fmaf(p0[r], C, mnC)); p1[r] = __builtin_amdgcn_exp2f(fmaf(p1[r], C, mnC)); }
            if (BAND) {
#pragma unroll
                for (int r = 0; r < 16; ++r) { p0[r] = ((vmask >> r) & 1u) ? p0[r] : 0.f; p1[r] = ((vmask >> (16 + r)) & 1u) ? p1[r] : 0.f; } }
            float ps = 0.f;
#pragma unroll
            for (int r = 0; r < 16; ++r) ps += p0[r];
#pragma unroll
            for (int r = 0; r < 16; ++r) ps += p1[r];
            { auto rr = __builtin_amdgcn_permlane32_swap(__float_as_uint(ps), __float_as_uint(ps), false, false); ps = __uint_as_float(rr[0]) + __uint_as_float(rr[1]); }
            l_reg = l_reg * alpha + ps;
            bf16x8 pa0, pa1, pa2, pa3;
#define PK4(P, BASE, OUT) do { unsigned a0 = cvt_pk_bf16(P[BASE + 0], P[BASE + 1]), a1 = cvt_pk_bf16(P[BASE + 2], P[BASE + 3]); \
        unsigned b0 = cvt_pk_bf16(P[BASE + 4], P[BASE + 5]), b1 = cvt_pk_bf16(P[BASE + 6], P[BASE + 7]); \
        auto r0 = __builtin_amdgcn_permlane32_swap(a0, b0, false, false); auto r1 = __builtin_amdgcn_permlane32_swap(a1, b1, false, false); \
        u32x4 w = {r0[0], r1[0], r0[1], r1[1]}; OUT = *reinterpret_cast<bf16x8*>(&w); } while (0)
            PK4(p0, 0, pa0); PK4(p0, 8, pa1); PK4(p1, 0, pa2); PK4(p1, 8, pa3);
#undef PK4
            if (__any(alpha < 1.f)) {
                if (hi == 0) al_l[r32] = alpha;
                LDS_WAIT();
#pragma unroll
                for (int r = 0; r < 16; ++r) { const float a = al_l[crow(r, hi)];
#pragma unroll
                    for (int d = 0; d < 4; ++d) o[d][r] *= a; }
            }
            const int vb = vb0 + (j & 1) * 16384;
            pv_one<0>(o[0], vb, pa0, pa1, pa2, pa3); pv_one<1>(o[1], vb, pa0, pa1, pa2, pa3); pv_one<2>(o[2], vb, pa0, pa1, pa2, pa3); pv_one<3>(o[3], vb, pa0, pa1, pa2, pa3);
        }
        if (j + 1 < ntiles) SWRITE((j + 1) & 1);
    }
#undef BG_STEP
#undef KPOS
#undef SLOAD
#undef SWRITE
}

__device__ __forceinline__ void attn_pass_band_dma(const bf16_t* __restrict__ Qw, const bf16_t* __restrict__ Kb, const bf16_t* __restrict__ Vb, size_t kvs,
                                                   int key0, int L, int qpos, int t_lo, int t_hi, LAS char* lds, f32x16 (&o)[4], float& m_reg, float& l_reg, const BgConv bg, BgState& bs) {
    constexpr int DQK = 128, ND0 = 8, ntiles = 6; constexpr bool BAND = true;
    constexpr float SCALE = 0.08838834764831845f, C = SCALE * 1.4426950408889634f, THR = 8.f;
    const int tid = fresh_tid(), wid = __builtin_amdgcn_readfirstlane(tid >> 6), lane = tid & 63, r32 = lane & 31, hi = lane >> 5;
    LAS char* V_lds = lds; LAS char* K_lds = lds + 49152;
    LAS float* al_l = (LAS float*)(lds + 98304) + wid * 64;
    bf16x8 qr[ND0];
#pragma unroll
    for (int d0 = 0; d0 < ND0; ++d0) qr[d0] = *(const bf16x8*)(Qw + d0 * 16);
    const int vb0 = (int)(unsigned)(size_t)V_lds + v_rd_base(lane);
    int vrow[2], vcol[2], krow[2], kcol[2];
#pragma unroll
    for (int i = 0; i < 2; ++i) { const int g = (i * 8 + wid) * 64 + lane;
        const int sub = g >> 5, within = g & 31, kk = (sub >> 2) * 8 + (within >> 2);
        vrow[i] = (kk & ~0xC) | ((kk & 4) << 1) | ((kk & 8) >> 1); vcol[i] = (sub & 3) * 32 + (within & 3) * 8;
        krow[i] = g >> 4; kcol[i] = (((g & 15) ^ (krow[i] & 7))) * 8; }
#define KPOSC(j, row) ({ int _p = key0 + 64 * (j) + (row); _p = _p < 0 ? 0 : (_p >= L ? L - 1 : _p); (size_t)_p; })
#define DMA_TILE(j, b) do { _Pragma("unroll") for (int _i = 0; _i < 2; ++_i) { \
        __builtin_amdgcn_global_load_lds((const unsigned*)(Vb + KPOSC(j, vrow[_i]) * kvs + vcol[_i]), (LAS unsigned*)(V_lds + (b) * 16384 + (_i * 8 + wid) * 1024), 16, 0, 0); \
        __builtin_amdgcn_global_load_lds((const unsigned*)(Kb + KPOSC(j, krow[_i]) * kvs + kcol[_i]), (LAS unsigned*)(K_lds + (b) * 16384 + (_i * 8 + wid) * 1024), 16, 0, 0); } } while (0)
    asm volatile("s_waitcnt vmcnt(0) lgkmcnt(0)" ::: "memory"); __builtin_amdgcn_s_barrier(); asm volatile("" ::: "memory");
    DMA_TILE(0, 0); DMA_TILE(1, 1);
    int cur = 0;
    for (int j = 0; j < ntiles; ++j) {
        if (j + 1 < ntiles) asm volatile("s_waitcnt vmcnt(4)" ::: "memory"); else asm volatile("s_waitcnt vmcnt(0)" ::: "memory");
        asm volatile("s_waitcnt lgkmcnt(0)" ::: "memory"); __builtin_amdgcn_s_barrier(); asm volatile("" ::: "memory");
        { LAS unsigned char* bgscr = (LAS unsigned char*)lds + LDS_BG + wid * LDS_BGW;
          bg_finish<false>(bg, bs.pend, bs.par, bgscr, lane);
          if (j + 1 < ntiles) bg_issue(bg, bs.it, bs.pend, bs.par, bgscr, lane); }
        if (j + 2 < ntiles) { const int nb = cur == 0 ? 2 : cur - 1; DMA_TILE(j + 2, nb); }
        if (j >= t_lo && j <= t_hi) {
            const LAS char* Kt = K_lds + cur * 16384;
            f32x16 p0 = {}, p1 = {};
#pragma unroll
            for (int d0 = 0; d0 < ND0; ++d0) { const int cb = (d0 * 16 + hi * 8) * 2;
                const bf16x8 b0 = *(const LAS bf16x8*)(Kt + (DQK == 128 ? KSWZ128(r32, cb) : KSWZ64(r32, cb)));
                const bf16x8 b1 = *(const LAS bf16x8*)(Kt + (DQK == 128 ? KSWZ128(32 + r32, cb) : KSWZ64(32 + r32, cb)));
                p0 = __builtin_amdgcn_mfma_f32_32x32x16_bf16(b0, qr[d0], p0, 0, 0, 0);
                p1 = __builtin_amdgcn_mfma_f32_32x32x16_bf16(b1, qr[d0], p1, 0, 0, 0); }
            unsigned vmask = 0xffffffffu;
            if (BAND) { vmask = 0u; const int kb = key0 + 64 * j;
#pragma unroll
                for (int r = 0; r < 16; ++r) { const int k0p = kb + crow(r, hi), k1p = k0p + 32; const int d0p = qpos - k0p, d1p = qpos - k1p;
                    const bool v0 = (d0p <= 64) && (d0p >= -64) && (k0p >= 0) && (k0p < L), v1 = (d1p <= 64) && (d1p >= -64) && (k1p >= 0) && (k1p < L);
                    vmask |= (v0 ? 1u : 0u) << r; vmask |= (v1 ? 1u : 0u) << (16 + r);
                    p0[r] = v0 ? p0[r] : -1e30f; p1[r] = v1 ? p1[r] : -1e30f; } }
            float pmax = p0[0];
#pragma unroll
            for (int r = 1; r < 16; ++r) pmax = fmaxf(pmax, p0[r]);
#pragma unroll
            for (int r = 0; r < 16; ++r) pmax = fmaxf(pmax, p1[r]);
            { auto rr = __builtin_amdgcn_permlane32_swap(__float_as_uint(pmax), __float_as_uint(pmax), false, false); pmax = fmaxf(__uint_as_float(rr[0]), __uint_as_float(rr[1])); }
            float mn, alpha;
            if (__all(pmax - m_reg <= THR / SCALE)) { mn = m_reg; alpha = 1.f; }
            else { mn = fmaxf(m_reg, pmax); alpha = __builtin_amdgcn_exp2f((m_reg - mn) * C); m_reg = mn; }
            const float mnC = -mn * C;
#pragma unroll
            for (int r = 0; r < 16; ++r) { p0[r] = __builtin_amdgcn_exp2f(fmaf(p0[r], C, mnC)); p1[r] = __builtin_amdgcn_exp2f(fmaf(p1[r], C, mnC)); }
            if (BAND) {
#pragma unroll
                for (int r = 0; r < 16; ++r) { p0[r] = ((vmask >> r) & 1u) ? p0[r] : 0.f; p1[r] = ((vmask >> (16 + r)) & 1u) ? p1[r] : 0.f; } }
            float ps = 0.f;
#pragma unroll
            for (int r = 0; r < 16; ++r) ps += p0[r];
#pragma unroll
            for (int r = 0; r < 16; ++r) ps += p1[r];
            { auto rr = __builtin_amdgcn_permlane32_swap(__float_as_uint(ps), __float_as_uint(ps), false, false); ps = __uint_as_float(rr[0]) + __uint_as_float(rr[1]); }
            l_reg = l_reg * alpha + ps;
            bf16x8 pa0, pa1, pa2, pa3;
#define PK4(P, BASE, OUT) do { unsigned a0 = cvt_pk_bf16(P[BASE + 0], P[BASE + 1]), a1 = cvt_pk_bf16(P[BASE + 2], P[BASE + 3]); \
        unsigned b0 = cvt_pk_bf16(P[BASE + 4], P[BASE + 5]), b1 = cvt_pk_bf16(P[BASE + 6], P[BASE + 7]); \
        auto r0 = __builtin_amdgcn_permlane32_swap(a0, b0, false, false); auto r1 = __builtin_amdgcn_permlane32_swap(a1, b1, false, false); \
        u32x4 w = {r0[0], r1[0], r0[1], r1[1]}; OUT = *reinterpret_cast<bf16x8*>(&w); } while (0)
            PK4(p0, 0, pa0); PK4(p0, 8, pa1); PK4(p1, 0, pa2); PK4(p1, 8, pa3);
#undef PK4
            if (__any(alpha < 1.f)) {
                if (hi == 0) al_l[r32] = alpha;
                LDS_WAIT();
#pragma unroll
                for (int r = 0; r < 16; ++r) { const float a = al_l[crow(r, hi)];
#pragma unroll
                    for (int d = 0; d < 4; ++d) o[d][r] *= a; }
            }
            const int vb = vb0 + cur * 16384;
            pv_one<0>(o[0], vb, pa0, pa1, pa2, pa3); pv_one<1>(o[1], vb, pa0, pa1, pa2, pa3); pv_one<2>(o[2], vb, pa0, pa1, pa2, pa3); pv_one<3>(o[3], vb, pa0, pa1, pa2, pa3);
        }
        cur = cur == 2 ? 0 : cur + 1;
    }
    asm volatile("s_waitcnt vmcnt(0) lgkmcnt(0)" ::: "memory");
#undef KPOSC
#undef DMA_TILE
}
}

__device__ __forceinline__ void transpose_item(const float* __restrict__ src, int N, bf16_t* __restrict__ dst, int dK, LAS float* scr, int lane) {
#pragma unroll 8
    for (int i = 0; i < 32; ++i) { const int kk = 2 * i + (lane >> 5); scr[kk * 33 + (lane & 31)] = src[(size_t)kk * N + (lane & 31)]; }
    LDS_WAIT();
    const int c = lane & 7;
#pragma unroll
    for (int j = 0; j < 4; ++j) { const int n = (lane >> 3) + 8 * j; const LAS float* s = scr + (8 * c) * 33 + n;
        u32x4 o; o.x = cvt_pk_bf16(s[0 * 33], s[1 * 33]); o.y = cvt_pk_bf16(s[2 * 33], s[3 * 33]); o.z = cvt_pk_bf16(s[4 * 33], s[5 * 33]); o.w = cvt_pk_bf16(s[6 * 33], s[7 * 33]);
        *(u32x4*)(dst + (size_t)n * dK + 8 * c) = o; }
    LDS_WAIT();
}

__device__ __forceinline__ void transpose_item_fp8(const float* __restrict__ src, int N, unsigned char* __restrict__ dst, int dK, float sc, LAS float* scr, int lane) {
#pragma unroll 8
    for (int i = 0; i < 32; ++i) { const int kk = 2 * i + (lane >> 5); scr[kk * 33 + (lane & 31)] = src[(size_t)kk * N + (lane & 31)]; }
    LDS_WAIT();
    const int c = lane & 7;
#pragma unroll
    for (int j = 0; j < 4; ++j) { const int n = (lane >> 3) + 8 * j; const LAS float* s = scr + (8 * c) * 33 + n;
        u32x2 o; o.x = cvt_pk4_fp8(s[0 * 33] * sc, s[1 * 33] * sc, s[2 * 33] * sc, s[3 * 33] * sc); o.y = cvt_pk4_fp8(s[4 * 33] * sc, s[5 * 33] * sc, s[6 * 33] * sc, s[7 * 33] * sc);
        *(u32x2*)(dst + (size_t)n * dK + 8 * c) = o; }
    LDS_WAIT();
}

__device__ __forceinline__ void phase0(const Params& p, LAS unsigned char* lds, int vcu, int G) {
    unsigned char* ws = p.ws;
    const int tid = fresh_tid(), wave = tid >> 6, lane = tid & 63;
    const int gw = vcu * 8 + wave, NGW = G * 8;
    LAS float* scr = (LAS float*)(lds + wave * 8448);
    { const float* x = p.in[0]; bf16_t* xb = (bf16_t*)(ws + WS_XB); const size_t n8 = (size_t)T_TOK * DM / 8;
      for (size_t i = (size_t)blockIdx.x * NTHREADS + tid; i < n8; i += (size_t)G * NTHREADS) {
          const f32x4 a = *(const f32x4*)(x + i * 8), b = *(const f32x4*)(x + i * 8 + 4);
          u32x4 o; o.x = cvt_pk_bf16(a[0], a[1]); o.y = cvt_pk_bf16(a[2], a[3]); o.z = cvt_pk_bf16(b[0], b[1]); o.w = cvt_pk_bf16(b[2], b[3]);
          *(u32x4*)(xb + i * 8) = o;
          u32x2 o8; o8.x = cvt_pk4_fp8(a[0] * SX8, a[1] * SX8, a[2] * SX8, a[3] * SX8); o8.y = cvt_pk4_fp8(b[0] * SX8, b[1] * SX8, b[2] * SX8, b[3] * SX8);
          *(u32x2*)(ws + WS_X8 + i * 8) = o8; } }
    { const float* w_in = p.in[1]; const float* w_br = p.in[7]; const float* w_out = p.in[8];
      bf16_t* WINT = (bf16_t*)(ws + WS_WINT); bf16_t* WBT = (bf16_t*)(ws + WS_WBT); bf16_t* WOT = (bf16_t*)(ws + WS_WOT);
      for (int it = gw; it < 10240 + 1024 + 2048; it += NGW) {
          int r = it;
          if (r < 10240) { const int kb = r / 320, nb = r % 320;
              if (nb >= 144 && nb < 192) transpose_item(w_in + (size_t)(64 * kb) * ZC + 32 * nb, ZC, WINT + (size_t)(32 * nb) * DM + 64 * kb, DM, scr, lane);
              else transpose_item_fp8(w_in + (size_t)(64 * kb) * ZC + 32 * nb, ZC, ws + WS_WING8 + (size_t)(32 * (nb < 144 ? nb : nb - 48)) * DM + 64 * kb, DM, SWG8, scr, lane);
              continue; }
          r -= 10240;
          if (r < 1024) { const int g = r >> 9, r2 = r & 511, kb = r2 >> 6, nb = r2 & 63; transpose_item(w_br + ((size_t)g * 512 + 64 * kb) * DM + 32 * nb, DM, WBT + (size_t)(32 * nb) * 1024 + g * 512 + 64 * kb, 1024, scr, lane); continue; }
          r -= 1024;
          { const int kb = r >> 6, nb = r & 63; transpose_item(w_out + (size_t)(64 * kb) * DM + 32 * nb, DM, WOT + (size_t)(32 * nb) * DM + 64 * kb, DM, scr, lane); }
      } }
    { float* cosA = (float*)(ws + WS_COSA); float* sinA = (float*)(ws + WS_SINA); float* cosB = (float*)(ws + WS_COSB); float* sinB = (float*)(ws + WS_SINB);
      const int gt = blockIdx.x * NTHREADS + tid, NGT = G * NTHREADS;
      for (int i = gt; i < SEQ * 16; i += NGT) { const int pos = i >> 4, k = i & 15; const float inv = (float)pow(500000.0, -(double)k / 16.0); const float ang = (float)pos * inv; cosA[i] = cosf(ang); sinA[i] = sinf(ang); }
      for (int i = gt; i < SEQ * 8; i += NGT) { const int pos = i >> 3, k = i & 7; const float inv = (float)pow(500000.0, -(double)k / 8.0); const float ang = (float)pos * inv; cosB[i] = cosf(ang); sinB[i] = sinf(ang); }
      const float* wr = p.in[11]; float* wrt = (float*)(ws + WS_WRT);
      for (int i = gt; i < NE * DM; i += NGT) { const int e = i >> 11, d = i & (DM - 1); wrt[i] = wr[d * NE + e]; } }
}

__device__ __forceinline__ void moe_weight_convert(LAS unsigned char* lds, const BgConv bg, BgState& bs) {
    const int tid = fresh_tid(), wave = __builtin_amdgcn_readfirstlane(tid >> 6), lane = tid & 63;
    LAS unsigned char* scr = lds + LDS_BG + wave * LDS_BGW;
    for (;;) { bg_finish(bg, bs.pend, bs.par, scr, lane); if (bs.it >= BG_ITEMS) break; bg_issue(bg, bs.it, bs.pend, bs.par, scr, lane); }
}
__device__ __forceinline__ void bg_drain(LAS unsigned char* lds, const BgConv bg, BgState& bs) {
    const int tid = fresh_tid(), wave = __builtin_amdgcn_readfirstlane(tid >> 6), lane = tid & 63;
    bg_finish(bg, bs.pend, bs.par, lds + LDS_BG + wave * LDS_BGW, lane);
}

__device__ __forceinline__ void dil_item(const Params& p, LAS unsigned char* lds, int idx, const BgConv bg, BgState& bs) {
    using namespace att;
    unsigned char* ws = p.ws;
    const bf16_t* Z = (const bf16_t*)(ws + WS_Z); bf16_t* OG = (bf16_t*)(ws + WS_OG); float* LSEG = (float*)(ws + WS_LSEG);
    const int tid = fresh_tid(), wid = __builtin_amdgcn_readfirstlane(tid >> 6), lane = tid & 63, r32 = lane & 31, hi = lane >> 5;
    const int sub = idx & 15, h = (idx >> 4) & 3, bgi = idx >> 6, g = bgi % 3, b = bgi / 3;
    const int lr = g * 2, r = 1 << lr, L = SEQ >> lr, phase = sub & (r - 1), qb = sub >> lr;
    const int head = g * 4 + h;
    const int qpos = qb * 256 + wid * 32 + r32;
    const size_t tokq = (size_t)b * SEQ + phase + (size_t)r * qpos;
    const bf16_t* Qw = Z + tokq * ZC + head * 128 + hi * 8;
    const bf16_t* Kb = Z + ((size_t)b * SEQ + phase) * ZC + 1536 + head * 128;
    const bf16_t* Vb = Z + ((size_t)b * SEQ + phase) * ZC + 3072 + head * 128;
    f32x16 o[4] = {}; float m_reg = -1e30f, l_reg = 0.f;
    attn_pass_band_dma(Qw, Kb, Vb, (size_t)r * ZC, qb * 256 - 64, L, qpos, wid >> 1, (wid >> 1) + 2, (LAS char*)lds, o, m_reg, l_reg, bg, bs);
    LAS float* li_l = (LAS float*)(lds + 98304) + wid * 64 + 32;
    int r32e = r32, hie = hi; asm volatile("" : "+v"(r32e), "+v"(hie));
    if (hie == 0) { li_l[r32e] = l_reg; const size_t tq = (size_t)b * SEQ + phase + (size_t)r * (qb * 256 + wid * 32 + r32e); LSEG[((size_t)g * T_TOK + tq) * 4 + h] = m_reg * 0.08838834764831845f + __logf(l_reg); }
    LDS_WAIT();
#pragma unroll
    for (int rr = 0; rr < 16; ++rr) { const int row = crow(rr, hie); const float rl = 1.f / li_l[row];
        const size_t tok = (size_t)b * SEQ + phase + (size_t)r * (qb * 256 + wid * 32 + row);
        bf16_t* op = OG + ((size_t)g * T_TOK + tok) * 512 + h * 128 + r32e;
#pragma unroll
        for (int d0 = 0; d0 < 4; ++d0) op[d0 * 32] = f2bf(o[d0][rr] * rl);
        asm volatile("" ::: "memory"); }
    LDS_WAIT();
}

__device__ __forceinline__ void diff_item(const Params& p, LAS unsigned char* lds, int item, const BgConv bg, BgState& bs) {
    using namespace att;
    unsigned char* ws = p.ws;
    const bf16_t* Z = (const bf16_t*)(ws + WS_Z); float* O0 = (float*)(ws + WS_O0); bf16_t* BR = (bf16_t*)(ws + WS_BR);
    const int tid = fresh_tid(), wid = __builtin_amdgcn_readfirstlane(tid >> 6), lane = tid & 63, r32 = lane & 31, hi = lane >> 5;
    const int b = item >> 6, h = (item >> 4) & 3, qb = item & 15;
    const size_t tok0 = (size_t)b * SEQ + qb * 256 + wid * 32;
    LAS float* li_l = (LAS float*)(lds + 65536) + wid * 64 + 32;
    for (int c = 0; c < 2; ++c) {
        const bf16_t* Qw = Z + (tok0 + r32) * ZC + 4608 + h * 128 + c * 64 + hi * 8;
        const bf16_t* Kb = Z + ((size_t)b * SEQ) * ZC + 5120 + h * 128 + c * 64;
        const bf16_t* Vb = Z + ((size_t)b * SEQ) * ZC + 5632 + h * 128;
        f32x16 o[4] = {}; float m_reg = -1e30f, l_reg = 0.f;
        attn_pass<64, false>(Qw, Kb, Vb, (size_t)ZC, SEQ / 64, 0, SEQ, 0, 0, SEQ / 64 - 1, (LAS char*)lds, o, m_reg, l_reg, bg, bs);
        int r32e = r32, hie = hi, lanee = lane; asm volatile("" : "+v"(r32e), "+v"(hie), "+v"(lanee));
        if (hie == 0) li_l[r32e] = l_reg;
        LDS_WAIT();
        if (c == 0) {
#pragma unroll
            for (int rr = 0; rr < 16; ++rr) { const int row = crow(rr, hie); const float rl = 1.f / li_l[row];
                float* op = O0 + (tok0 + row) * 512 + h * 128 + r32e;
#pragma unroll
                for (int d0 = 0; d0 < 4; ++d0) op[d0 * 32] = o[d0][rr] * rl;
                asm volatile("" ::: "memory"); }
        } else {
            const float s1 = wave_sum(p.in[2][lanee] * p.in[3][lanee]), s2 = wave_sum(p.in[4][lanee] * p.in[5][lanee]);
            const float lam = __expf(s1) - __expf(s2) + 0.2f;
            const float* nw = p.in[6];
            float nwv[4];
#pragma unroll
            for (int d0 = 0; d0 < 4; ++d0) nwv[d0] = nw[d0 * 32 + r32e] * 0.8f;
#pragma unroll
            for (int rr = 0; rr < 16; ++rr) { const int row = crow(rr, hie); const float rl = 1.f / li_l[row];
                const float* ip = O0 + (tok0 + row) * 512 + h * 128 + r32e;
                float v[4], ss = 0.f;
#pragma unroll
                for (int d0 = 0; d0 < 4; ++d0) { v[d0] = ip[d0 * 32] - lam * (o[d0][rr] * rl); ss += v[d0] * v[d0]; }
                ss = half_sum(ss);
                const float rinv = rsqrtf(ss * (1.f / 128.f) + 1e-5f);
                bf16_t* op = BR + (tok0 + row) * 1024 + 512 + h * 128 + r32e;
#pragma unroll
                for (int d0 = 0; d0 < 4; ++d0) op[d0 * 32] = f2bf(v[d0] * rinv * nwv[d0]);
                asm volatile("" ::: "memory"); }
        }
        LDS_WAIT();
    }
}

__device__ __forceinline__ void combine_rows(const Params& p, int vcu, int G) {
    unsigned char* ws = p.ws;
    const bf16_t* OG = (const bf16_t*)(ws + WS_OG); const float* LSEG = (const float*)(ws + WS_LSEG); bf16_t* BR = (bf16_t*)(ws + WS_BR);
    const int tid = fresh_tid(), wave = tid >> 6, lane = tid & 63;
    const int h = lane >> 4;
    for (int t = vcu * 8 + wave; t < T_TOK; t += G * 8) {
        const float l0 = LSEG[((size_t)0 * T_TOK + t) * 4 + h], l1 = LSEG[((size_t)1 * T_TOK + t) * 4 + h], l2 = LSEG[((size_t)2 * T_TOK + t) * 4 + h];
        const float mx = fmaxf(l0, fmaxf(l1, l2)); float w0 = __expf(l0 - mx), w1 = __expf(l1 - mx), w2 = __expf(l2 - mx); const float inv = 1.f / (w0 + w1 + w2); w0 *= inv; w1 *= inv; w2 *= inv;
        const u32x4 a = *(const u32x4*)(OG + ((size_t)0 * T_TOK + t) * 512 + lane * 8), bq = *(const u32x4*)(OG + ((size_t)1 * T_TOK + t) * 512 + lane * 8), cq = *(const u32x4*)(OG + ((size_t)2 * T_TOK + t) * 512 + lane * 8);
        u32x4 o;
#pragma unroll
        for (int k = 0; k < 4; ++k) { const float lo = w0 * bf_lo(a[k]) + w1 * bf_lo(bq[k]) + w2 * bf_lo(cq[k]), hi2 = w0 * bf_hi(a[k]) + w1 * bf_hi(bq[k]) + w2 * bf_hi(cq[k]); o[k] = cvt_pk_bf16(lo, hi2); }
        *(u32x4*)(BR + (size_t)t * 1024 + lane * 8) = o;
    }
}

__device__ __forceinline__ void ln1_router(const Params& p, LAS unsigned char* lds, int vcu, int G) {
    unsigned char* ws = p.ws;
    const float* V1 = p.in[0]; const bf16_t* MIX = (const bf16_t*)(ws + WS_MIX); unsigned char* X1B = ws + WS_X1B;     const float* wrt = (const float*)(ws + WS_WRT); float* AFFT = (float*)(ws + WS_AFFT);
    const float* g1 = p.in[9]; const float* b1 = p.in[10];
    const int tid = fresh_tid(), wave = tid >> 6, lane = tid & 63;
    __syncthreads();
    for (int i = tid; i < NE * DM / 4; i += NTHREADS) ((LAS f32x4*)lds)[i] = ((const f32x4*)wrt)[i];
    __syncthreads();
    for (int rp = vcu * 8 + wave; rp < T_TOK / 4; rp += G * 8) {
        const int t0 = rp * 4;
        f32x4 v[4][8];
#pragma unroll
        for (int q = 0; q < 4; ++q) {
            const float* xr = V1 + (size_t)(t0 + q) * DM + lane * 4; const bf16_t* mr = MIX + (size_t)(t0 + q) * DM + lane * 4; float s = 0.f;
#pragma unroll
            for (int j = 0; j < 8; ++j) { v[q][j] = *(const f32x4*)(xr + 256 * j) * ALPHA + pg8::ld_bf16x4(mr + 256 * j); s += (v[q][j][0] + v[q][j][1]) + (v[q][j][2] + v[q][j][3]); }
            const float mean = wave_sum(s) * (1.f / DM); float s2 = 0.f;
#pragma unroll
            for (int j = 0; j < 8; ++j) { v[q][j] = v[q][j] - mean; s2 += (v[q][j][0] * v[q][j][0] + v[q][j][1] * v[q][j][1]) + (v[q][j][2] * v[q][j][2] + v[q][j][3] * v[q][j][3]); }
            const float rstd = rsqrtf(wave_sum(s2) * (1.f / DM) + LN_EPS);
            unsigned char* xbo = X1B + (size_t)(t0 + q) * DM + lane * 4;
#pragma unroll
            for (int j = 0; j < 8; ++j) { const f32x4 gg = *(const f32x4*)(g1 + lane * 4 + 256 * j), bb = *(const f32x4*)(b1 + lane * 4 + 256 * j);
                v[q][j] = v[q][j] * rstd * gg + bb; *(unsigned*)(xbo + 256 * j) = cvt_pk4_fp8(v[q][j][0] * SX8, v[q][j][1] * SX8, v[q][j][2] * SX8, v[q][j][3] * SX8); }
            asm volatile("" ::: "memory");
        }
        float lg[4] = {0.f, 0.f, 0.f, 0.f};
        const LAS float* wl = (const LAS float*)lds + lane * 4;
#pragma unroll 1
        for (int e = 0; e < NE; ++e) {
            f32x4 W[8];
#pragma unroll
            for (int j = 0; j < 8; ++j) W[j] = *(const LAS f32x4*)(wl + e * DM + 256 * j);
#pragma unroll
            for (int q = 0; q < 4; ++q) { float a = 0.f;
#pragma unroll
                for (int j = 0; j < 8; ++j) a += (v[q][j][0] * W[j][0] + v[q][j][1] * W[j][1]) + (v[q][j][2] * W[j][2] + v[q][j][3] * W[j][3]);
                a = wave_sum(a); lg[q] = (lane == e) ? a : lg[q]; }
        }
#pragma unroll
        for (int q = 0; q < 4; ++q) {
            float mx = lg[q];
            mx = fmaxf(mx, swz_xor<1>(mx)); mx = fmaxf(mx, swz_xor<2>(mx)); mx = fmaxf(mx, swz_xor<4>(mx)); mx = fmaxf(mx, swz_xor<8>(mx));
            const float ex = expf(lg[q] - mx); float sum = ex;
            sum += swz_xor<1>(sum); sum += swz_xor<2>(sum); sum += swz_xor<4>(sum); sum += swz_xor<8>(sum);
            const int t = t0 + q, bb = t >> 12, s = t & (SEQ - 1);
            if (lane < NE) AFFT[((size_t)bb * NE + lane) * SEQ + s] = ex / sum;
        }
    }
}

__device__ __forceinline__ void topk_gather(const Params& p, LAS unsigned char* lds, int G) {
    unsigned char* ws = p.ws;
    const float* AFFT = (const float*)(ws + WS_AFFT); int* SLOT = (int*)(ws + WS_SLOT); float* GATE = (float*)(ws + WS_GATE);
    const unsigned char* X1B = ws + WS_X1B; unsigned char* XG = ws + WS_XG;
    const int tid = fresh_tid(), wave = tid >> 6, lane = tid & 63;
    LAS unsigned* hist = (LAS unsigned*)lds;
    LAS unsigned* ctl = hist + 256;
    LAS unsigned* wtot = hist + 272;
    LAS int* rows = (LAS int*)(hist + 288);
    for (int item = blockIdx.x; item < NB * NE * 4; item += G) {
        const int qd = item & 3, be = item >> 2, b = be >> 4, e = be & 15;
        const float* ap = AFFT + (size_t)be * SEQ + tid * 8;
        const f32x4 fa = *(const f32x4*)ap, fb = *(const f32x4*)(ap + 4);
        float av[8] = {fa[0], fa[1], fa[2], fa[3], fb[0], fb[1], fb[2], fb[3]};
        unsigned key[8];
#pragma unroll
        for (int i = 0; i < 8; ++i) key[i] = __float_as_uint(av[i]);
        unsigned prefix = 0u, mask = 0u, remaining = CAP;
        for (int pass = 0; pass < 4; ++pass) {
            const int shift = 24 - 8 * pass;
            __syncthreads();
            if (tid < 256) hist[tid] = 0u;
            __syncthreads();
#pragma unroll
            for (int i = 0; i < 8; ++i) if ((key[i] & mask) == prefix) atomicAdd((unsigned*)&hist[(key[i] >> shift) & 255u], 1u);
            __syncthreads();
            if (wave == 0) {
                unsigned c0 = hist[4 * lane], c1 = hist[4 * lane + 1], c2 = hist[4 * lane + 2], c3 = hist[4 * lane + 3];
                const unsigned t = c0 + c1 + c2 + c3; unsigned v = t;
#pragma unroll
                for (int of = 1; of < 64; of <<= 1) { const unsigned u = __shfl_down(v, of); if (lane + of < 64) v += u; }
                unsigned cum = v - t;
                unsigned cs[4] = {c0, c1, c2, c3};
#pragma unroll
                for (int k = 3; k >= 0; --k) { if (cum < remaining && cum + cs[k] >= remaining) { ctl[0] = 4 * lane + k; ctl[1] = remaining - cum; } cum += cs[k]; }
            }
            __syncthreads();
            prefix |= ctl[0] << shift; mask |= 0xFFu << shift; remaining = ctl[1];
        }
        const unsigned Tk = prefix, need_eq = remaining, cnt_gt_total = CAP - need_eq;
        unsigned ngt = 0, neq = 0;
#pragma unroll
        for (int i = 0; i < 8; ++i) { ngt += key[i] > Tk ? 1u : 0u; neq += key[i] == Tk ? 1u : 0u; }
        const unsigned packed = ngt | (neq << 16); unsigned incl = packed;
#pragma unroll
        for (int of = 1; of < 64; of <<= 1) { const unsigned u = __shfl_up(incl, of); if (lane >= of) incl += u; }
        __syncthreads();
        if (lane == 63) wtot[wave] = incl;
        __syncthreads();
        unsigned base = 0;
        for (int w = 0; w < wave; ++w) base += wtot[w];
        unsigned excl = base + incl - packed; unsigned rgt = excl & 0xffffu, req = excl >> 16;
        int slots[8];
#pragma unroll
        for (int i = 0; i < 8; ++i) { int sl = -1;
            if (key[i] > Tk) { sl = (int)rgt; ++rgt; } else if (key[i] == Tk) { if (req < need_eq) sl = (int)(cnt_gt_total + req); ++req; }
            slots[i] = sl;
            if (sl >= 0) { if ((sl >> 7) == qd) rows[sl & 127] = tid * 8 + i; if (qd == 0) GATE[(size_t)e * 2048 + b * CAP + sl] = av[i]; } }
        if (qd == 0) { int* sp = SLOT + (size_t)be * SEQ + tid * 8; *(int4*)sp = make_int4(slots[0], slots[1], slots[2], slots[3]); *(int4*)(sp + 4) = make_int4(slots[4], slots[5], slots[6], slots[7]); }
        __syncthreads();
        for (int r = wave; r < 128; r += 8) {
            const int s = rows[r];
            const u32x4* src = (const u32x4*)(X1B + ((size_t)b * SEQ + s) * DM); u32x4* dst = (u32x4*)(XG + ((size_t)e * 2048 + b * CAP + qd * 128 + r) * DM);
#pragma unroll
            for (int j = 0; j < 2; ++j) dst[lane + 64 * j] = src[lane + 64 * j];
        }
    }
}

__device__ __forceinline__ void ln2_rows(const Params& p, int vcu, int G) {
    unsigned char* ws = p.ws;
    const bf16_t* YS = (const bf16_t*)(ws + WS_YS); const int* SLOT = (const int*)(ws + WS_SLOT);
    const float* g2 = p.in[15]; const float* b2 = p.in[16]; float* out = p.out;
    const int tid = fresh_tid(), wave = tid >> 6, lane = tid & 63;
    for (int t = vcu * 8 + wave; t < T_TOK; t += G * 8) {
        const int b = t >> 12, s = t & (SEQ - 1);
        const int myslot = lane < NE ? SLOT[((size_t)b * NE + lane) * SEQ + s] : -1;
        f32x4 v[8];
        const float* xr = p.in[0] + (size_t)t * DM + lane * 4; const bf16_t* mr = (const bf16_t*)(ws + WS_MIX) + (size_t)t * DM + lane * 4;
        { float s0 = 0.f;
#pragma unroll
          for (int j = 0; j < 8; ++j) { v[j] = *(const f32x4*)(xr + 256 * j) * ALPHA + pg8::ld_bf16x4(mr + 256 * j); s0 += (v[j][0] + v[j][1]) + (v[j][2] + v[j][3]); }
          const float mean1 = wave_sum(s0) * (1.f / DM); float q1 = 0.f;
#pragma unroll
          for (int j = 0; j < 8; ++j) { v[j] = v[j] - mean1; q1 += (v[j][0] * v[j][0] + v[j][1] * v[j][1]) + (v[j][2] * v[j][2] + v[j][3] * v[j][3]); }
          const float rstd1 = rsqrtf(wave_sum(q1) * (1.f / DM) + LN_EPS);
#pragma unroll
          for (int j = 0; j < 8; ++j) { const f32x4 gg = *(const f32x4*)(p.in[9] + lane * 4 + 256 * j), bb = *(const f32x4*)(p.in[10] + lane * 4 + 256 * j); v[j] = (v[j] * rstd1 * gg + bb) * ALPHA; } }
        for (int e = 0; e < NE; ++e) {
            const int sl = __builtin_amdgcn_readlane(myslot, e);
            if (sl >= 0) { const bf16_t* yr = YS + ((size_t)e * 2048 + b * CAP + sl) * DM + lane * 4;
#pragma unroll
                for (int j = 0; j < 8; ++j) v[j] += pg8::ld_bf16x4(yr + 256 * j); }
        }
        float sm = 0.f;
#pragma unroll
        for (int j = 0; j < 8; ++j) sm += (v[j][0] + v[j][1]) + (v[j][2] + v[j][3]);
        const float mean = wave_sum(sm) * (1.f / DM); float s2 = 0.f;
#pragma unroll
        for (int j = 0; j < 8; ++j) { v[j] = v[j] - mean; s2 += (v[j][0] * v[j][0] + v[j][1] * v[j][1]) + (v[j][2] * v[j][2] + v[j][3] * v[j][3]); }
        const float rstd = rsqrtf(wave_sum(s2) * (1.f / DM) + LN_EPS);
        float* orow = out + (size_t)t * DM + lane * 4;
#pragma unroll
        for (int j = 0; j < 8; ++j) { const f32x4 gg = *(const f32x4*)(g2 + lane * 4 + 256 * j), bb = *(const f32x4*)(b2 + lane * 4 + 256 * j); *(f32x4*)(orow + 256 * j) = v[j] * rstd * gg + bb; }
    }
}

__global__ void __launch_bounds__(NTHREADS, 2) mega(Params p) {
    extern __shared__ __attribute__((aligned(16))) unsigned char shm[];
    LAS unsigned char* lds = (LAS unsigned char*)shm;
    cg::grid_group grid = cg::this_grid();
    const int G = gridDim.x, bx = blockIdx.x;
    const int vcu = (G % 8 == 0) ? (bx % 8) * (G / 8) + bx / 8 : bx;
    unsigned char* ws = p.ws;
    if (fresh_tid() < 16) ((LAS unsigned*)(lds + LDS_BARW))[fresh_tid()] = 0u;
    __syncthreads();
    const XcdBarrier xb = xcd_barrier_post((unsigned*)(ws + WS_BARW), (volatile LAS unsigned*)(lds + LDS_BARW));

    const BgConv bg{p.in[12], p.in[13], p.in[14], ws + WS_WGUT, ws + WS_WDT, G * 8, 0};
    BgState bs; bs.it = vcu * 8 + __builtin_amdgcn_readfirstlane(fresh_tid() >> 6); bs.pend = -1; bs.par = 0; bs.tick = 0;
    if (PHASE_MASK & 1) REPS(0) phase0(p, lds, vcu, G);
    if (p.ws == nullptr) grid.sync();
    xcd_barrier(xb);
    if (PHASE_MASK & 2) REPS(1) {
      { pg8::Gemm g{(const bf16_t*)(ws + WS_XB), (const bf16_t*)(ws + WS_WINT) + (size_t)4608 * DM, T_TOK, 1536, DM}; pg8::InBf16Order S{G, bx};
        pg8::EpiZ E{(bf16_t*)(ws + WS_Z), (const float*)(ws + WS_COSA), (const float*)(ws + WS_SINA), (const float*)(ws + WS_COSB), (const float*)(ws + WS_SINB), 18, 1.f};
        pg8::gemm_phase(lds, g, S, E); }
      { pg8::Gemm g{(const bf16_t*)(ws + WS_X8), (const bf16_t*)(ws + WS_WING8), T_TOK, 8704, DM}; pg8::InFp8Order S{G, bx};
        pg8::EpiInFp8 E{pg8::EpiZ{(bf16_t*)(ws + WS_Z), (const float*)(ws + WS_COSA), (const float*)(ws + WS_SINA), (const float*)(ws + WS_COSB), (const float*)(ws + WS_SINB), 0, 1.f / (SX8 * SWG8)}, pg8::EpiGate{ws + WS_GF}};
        pg8::gemm_phase<pg8::EpiInFp8, pg8::InFp8Order, true>(lds, g, S, E); } }
    xcd_barrier(xb);
    if (PHASE_MASK & 4) REPS(2) for (int it = vcu; it < 768; it += G) dil_item(p, lds, it, bg, bs);
    bg_drain(lds, bg, bs);
    xcd_barrier(xb);
    if (PHASE_MASK & 8) REPS(3) combine_rows(p, vcu, G);
    if (PHASE_MASK & 16) REPS(4) for (int it = vcu; it < 256; it += G) diff_item(p, lds, it, bg, bs);
    bg_drain(lds, bg, bs);
    xcd_barrier(xb);
    if (PHASE_MASK & 32) REPS(5) { pg8::Gemm g{(const bf16_t*)(ws + WS_BR), (const bf16_t*)(ws + WS_WBT), T_TOK, DM, 1024}; pg8::StaticOrder S; S.init(T_TOK, DM, G, bx);
      pg8::EpiBranch E{(bf16_t*)(ws + WS_MERGED), ws + WS_GF};
      pg8::gemm_phase(lds, g, S, E); }
    xcd_barrier(xb);
    if (PHASE_MASK & 64) REPS(6) { pg8::Gemm g{(const bf16_t*)(ws + WS_MERGED), (const bf16_t*)(ws + WS_WOT), T_TOK, DM, DM}; pg8::StaticOrder S; S.init(T_TOK, DM, G, bx);
      pg8::EpiOut E{(bf16_t*)(ws + WS_MIX)};
      pg8::gemm_phase(lds, g, S, E); }
    xcd_barrier(xb);
    if (PHASE_MASK & 128) moe_weight_convert(lds, bg, bs);
    if (PHASE_MASK & 256) REPS(8) ln1_router(p, lds, vcu, G);
    xcd_barrier(xb);
    if (PHASE_MASK & 512) REPS(9) topk_gather(p, lds, G);
    xcd_barrier(xb);
    if (PHASE_MASK & 1024) REPS(10) { pg8::Gemm g{(const bf16_t*)(ws + WS_XG), (const bf16_t*)(ws + WS_WGUT), NE * 2048, NE * 4096, DM}; pg8::UpOrder S{G, bx};
      pg8::EpiUp E{ws + WS_H};
      pg8::gemm_phase<pg8::EpiUp, pg8::UpOrder, true>(lds, g, S, E); }
    xcd_barrier(xb);
    if (PHASE_MASK & 2048) REPS(11) { pg8::Gemm g{(const bf16_t*)(ws + WS_H), (const bf16_t*)(ws + WS_WDT), NE * 2048, NE * 2048, DM}; pg8::DownOrder S{G, bx};
      pg8::EpiDown E{(bf16_t*)(ws + WS_YS), (const float*)(ws + WS_GATE)};
      pg8::gemm_phase<pg8::EpiDown, pg8::DownOrder, true>(lds, g, S, E); }
    xcd_barrier(xb);
    if (PHASE_MASK & 4096) REPS(12) ln2_rows(p, vcu, G);
}

extern "C" void kernel_launch(void* const* d_in, const int* in_sizes, int n_in, void* d_out, int out_size, void* d_ws, size_t ws_size, hipStream_t stream) {
    static int grid = 0;
    if (grid == 0) {
        if (n_in != 17 || out_size != T_TOK * DM || ws_size < WS_END) { fprintf(stderr, "kernel_launch: unexpected shapes (n_in %d out %d ws %zu, need ws >= %zu)\n", n_in, out_size, ws_size, (size_t)WS_END); grid = -1; return; }
        int dev = 0, cus = 0, per_cu = 0;
        hipGetDevice(&dev); hipDeviceGetAttribute(&cus, hipDeviceAttributeMultiprocessorCount, dev);
        if (hipFuncSetAttribute((const void*)mega, hipFuncAttributeMaxDynamicSharedMemorySize, LDS_BYTES) != hipSuccess) { fprintf(stderr, "kernel_launch: hipFuncSetAttribute failed\n"); grid = -1; return; }
        if (hipOccupancyMaxActiveBlocksPerMultiprocessor(&per_cu, (const void*)mega, NTHREADS, LDS_BYTES) != hipSuccess || per_cu < 1) { fprintf(stderr, "kernel_launch: occupancy query gave %d\n", per_cu); per_cu = 1; }
        (void)hipGetLastError();
        grid = cus * per_cu;
    }
    if (grid < 0) return;
    Params p{};
    for (int i = 0; i < 17; ++i) p.in[i] = (const float*)d_in[i];
    p.out = (float*)d_out; p.ws = (unsigned char*)d_ws;
    void* args[] = {&p};
    if (hipMemsetAsync((char*)d_ws + WS_BARW, 0, XCD_BAR_WORDS * 4, stream) != hipSuccess) { fprintf(stderr, "kernel_launch: memset of the barrier words failed\n"); return; }
    hipError_t e = hipLaunchCooperativeKernel((void*)mega, dim3(grid), dim3(NTHREADS), args, LDS_BYTES, stream);
    if (e != hipSuccess) fprintf(stderr, "cooperative launch failed: %s (grid %d)\n", hipGetErrorString(e), grid);
}
```

```cpp
#include <hip/hip_runtime.h>
#include <hip/hip_cooperative_groups.h>
#include <cstdio>
#include <cstdint>
namespace cg = cooperative_groups;

#define LAS __attribute__((address_space(3)))
typedef unsigned short bf16_t;
typedef short bf16x8 __attribute__((ext_vector_type(8)));
typedef short s16x4 __attribute__((ext_vector_type(4)));
typedef float f32x4 __attribute__((ext_vector_type(4)));
typedef float f32x16 __attribute__((ext_vector_type(16)));
typedef unsigned u32x4 __attribute__((ext_vector_type(4)));
typedef unsigned u32x2 __attribute__((ext_vector_type(2)));
typedef int i32x4 __attribute__((ext_vector_type(4)));
typedef int i32x8 __attribute__((ext_vector_type(8)));

constexpr int T_TOK = 16384, DM = 2048, SEQ = 4096, NB = 4, ZC = 10240, NE = 16, CAP = 512;
constexpr float ALPHA = 1.189207115002721f;
constexpr float LN_EPS = 1e-5f;
constexpr float SX8 = 8.f, SW8 = 64.f, SH8 = 16.f, SWG8 = 32.f;
constexpr int LDS_BG = 100352, LDS_BGW = 4224, LDS_BARW = 135168;
constexpr int LDS_BYTES = LDS_BARW + 64;
constexpr int NTHREADS = 512;
#ifndef PHASE_MASK
#define PHASE_MASK 0xFFFF
#endif
#ifndef REP_MASK
#define REP_MASK 0
#endif
#define REPS(k) for (int rep_ = 0; rep_ < 1 + ((REP_MASK >> (k)) & 1); ++rep_)

constexpr size_t MiB = (size_t)1 << 20;
constexpr size_t WS_WGUT = 0, WS_WDT = 128 * MiB;
constexpr size_t WS_XB = 384 * MiB, WS_WINT = 448 * MiB, WS_Z = 488 * MiB;
constexpr size_t WS_XG = 384 * MiB, WS_YS = 384 * MiB, WS_H = 512 * MiB;
constexpr size_t WS_WBT = 808 * MiB, WS_WOT = 812 * MiB, WS_COSA = 820 * MiB, WS_SINA = WS_COSA + 256 * 1024,
                 WS_COSB = WS_SINA + 256 * 1024, WS_SINB = WS_COSB + 128 * 1024, WS_WRT = 821 * MiB,
                 WS_AFFT = 822 * MiB, WS_SLOT = 823 * MiB, WS_GATE = 824 * MiB, WS_LSEG = 825 * MiB;
constexpr size_t WS_BR = 826 * MiB, WS_MERGED = 858 * MiB, WS_OG = 922 * MiB, WS_O0 = 970 * MiB;
constexpr size_t WS_X1B = 922 * MiB;
constexpr size_t WS_GF = 192 * MiB;
constexpr size_t WS_MIX = 576 * MiB;
constexpr size_t WS_X8 = 320 * MiB, WS_WING8 = 352 * MiB;
constexpr size_t WS_BARW = 1002 * MiB, WS_END = 1002 * MiB + 16384;

struct Params { const float* in[17]; float* out; unsigned char* ws; };

typedef __bf16 bf16x2_t __attribute__((ext_vector_type(2)));
typedef float f32x2_t __attribute__((ext_vector_type(2)));
__device__ __forceinline__ unsigned cvt_pk_bf16(float lo, float hi) { const f32x2_t v = {lo, hi}; const bf16x2_t b = __builtin_convertvector(v, bf16x2_t); return __builtin_bit_cast(unsigned, b); }
__device__ __forceinline__ unsigned cvt_pk4_fp8(float a, float b, float c, float d) { int w = __builtin_amdgcn_cvt_pk_fp8_f32(a, b, 0, false); w = __builtin_amdgcn_cvt_pk_fp8_f32(c, d, w, true); return (unsigned)w; }
__device__ __forceinline__ float bf_lo(unsigned w) { return __uint_as_float(w << 16); }
__device__ __forceinline__ float bf_hi(unsigned w) { return __uint_as_float(w & 0xffff0000u); }
__device__ __forceinline__ bf16_t f2bf(float f) { unsigned u = __float_as_uint(f); u += 0x7FFFu + ((u >> 16) & 1u); return (bf16_t)(u >> 16); }
template <int K> __device__ __forceinline__ float swz_xor(float v) { return __int_as_float(__builtin_amdgcn_ds_swizzle(__float_as_int(v), (K << 10) | 0x1f)); }
__device__ __forceinline__ float half_sum(float v) { v += swz_xor<1>(v); v += swz_xor<2>(v); v += swz_xor<4>(v); v += swz_xor<8>(v); v += swz_xor<16>(v); return v; }
__device__ __forceinline__ float wave_sum(float v) {
    v = half_sum(v);
    auto rr = __builtin_amdgcn_permlane32_swap(__float_as_uint(v), __float_as_uint(v), false, false);
    return __uint_as_float(rr[0]) + __uint_as_float(rr[1]);
}
__device__ __forceinline__ int fresh_tid() { int t = __builtin_amdgcn_workitem_id_x(); asm volatile("" : "+v"(t)); return t; }
#define LDS_WAIT() asm volatile("s_waitcnt lgkmcnt(0)" ::: "memory")


#define XB_TMO      128
#define XB_XCNT(j)  (256  + 64 * (j))
#define XB_XSUB(j)  (1280 + 64 * (j))
#define XB_XGEN(j)  (2304 + 64 * (j))
#define XB_TOP      3328
#define XB_TOPGEN   3392
#define XCD_BAR_WORDS 3456
#define XB_SPIN_CAP (1u << 18)
__device__ __forceinline__ unsigned xb_ld(unsigned* p)              { return __hip_atomic_load(p, __ATOMIC_RELAXED, __HIP_MEMORY_SCOPE_AGENT); }
__device__ __forceinline__ unsigned xb_add(unsigned* p, unsigned v) { return __hip_atomic_fetch_add(p, v, __ATOMIC_RELAXED, __HIP_MEMORY_SCOPE_AGENT); }
__device__ __forceinline__ unsigned xb_xcc_id() { return (unsigned)__builtin_amdgcn_s_getreg((3 << 11) | 20) & 0xFu; }
#define XB_SPIN(cond, bar) do { unsigned _sp = 0; while (cond) { __builtin_amdgcn_s_sleep(1); \
    if ((++_sp & 255u) == 0u) { if (xb_ld(&(bar)[XB_TMO])) break; if (_sp > XB_SPIN_CAP) { atomicAdd(&(bar)[XB_TMO], 1u); break; } } } } while (0)
struct XcdBarrier { unsigned* bar; unsigned x; volatile LAS unsigned* st; };
__device__ __forceinline__ XcdBarrier xcd_barrier_post(unsigned* bar, volatile LAS unsigned* st) {
    XcdBarrier b; b.bar = bar; b.x = xb_xcc_id(); b.st = st;
    if (fresh_tid() == 0) (void)xb_add(&bar[XB_XCNT(b.x)], 1u);
    return b;
}
__device__ __forceinline__ void xcd_barrier_complete(unsigned* bar, unsigned x, unsigned& nloc, unsigned& nx) {
    const unsigned G = gridDim.x * gridDim.y * gridDim.z;
    unsigned sum, cnt, mine, sp = 0u;
    for (;;) {
        sum = 0u; cnt = 0u; mine = 0u;
#pragma unroll
        for (unsigned j = 0; j < 16; ++j) { const unsigned c = xb_ld(&bar[XB_XCNT(j)]); sum += c; cnt += (c > 0u) ? 1u : 0u; mine = (j == x) ? c : mine; }
        if (sum == G) break;
        __builtin_amdgcn_s_sleep(1);
        if ((++sp & 255u) == 0u) { if (xb_ld(&bar[XB_TMO])) break; if (sp > XB_SPIN_CAP) { atomicAdd(&bar[XB_TMO], 1u); break; } }
    }
    nloc = mine > 0u ? mine : 1u; nx = cnt > 0u ? cnt : 1u;
}
__device__ __forceinline__ void xcd_barrier(const XcdBarrier& b) {
    asm volatile("s_waitcnt vmcnt(0)" ::: "memory");
    __syncthreads();
    if (fresh_tid() == 0) {
        unsigned* bar = b.bar;
        __builtin_amdgcn_s_waitcnt(0);
        unsigned nloc = b.st[0], nx = b.st[1];
        if (nloc == 0u) { xcd_barrier_complete(bar, b.x, nloc, nx); b.st[0] = nloc; b.st[1] = nx; }
        const unsigned old = xb_add(&bar[XB_XSUB(b.x)], 1u);
        const unsigned gen = old / nloc;
        if (old + 1u == (gen + 1u) * nloc) {
            __builtin_amdgcn_fence(__ATOMIC_RELEASE, "agent");
            asm volatile("s_waitcnt vmcnt(0)" ::: "memory");
            const unsigned og = xb_add(&bar[XB_TOP], 1u);
            const unsigned tg = og / nx;
            if (og + 1u == (tg + 1u) * nx) xb_add(&bar[XB_TOPGEN], 1u);
            else XB_SPIN(xb_ld(&bar[XB_TOPGEN]) == tg, bar);
            __builtin_amdgcn_fence(__ATOMIC_ACQUIRE, "agent");
            xb_add(&bar[XB_XGEN(b.x)], 1u);
            asm volatile("s_waitcnt vmcnt(0)" ::: "memory");
        } else {
            XB_SPIN(xb_ld(&bar[XB_XGEN(b.x)]) == gen, bar);
            __builtin_amdgcn_fence(__ATOMIC_ACQUIRE, "agent");
            asm volatile("s_waitcnt vmcnt(0)" ::: "memory");
        }
    }
    __syncthreads();
}

namespace pg8 {
constexpr int BM = 256, BK = 64, HALF = 128, HTB = HALF * BK * 2, STAGE_BYTES = 8 * HTB, NXCD = 8, WGM = 8;
__host__ __device__ __forceinline__ int lds_byte(int r, int c) { const int st = (r >> 4) * 2 + (c >> 5), rr = r & 15, cc = c & 31, ob = rr * 64 + cc * 2; return st * 1024 + (ob ^ (((ob >> 9) & 1) << 5)); }
__host__ __device__ __forceinline__ void stage_rc(int b, int& R, int& C) { const int st = b / 1024, sb = b % 1024, swz = sb ^ (((sb >> 9) & 1) << 5); R = (st >> 1) * 16 + swz / 64; C = (st & 1) * 32 + (swz % 64) / 2; }
__host__ __device__ __forceinline__ int perm32(int rho) { const int n = rho >> 4, i = rho & 15; return 8 * (i >> 2) + 4 * n + (i & 3); }
struct Unit { int pm, pn; };
struct Gemm { const bf16_t* A; const bf16_t* Bt; int M, N, K; };

__device__ __forceinline__ void static_map(int L, int nM, int nN, int& pm, int& pn) {
    const int nwg = nM * nN; int wgid = L;
    { const int q = nwg / NXCD, r = nwg % NXCD, xcd = wgid % NXCD, off = wgid / NXCD; wgid = (xcd < r ? xcd * (q + 1) : r * (q + 1) + (xcd - r) * q) + off; }
    const int nig = WGM * nN, gid = wgid / nig, fm = gid * WGM, gsz = (nM - fm) < WGM ? (nM - fm) : WGM;
    pm = fm + ((wgid % nig) % gsz); pn = (wgid % nig) / gsz;
}
struct StaticOrder {
    int nM, nN, nwg, G, c;
    __device__ void init(int M, int N, int G_, int c_) { nM = M / BM; nN = N / BM; nwg = nM * nN; G = G_; c = c_; }
    __device__ bool next(int i, Unit& u) const { const long L = (long)i * G + c; if (L >= nwg) return false; static_map((int)L, nM, nN, u.pm, u.pn); return true; }
    __device__ __forceinline__ void a_ready(const Unit&) const {}
    __device__ __forceinline__ void done(const Unit&) const {}
};
struct BranchOrder {
    int G, c;
    __device__ bool next(int i, Unit& u) const { const long L = (long)(i >> 1) * G + c; if (L >= 512) return false; int pm, pn; static_map((int)L, 64, 8, pm, pn); const int g = i & 1; u.pm = g * 64 + pm; u.pn = g * 8 + pn; return true; }
    __device__ __forceinline__ void a_ready(const Unit&) const {}
    __device__ __forceinline__ void done(const Unit&) const {}
};
struct InFp8Order {
    int G, c;
    __device__ bool next(int i, Unit& u) const { long L; if (G != 256) L = (long)i * G + c; else if (i < 8) L = (long)i * G + c; else if (i == 8 && c >= G / 2) L = 8L * G + (c - G / 2); else return false; if (L >= 2176) return false; static_map((int)L, 64, 34, u.pm, u.pn); return true; }
    __device__ __forceinline__ void a_ready(const Unit&) const {}
    __device__ __forceinline__ void done(const Unit&) const {}
};
struct InBf16Order {
    int G, c;
    __device__ bool next(int i, Unit& u) const { long L; if (G != 256) L = (long)i * G + c; else if (i == 0) L = c; else if (i == 1 && c < G / 2) L = (long)G + c; else return false; if (L >= 384) return false; static_map((int)L, 64, 6, u.pm, u.pn); return true; }
    __device__ __forceinline__ void a_ready(const Unit&) const {}
    __device__ __forceinline__ void done(const Unit&) const {}
};
struct UpOrder {
    int G, c;
    __device__ bool next(int i, Unit& u) const { const long L = (long)i * G + c; if (L >= 2048) return false; const int rd = (int)L >> 8, cc = (int)L & 255, x = cc & 7, k = cc >> 3;
        const int e = 2 * rd + (x >> 2), pn0 = (x & 3) * 4 + (k >> 3), pm0 = k & 7; u.pm = e * 8 + pm0; u.pn = e * 16 + pn0; return true; }
    __device__ __forceinline__ void a_ready(const Unit&) const {}
    __device__ __forceinline__ void done(const Unit&) const {}
};
struct DownOrder {
    int G, c;
    __device__ bool next(int i, Unit& u) const { const long L = (long)i * G + c; if (L >= 1024) return false; const int rd = (int)L >> 8, cc = (int)L & 255, x = cc & 7, k = cc >> 3;
        const int e = 4 * rd + (x >> 1), pn0 = (x & 1) * 4 + (k >> 3), pm0 = k & 7; u.pm = e * 8 + pm0; u.pn = e * 8 + pn0; return true; }
    __device__ __forceinline__ void a_ready(const Unit&) const {}
    __device__ __forceinline__ void done(const Unit&) const {}
};

template <class Epi, class Sched, bool FP8 = false>
__device__ __forceinline__ void gemm_phase(LAS unsigned char* lds, const Gemm g, const Sched& S, const Epi& E) {
    const int tid = fresh_tid(), wid = __builtin_amdgcn_readfirstlane(tid >> 6), lane = tid & 63, wr = wid >> 2, wc = wid & 3, fr = lane & 15, fq = lane >> 4;
    const int K = g.K, nt = FP8 ? K / 128 : K / BK, pitch = FP8 ? K : 2 * K;
    unsigned voffA[2], voffB[2];
#pragma unroll
    for (int i = 0; i < 2; ++i) { int R, C; stage_rc(tid * 16 + i * 8192, R, C); const int Rb = Epi::PERM ? ((R & ~31) + perm32(R & 31)) : R; voffA[i] = (unsigned)(R * pitch + C * 2); voffB[i] = (unsigned)(Rb * pitch + C * 2); }
    const size_t kstep = (size_t)(BK * 2);
    const size_t hstep = (size_t)HALF * pitch;
    const size_t tstep = 2 * hstep;
    const unsigned ldsw = (unsigned)wid * 1024u;
    const int aoff = lds_byte(wr * 64 + fr, fq * 8), boff = lds_byte(wc * 32 + fr, fq * 8);
#define PG8_SA(b, h) (((b) * 2 + (h)) * HTB)
#define PG8_SB(b, h) ((4 + (b) * 2 + (h)) * HTB)
#define PG8_STAGE(bufoff, gbase, voff) do { _Pragma("unroll") for (int _i = 0; _i < 2; ++_i) \
        __builtin_amdgcn_global_load_lds((const unsigned*)((const char*)(gbase) + (voff)[_i]), (LAS unsigned*)(lds + (bufoff) + ldsw + _i * 8192), 16, 0, 0); } while (0)
#define PG8_RD8(addr) __builtin_shufflevector(*(const LAS i32x4*)(addr), *(const LAS i32x4*)((addr) + 1024), 0, 1, 2, 3, 4, 5, 6, 7)
#define PG8_LDA(dst, b, h) do { _Pragma("unroll") for (int m = 0; m < 4; ++m) { if constexpr (FP8) dst##8[m] = PG8_RD8(lds + PG8_SA(b, h) + aoff + m * 2048); \
        else { _Pragma("unroll") for (int k = 0; k < 2; ++k) dst[m][k] = *(const LAS bf16x8*)(lds + PG8_SA(b, h) + aoff + m * 2048 + k * 1024); } } } while (0)
#define PG8_LDB(dst, b, h) do { _Pragma("unroll") for (int n = 0; n < 2; ++n) { if constexpr (FP8) dst##8[n] = PG8_RD8(lds + PG8_SB(b, h) + boff + n * 2048); \
        else { _Pragma("unroll") for (int k = 0; k < 2; ++k) dst[n][k] = *(const LAS bf16x8*)(lds + PG8_SB(b, h) + boff + n * 2048 + k * 1024); } } } while (0)
#define PG8_CAT(v) __builtin_shufflevector(__builtin_bit_cast(i32x4, v[0]), __builtin_bit_cast(i32x4, v[1]), 0, 1, 2, 3, 4, 5, 6, 7)
#define PG8_MMA(ai, bj, At, Bt) do { __builtin_amdgcn_s_setprio(1); _Pragma("unroll") for (int m = 0; m < 4; ++m) _Pragma("unroll") for (int n = 0; n < 2; ++n) { \
        if constexpr (FP8) asm volatile("v_mfma_f32_16x16x128_f8f6f4 %0, %1, %2, %0" : "+v"(acc[ai][bj][m][n]) : "v"(Bt##8[n]), "v"(At##8[m]));   \
        else { _Pragma("unroll") for (int k = 0; k < 2; ++k) acc[ai][bj][m][n] = __builtin_amdgcn_mfma_f32_16x16x32_bf16(Bt[n][k], At[m][k], acc[ai][bj][m][n], 0, 0, 0); } } \
        __builtin_amdgcn_s_setprio(0); } while (0)
#define PG8_WAIT_V(n) asm volatile("s_waitcnt vmcnt(" #n ")" ::: "memory")
#define PG8_WAIT_L(n) asm volatile("s_waitcnt lgkmcnt(" #n ")" ::: "memory")
#define PG8_BAR __builtin_amdgcn_s_barrier()
#define PG8_SCHED __builtin_amdgcn_sched_barrier(0)
    Unit cur, nxt; int ui = 0;
    if (!S.next(0, cur)) return;
    f32x4 acc[2][2][4][2];
#pragma unroll
    for (int a = 0; a < 2; ++a)
#pragma unroll
        for (int b = 0; b < 2; ++b)
#pragma unroll
            for (int m = 0; m < 4; ++m)
#pragma unroll
                for (int n = 0; n < 2; ++n) acc[a][b][m][n] = (f32x4){0.f, 0.f, 0.f, 0.f};
    bf16x8 At[4][2], B0[2][2], B1[2][2]; i32x8 At8[4], B08[2], B18[2];
    const char* cA = (const char*)g.A + (size_t)cur.pm * tstep; const char* cB = (const char*)g.Bt + (size_t)cur.pn * tstep;
    S.a_ready(cur);
    PG8_STAGE(PG8_SB(0, 0), cB, voffB); PG8_STAGE(PG8_SA(0, 0), cA, voffA); PG8_STAGE(PG8_SB(0, 1), cB + hstep, voffB); PG8_STAGE(PG8_SA(0, 1), cA + hstep, voffA);
    if (wr == 1) PG8_BAR;
    PG8_WAIT_V(4); PG8_BAR;
    PG8_STAGE(PG8_SB(1, 0), cB + kstep, voffB); PG8_STAGE(PG8_SA(1, 0), cA + kstep, voffA); PG8_STAGE(PG8_SB(1, 1), cB + hstep + kstep, voffB);
    PG8_WAIT_V(6); PG8_BAR;
    for (;;) {
        const bool has_next = S.next(ui + 1, nxt);
        const char* nA = has_next ? (const char*)g.A + (size_t)nxt.pm * tstep : cA; const char* nB = has_next ? (const char*)g.Bt + (size_t)nxt.pn * tstep : cB;
        for (int t = 0; t < nt; t += 2) {
            const bool last = (t == nt - 2);
            const char* a1 = cA + (size_t)(t + 1) * kstep;
            const char* a2 = last ? nA : cA + (size_t)(t + 2) * kstep; const char* b2 = last ? nB : cB + (size_t)(t + 2) * kstep;
            const char* a3 = a2 + kstep; const char* b3 = b2 + kstep;
            if (last && has_next) S.a_ready(nxt);
            if constexpr (Epi::MID_T > 0) { if (t == Epi::MID_T) { PG8_SCHED; E.mid(acc, cur, wr, wc, fr, fq); PG8_SCHED; } }
            PG8_LDB(B0, 0, 0); PG8_SCHED; PG8_LDA(At, 0, 0); PG8_STAGE(PG8_SA(1, 1), a1 + hstep, voffA);
            PG8_WAIT_L(8); PG8_BAR; PG8_WAIT_L(0); PG8_MMA(0, 0, At, B0); PG8_BAR; PG8_SCHED;
            PG8_LDB(B1, 0, 1); PG8_STAGE(PG8_SB(0, 0), b2, voffB);
            PG8_BAR; PG8_WAIT_L(0); PG8_MMA(0, 1, At, B1); PG8_BAR;
            PG8_LDA(At, 0, 1); PG8_STAGE(PG8_SA(0, 0), a2, voffA);
            PG8_BAR; PG8_WAIT_L(0); PG8_MMA(1, 0, At, B0); PG8_BAR; PG8_SCHED;
            PG8_STAGE(PG8_SB(0, 1), b2 + hstep, voffB);
            PG8_WAIT_V(6); PG8_BAR; PG8_MMA(1, 1, At, B1); PG8_BAR;
            PG8_LDB(B0, 1, 0); PG8_SCHED; PG8_LDA(At, 1, 0); PG8_STAGE(PG8_SA(0, 1), a2 + hstep, voffA);
            PG8_WAIT_L(8); PG8_BAR; PG8_WAIT_L(0); PG8_MMA(0, 0, At, B0); PG8_BAR; PG8_SCHED;
            PG8_LDB(B1, 1, 1); PG8_STAGE(PG8_SB(1, 0), b3, voffB);
            PG8_BAR; PG8_WAIT_L(0); PG8_MMA(0, 1, At, B1); PG8_BAR;
            PG8_LDA(At, 1, 1); PG8_STAGE(PG8_SA(1, 0), a3, voffA);
            PG8_BAR; PG8_WAIT_L(0); PG8_MMA(1, 0, At, B0); PG8_BAR; PG8_SCHED;
            PG8_STAGE(PG8_SB(1, 1), b3 + hstep, voffB);
            PG8_WAIT_V(6); PG8_BAR; PG8_MMA(1, 1, At, B1); PG8_BAR;
        }
        if constexpr (FP8) {
            asm volatile("s_nop 15\n\ts_nop 15\n\ts_nop 15" ::: "memory");
#pragma unroll
            for (int a = 0; a < 2; ++a)
#pragma unroll
                for (int b = 0; b < 2; ++b)
#pragma unroll
                    for (int m = 0; m < 4; ++m)
#pragma unroll
                        for (int n = 0; n < 2; ++n) asm volatile("" : "+v"(acc[a][b][m][n]));
        }
        E(acc, cur, wr, wc, fr, fq); S.done(cur);
        if (!has_next) break;
#pragma unroll
        for (int a = 0; a < 2; ++a)
#pragma unroll
            for (int b = 0; b < 2; ++b)
#pragma unroll
                for (int m = 0; m < 4; ++m)
#pragma unroll
                    for (int n = 0; n < 2; ++n) acc[a][b][m][n] = (f32x4){0.f, 0.f, 0.f, 0.f};
        cur = nxt; cA = nA; cB = nB; ++ui;
    }
    PG8_WAIT_V(0);
    if (wr == 0) PG8_BAR;
    PG8_BAR;
#undef PG8_SA
#undef PG8_SB
#undef PG8_STAGE
#undef PG8_LDA
#undef PG8_RD8
#undef PG8_LDB
#undef PG8_MMA
#undef PG8_CAT
#undef PG8_WAIT_V
#undef PG8_WAIT_L
#undef PG8_BAR
#undef PG8_SCHED
}

__device__ __forceinline__ void st_bf16x4(bf16_t* p, f32x4 v) { u32x2 w; w.x = cvt_pk_bf16(v[0], v[1]); w.y = cvt_pk_bf16(v[2], v[3]); *(u32x2*)p = w; }
__device__ __forceinline__ f32x4 ld_bf16x4(const bf16_t* p) { const u32x2 w = *(const u32x2*)p; return (f32x4){bf_lo(w.x), bf_hi(w.x), bf_lo(w.y), bf_hi(w.y)}; }

__device__ __forceinline__ size_t gf_off(int tile, int wid, int ai, int m, int bj, int lane) { return (size_t)tile * 131072 + wid * 16384 + (ai * 4 + m) * 2048 + bj * 1024 + lane * 16; }
struct EpiZ {
    static constexpr int MID_T = 0; static constexpr bool PERM = true;
    bf16_t* Z; const float* cosA; const float* sinA; const float* cosB; const float* sinB; int pn_off; float sc;
    __device__ __forceinline__ void operator()(const f32x4 (&acc)[2][2][4][2], const Unit& u, int wr, int wc, int fr, int fq) const {
        asm volatile("" : "+v"(fr), "+v"(fq));
        const int pn = u.pn + pn_off;
        const int type = pn < 12 ? 1 : pn < 18 ? 0 : pn < 22 ? 2 : 0;
        const int row0 = u.pm * BM + wr * 64 + fr, col0 = pn * BM + wc * 32 + 8 * fq;
#pragma unroll
        for (int ai = 0; ai < 2; ++ai)
#pragma unroll
            for (int m = 0; m < 4; ++m) {
                const int row = row0 + ai * HALF + m * 16, pos = row & (SEQ - 1);
                f32x4 c0 = {1.f, 1.f, 1.f, 1.f}, s0 = {0.f, 0.f, 0.f, 0.f}, c1 = c0, s1 = s0;
                if (type == 1 && wc == 0) { const float* cp = cosA + pos * 16 + 8 * (fq & 1); const float* sp = sinA + pos * 16 + 8 * (fq & 1);
                    c0 = *(const f32x4*)cp; c1 = *(const f32x4*)(cp + 4); s0 = *(const f32x4*)sp; s1 = *(const f32x4*)(sp + 4); }
                if (type == 2 && (wc & 1) == 0) { const float* cp = cosB + pos * 8; const float* sp = sinB + pos * 8;
                    c0 = *(const f32x4*)cp; c1 = *(const f32x4*)(cp + 4); s0 = *(const f32x4*)sp; s1 = *(const f32x4*)(sp + 4); }
                bf16_t* rowp = Z + (size_t)row * ZC + col0;
#pragma unroll
                for (int bj = 0; bj < 2; ++bj) {
                    f32x4 v0 = acc[ai][bj][m][0] * sc, v1 = acc[ai][bj][m][1] * sc;
                    if (type == 1 && wc == 0) {
                        f32x4 p0, p1;
#pragma unroll
                        for (int j = 0; j < 4; ++j) { p0[j] = __shfl_xor(v0[j], 32); p1[j] = __shfl_xor(v1[j], 32); }
                        if (fq < 2) { v0 = v0 * c0 - p0 * s0; v1 = v1 * c1 - p1 * s1; } else { v0 = v0 * c0 + p0 * s0; v1 = v1 * c1 + p1 * s1; }
                    }
                    if (type == 2 && (wc & 1) == 0) {
                        f32x4 p0, p1;
#pragma unroll
                        for (int j = 0; j < 4; ++j) { p0[j] = swz_xor<16>(v0[j]); p1[j] = swz_xor<16>(v1[j]); }
                        if (fq == 0) { v0 = v0 * c0 - p0 * s0; v1 = v1 * c1 - p1 * s1; } else if (fq == 1) { v0 = v0 * c0 + p0 * s0; v1 = v1 * c1 + p1 * s1; }
                    }
                    u32x4 w; w.x = cvt_pk_bf16(v0[0], v0[1]); w.y = cvt_pk_bf16(v0[2], v0[3]); w.z = cvt_pk_bf16(v1[0], v1[1]); w.w = cvt_pk_bf16(v1[2], v1[3]);
                    *(u32x4*)(rowp + bj * HALF) = w;
                }
            }
    }
};
struct EpiGate {
    static constexpr int MID_T = 0; static constexpr bool PERM = true;
    unsigned char* GF;
    __device__ __forceinline__ void operator()(const f32x4 (&acc)[2][2][4][2], const Unit& u, int wr, int wc, int fr, int fq) const {
        asm volatile("" : "+v"(fr), "+v"(fq));
        const int tile = ((u.pn >> 3) * 64 + u.pm) * 8 + (u.pn & 7), wid = wr * 4 + wc, lane = fq * 16 + fr;
        constexpr float SC = -1.f / (SX8 * SWG8);
#pragma unroll
        for (int ai = 0; ai < 2; ++ai)
#pragma unroll
            for (int m = 0; m < 4; ++m)
#pragma unroll
                for (int bj = 0; bj < 2; ++bj) {
                    f32x4 v0 = acc[ai][bj][m][0], v1 = acc[ai][bj][m][1];
#pragma unroll
                    for (int j = 0; j < 4; ++j) { v0[j] = __builtin_amdgcn_rcpf(1.f + __expf(v0[j] * SC)); v1[j] = __builtin_amdgcn_rcpf(1.f + __expf(v1[j] * SC)); }
                    u32x4 w; w.x = cvt_pk_bf16(v0[0], v0[1]); w.y = cvt_pk_bf16(v0[2], v0[3]); w.z = cvt_pk_bf16(v1[0], v1[1]); w.w = cvt_pk_bf16(v1[2], v1[3]);
                    *(u32x4*)(GF + gf_off(tile, wid, ai, m, bj, lane)) = w;
                }
    }
};
struct EpiInFp8 {
    static constexpr int MID_T = 0; static constexpr bool PERM = true;
    EpiZ z; EpiGate g;
    __device__ __forceinline__ void operator()(const f32x4 (&acc)[2][2][4][2], const Unit& u, int wr, int wc, int fr, int fq) const {
        if (u.pn < 18) z(acc, u, wr, wc, fr, fq);
        else { Unit u2; u2.pm = u.pm; u2.pn = u.pn - 18; g(acc, u2, wr, wc, fr, fq); }
    }
};
struct EpiBranch {
    static constexpr int MID_T = 8; static constexpr bool PERM = true;
    bf16_t* merged; const unsigned char* GF;
    __device__ __forceinline__ void mid(f32x4 (&acc)[2][2][4][2], const Unit& u, int wr, int wc, int fr, int fq) const {
        asm volatile("" : "+v"(fr), "+v"(fq));
        const int t0 = u.pm * 8 + u.pn, wid = wr * 4 + wc, lane = fq * 16 + fr;
#pragma unroll
        for (int ai = 0; ai < 2; ++ai) {
#pragma unroll
            for (int m = 0; m < 4; ++m)
#pragma unroll
                for (int bj = 0; bj < 2; ++bj) {
                    const u32x4 a = *(const u32x4*)(GF + gf_off(t0, wid, ai, m, bj, lane)), b = *(const u32x4*)(GF + gf_off(512 + t0, wid, ai, m, bj, lane));
                    const f32x4 g00 = {bf_lo(a.x), bf_hi(a.x), bf_lo(a.y), bf_hi(a.y)}, g01 = {bf_lo(a.z), bf_hi(a.z), bf_lo(a.w), bf_hi(a.w)};
                    const f32x4 g10 = {bf_lo(b.x), bf_hi(b.x), bf_lo(b.y), bf_hi(b.y)}, g11 = {bf_lo(b.z), bf_hi(b.z), bf_lo(b.w), bf_hi(b.w)};
#pragma unroll
                    for (int j = 0; j < 4; ++j) { acc[ai][bj][m][0][j] *= g00[j] * __builtin_amdgcn_rcpf(g10[j]); acc[ai][bj][m][1][j] *= g01[j] * __builtin_amdgcn_rcpf(g11[j]); }
                }
            asm volatile("" ::: "memory");
        }
    }
    __device__ __forceinline__ void operator()(const f32x4 (&acc)[2][2][4][2], const Unit& u, int wr, int wc, int fr, int fq) const {
        asm volatile("" : "+v"(fr), "+v"(fq));
        const int t1 = 512 + u.pm * 8 + u.pn, wid = wr * 4 + wc, lane = fq * 16 + fr;
        const int row0 = u.pm * BM + wr * 64 + fr, col0 = u.pn * BM + wc * 32 + 8 * fq;
#pragma unroll
        for (int ai = 0; ai < 2; ++ai)
#pragma unroll
            for (int m = 0; m < 4; ++m) {
                bf16_t* mp = merged + (size_t)(row0 + ai * HALF + m * 16) * DM + col0;
#pragma unroll
                for (int bj = 0; bj < 2; ++bj) {
                    const u32x4 b = *(const u32x4*)(GF + gf_off(t1, wid, ai, m, bj, lane));
                    const f32x4 g10 = {bf_lo(b.x), bf_hi(b.x), bf_lo(b.y), bf_hi(b.y)}, g11 = {bf_lo(b.z), bf_hi(b.z), bf_lo(b.w), bf_hi(b.w)};
                    const f32x4 y0 = acc[ai][bj][m][0] * g10, y1 = acc[ai][bj][m][1] * g11;
                    u32x4 w; w.x = cvt_pk_bf16(y0[0], y0[1]); w.y = cvt_pk_bf16(y0[2], y0[3]); w.z = cvt_pk_bf16(y1[0], y1[1]); w.w = cvt_pk_bf16(y1[2], y1[3]);
                    *(u32x4*)(mp + bj * HALF) = w;
                }
            }
    }
};
struct EpiOut {
    static constexpr int MID_T = 0; static constexpr bool PERM = true;
    bf16_t* MIX;
    __device__ __forceinline__ void operator()(const f32x4 (&acc)[2][2][4][2], const Unit& u, int wr, int wc, int fr, int fq) const {
        asm volatile("" : "+v"(fr), "+v"(fq));
        const int row0 = u.pm * BM + wr * 64 + fr, col0 = u.pn * BM + wc * 32 + 8 * fq;
#pragma unroll
        for (int ai = 0; ai < 2; ++ai)
#pragma unroll
            for (int m = 0; m < 4; ++m) {
                bf16_t* rowp = MIX + (size_t)(row0 + ai * HALF + m * 16) * DM + col0;
#pragma unroll
                for (int bj = 0; bj < 2; ++bj) { const f32x4 y0 = acc[ai][bj][m][0], y1 = acc[ai][bj][m][1];
                    u32x4 w; w.x = cvt_pk_bf16(y0[0], y0[1]); w.y = cvt_pk_bf16(y0[2], y0[3]); w.z = cvt_pk_bf16(y1[0], y1[1]); w.w = cvt_pk_bf16(y1[2], y1[3]);
                    *(u32x4*)(rowp + bj * HALF) = w; }
            }
    }
};
struct EpiUp {
    static constexpr int MID_T = 0; static constexpr bool PERM = true;
    unsigned char* H8;
    __device__ __forceinline__ void operator()(const f32x4 (&acc)[2][2][4][2], const Unit& u, int wr, int wc, int fr, int fq) const {
        asm volatile("" : "+v"(fr), "+v"(fq));
        const int pn0 = u.pn & 15;
        const int row0 = u.pm * BM + wr * 64 + fr, col0 = pn0 * HALF + wc * 32 + 8 * fq;
        constexpr float SC = 1.f / (SX8 * SW8);
#pragma unroll
        for (int ai = 0; ai < 2; ++ai)
#pragma unroll
            for (int m = 0; m < 4; ++m) {
                unsigned char* rowp = H8 + (size_t)(row0 + ai * HALF + m * 16) * DM + col0;
                u32x2 w8;
#pragma unroll
                for (int n = 0; n < 2; ++n) {
                    const f32x4 gt = acc[ai][0][m][n] * SC, up = acc[ai][1][m][n] * (SC * SH8); f32x4 h;
#pragma unroll
                    for (int j = 0; j < 4; ++j) h[j] = gt[j] * __builtin_amdgcn_rcpf(1.f + __expf(-gt[j])) * up[j];
                    w8[n] = cvt_pk4_fp8(h[0], h[1], h[2], h[3]);
                }
                *(u32x2*)rowp = w8;
            }
    }
};
struct EpiDown {
    static constexpr int MID_T = 0; static constexpr bool PERM = true;
    bf16_t* YS; const float* gate;
    __device__ __forceinline__ void operator()(const f32x4 (&acc)[2][2][4][2], const Unit& u, int wr, int wc, int fr, int fq) const {
        asm volatile("" : "+v"(fr), "+v"(fq));
        const int pn0 = u.pn & 7;
        const int row0 = u.pm * BM + wr * 64 + fr, col0 = pn0 * BM + wc * 32 + 8 * fq;
#pragma unroll
        for (int ai = 0; ai < 2; ++ai)
#pragma unroll
            for (int m = 0; m < 4; ++m) {
                const int row = row0 + ai * HALF + m * 16; const float gt = gate[row] * (1.f / (SH8 * SW8));
                bf16_t* rowp = YS + (size_t)row * DM + col0;
#pragma unroll
                for (int bj = 0; bj < 2; ++bj) { const f32x4 y0 = acc[ai][bj][m][0] * gt, y1 = acc[ai][bj][m][1] * gt;
                    u32x4 w; w.x = cvt_pk_bf16(y0[0], y0[1]); w.y = cvt_pk_bf16(y0[2], y0[3]); w.z = cvt_pk_bf16(y1[0], y1[1]); w.w = cvt_pk_bf16(y1[2], y1[3]);
                    *(u32x4*)(rowp + bj * HALF) = w; }
            }
    }
};
}


struct BgConv { const float* w0; const float* w1; const float* w2; unsigned char* WGUT; unsigned char* WDT; int NGW; int pad; };
struct BgState { int it, pend, par, tick; };
constexpr int BG_ITEMS = 3 * 65536;
__device__ __forceinline__ void bg_decode(const BgConv bg, int it, const float*& src, unsigned char*& dst) {
    const int mat = it >> 16, r = it & 65535, e = r >> 12, r2 = r & 4095, kb = r2 >> 6, nb = r2 & 63, k0 = 32 * kb, n0 = 32 * nb;
    src = (mat == 0 ? bg.w0 : mat == 1 ? bg.w1 : bg.w2) + ((size_t)e * DM + k0) * DM + n0;
    if (mat == 2) dst = bg.WDT + ((size_t)e * DM + n0) * DM + k0;
    else dst = bg.WGUT + ((size_t)e * 4096 + (n0 >> 7) * 256 + mat * 128 + (n0 & 127)) * DM + k0;
}
template <bool WAIT = true> __device__ __forceinline__ void bg_finish(const BgConv bg, int& pend, int par, LAS unsigned char* scr, int lane) {
    if (pend < 0) return;
    const float* src; unsigned char* dst; bg_decode(bg, pend, src, dst);
    if (WAIT) asm volatile("s_waitcnt vmcnt(0)" ::: "memory");
    const int c = lane & 1, n = lane >> 1;
    const LAS float* s0 = (const LAS float*)(scr + (2 * c) * 1056) + n;
    const LAS float* s1 = (const LAS float*)(scr + (2 * c + 1) * 1056) + n;
    u32x4 o;
    o.x = cvt_pk4_fp8(s0[0 * 32] * SW8, s0[1 * 32] * SW8, s0[2 * 32] * SW8, s0[3 * 32] * SW8); o.y = cvt_pk4_fp8(s0[4 * 32] * SW8, s0[5 * 32] * SW8, s0[6 * 32] * SW8, s0[7 * 32] * SW8);
    o.z = cvt_pk4_fp8(s1[0 * 32] * SW8, s1[1 * 32] * SW8, s1[2 * 32] * SW8, s1[3 * 32] * SW8); o.w = cvt_pk4_fp8(s1[4 * 32] * SW8, s1[5 * 32] * SW8, s1[6 * 32] * SW8, s1[7 * 32] * SW8);
    *(u32x4*)(dst + (size_t)n * DM + 16 * c) = o;
    LDS_WAIT();
    pend = -1;
}
__device__ __forceinline__ void bg_issue(const BgConv bg, int& it, int& pend, int& par, LAS unsigned char* scr, int lane) {
    if (it >= BG_ITEMS) return;
    const float* src; unsigned char* dst; bg_decode(bg, it, src, dst);
    par ^= 1;
    const float* lp = src + (size_t)(lane >> 3) * DM + (lane & 7) * 4;
#pragma unroll
    for (int i = 0; i < 4; ++i) __builtin_amdgcn_global_load_lds((const unsigned*)(lp + (size_t)(8 * i) * DM), (LAS unsigned*)(scr + i * 1056), 16, 0, 0);
    pend = it; it += bg.NGW;
}

namespace att {
#define KSWZ128(row, colB) ((row) * 256 + ((colB) ^ (((row) & 7) << 4)))
#define KSWZ64(row, colB) ((row) * 128 + ((colB) ^ (((row) & 7) << 4)))
#define SBAR() __builtin_amdgcn_sched_barrier(0)
__device__ __forceinline__ int crow(int r, int hi) { return (r & 3) + 8 * (r >> 2) + 4 * hi; }
__device__ __forceinline__ int v_st(int k, int c) { const int kk = (k & ~0xC) | ((k & 4) << 1) | ((k & 8) >> 1); return ((kk >> 3) * 4 + (c >> 5)) * 512 + ((kk & 7) * 32 + (c & 31)) * 2; }
__device__ __forceinline__ int v_rd_base(int lane) { return ((lane & 3) << 3) | (((lane >> 2) & 3) << 6) | (((lane >> 4) & 1) << 5) | (((lane >> 5) & 1) << 8); }
constexpr int v_rd_off(int d0, int ks, int half) { return d0 * 512 + ks * 4096 + half * 2048; }
template <int OFF> __device__ __forceinline__ s16x4 tr_read(int vb) { s16x4 r; asm volatile("ds_read_b64_tr_b16 %0, %1 offset:%2" : "=&v"(r) : "v"(vb), "i"(OFF) : "memory"); return r; }
template <int D0> __device__ __forceinline__ void pv_one(f32x16& od, int vb, bf16x8 pa0, bf16x8 pa1, bf16x8 pa2, bf16x8 pa3) {
    const s16x4 l0 = tr_read<v_rd_off(D0, 0, 0)>(vb), h0 = tr_read<v_rd_off(D0, 0, 1)>(vb), l1 = tr_read<v_rd_off(D0, 1, 0)>(vb), h1 = tr_read<v_rd_off(D0, 1, 1)>(vb);
    const s16x4 l2 = tr_read<v_rd_off(D0, 2, 0)>(vb), h2 = tr_read<v_rd_off(D0, 2, 1)>(vb), l3 = tr_read<v_rd_off(D0, 3, 0)>(vb), h3 = tr_read<v_rd_off(D0, 3, 1)>(vb);
    asm volatile("s_waitcnt lgkmcnt(0)" ::: "memory"); SBAR();
#define PK(L, H) (bf16x8){L[0], L[1], L[2], L[3], H[0], H[1], H[2], H[3]}
    od = __builtin_amdgcn_mfma_f32_32x32x16_bf16(pa0, PK(l0, h0), od, 0, 0, 0);
    od = __builtin_amdgcn_mfma_f32_32x32x16_bf16(pa1, PK(l1, h1), od, 0, 0, 0);
    od = __builtin_amdgcn_mfma_f32_32x32x16_bf16(pa2, PK(l2, h2), od, 0, 0, 0);
    od = __builtin_amdgcn_mfma_f32_32x32x16_bf16(pa3, PK(l3, h3), od, 0, 0, 0);
#undef PK
}

template <int DQK, bool BAND>
__device__ __forceinline__ void attn_pass(const bf16_t* __restrict__ Qw, const bf16_t* __restrict__ Kb, const bf16_t* __restrict__ Vb, size_t kvs,
                                          int ntiles, int key0, int L, int qpos, int t_lo, int t_hi, LAS char* lds, f32x16 (&o)[4], float& m_reg, float& l_reg, const BgConv bg, BgState& bs) {
    constexpr float SCALE = DQK == 128 ? 0.08838834764831845f : 0.125f;
    constexpr float C = SCALE * 1.4426950408889634f;
    constexpr float THR = 8.f;
    constexpr int ND0 = DQK / 16;
    const int tid = fresh_tid(), wid = __builtin_amdgcn_readfirstlane(tid >> 6), lane = tid & 63, r32 = lane & 31, hi = lane >> 5;
    LAS char* V_lds = lds; LAS char* K_lds = lds + 32768;
    LAS float* al_l = (LAS float*)(lds + 65536) + wid * 64;
    LAS unsigned char* bgscr = (LAS unsigned char*)lds + LDS_BG + wid * LDS_BGW;
    bf16x8 qr[ND0];
#pragma unroll
    for (int d0 = 0; d0 < ND0; ++d0) qr[d0] = *(const bf16x8*)(Qw + d0 * 16);
    const int sr = tid >> 4, sc = (tid & 15) * 8, vst0 = v_st(sr, sc), vst1 = v_st(32 + sr, sc);
    const int kr64 = tid >> 3, kc64 = (tid & 7) * 8;
    const int vb0 = (int)(unsigned)(size_t)V_lds + v_rd_base(lane);
    bf16x8 vs0, vs1, ks0, ks1;
#define KPOS(j, row) ({ int _p = key0 + 64 * (j) + (row); if (BAND) { _p = _p < 0 ? 0 : (_p >= L ? L - 1 : _p); } (size_t)_p; })
#define SLOAD(j) do { const size_t _p0 = KPOS(j, sr) * kvs, _p1 = KPOS(j, 32 + sr) * kvs; \
        vs0 = *(const bf16x8*)(Vb + _p0 + sc); vs1 = *(const bf16x8*)(Vb + _p1 + sc); \
        if (DQK == 128) { ks0 = *(const bf16x8*)(Kb + _p0 + sc); ks1 = *(const bf16x8*)(Kb + _p1 + sc); } \
        else { ks0 = *(const bf16x8*)(Kb + KPOS(j, kr64) * kvs + kc64); } } while (0)
#define SWRITE(b) do { *(LAS bf16x8*)(V_lds + (b) * 16384 + vst0) = vs0; *(LAS bf16x8*)(V_lds + (b) * 16384 + vst1) = vs1; \
        if (DQK == 128) { *(LAS bf16x8*)(K_lds + (b) * 16384 + KSWZ128(sr, sc * 2)) = ks0; *(LAS bf16x8*)(K_lds + (b) * 16384 + KSWZ128(32 + sr, sc * 2)) = ks1; } \
        else { *(LAS bf16x8*)(K_lds + (b) * 16384 + KSWZ64(kr64, kc64 * 2)) = ks0; } } while (0)
    __syncthreads();
    SLOAD(0); SWRITE(0);
    for (int j = 0; j < ntiles; ++j) {
        __syncthreads();
        constexpr bool SHADOW = (DQK == 64);
        if (SHADOW) { if (bs.pend >= 0) asm volatile("s_waitcnt vmcnt(0)" ::: "memory"); }
        else bg_finish<true>(bg, bs.pend, bs.par, bgscr, lane);
        if (j + 1 < ntiles) SLOAD(j + 1);
#define BG_STEP() do { bg_finish<false>(bg, bs.pend, bs.par, bgscr, lane); if (bs.tick != 2) bg_issue(bg, bs.it, bs.pend, bs.par, bgscr, lane); bs.tick = bs.tick == 2 ? 0 : bs.tick + 1; } while (0)
        if (!SHADOW || (BAND && !(j >= t_lo && j <= t_hi))) BG_STEP();
        if (!BAND || (j >= t_lo && j <= t_hi)) {
            const LAS char* Kt = K_lds + (j & 1) * 16384;
            f32x16 p0 = {}, p1 = {};
#pragma unroll
            for (int d0 = 0; d0 < ND0; ++d0) { const int cb = (d0 * 16 + hi * 8) * 2;
                const bf16x8 b0 = *(const LAS bf16x8*)(Kt + (DQK == 128 ? KSWZ128(r32, cb) : KSWZ64(r32, cb)));
                const bf16x8 b1 = *(const LAS bf16x8*)(Kt + (DQK == 128 ? KSWZ128(32 + r32, cb) : KSWZ64(32 + r32, cb)));
                p0 = __builtin_amdgcn_mfma_f32_32x32x16_bf16(b0, qr[d0], p0, 0, 0, 0);
                p1 = __builtin_amdgcn_mfma_f32_32x32x16_bf16(b1, qr[d0], p1, 0, 0, 0); }
            if (SHADOW) { SBAR(); BG_STEP(); SBAR(); }
            unsigned vmask = 0xffffffffu;
            if (BAND) { vmask = 0u; const int kb = key0 + 64 * j;
#pragma unroll
                for (int r = 0; r < 16; ++r) { const int k0p = kb + crow(r, hi), k1p = k0p + 32; const int d0p = qpos - k0p, d1p = qpos - k1p;
                    const bool v0 = (d0p <= 64) && (d0p >= -64) && (k0p >= 0) && (k0p < L), v1 = (d1p <= 64) && (d1p >= -64) && (k1p >= 0) && (k1p < L);
                    vmask |= (v0 ? 1u : 0u) << r; vmask |= (v1 ? 1u : 0u) << (16 + r);
                    p0[r] = v0 ? p0[r] : -1e30f; p1[r] = v1 ? p1[r] : -1e30f; } }
            float pmax = p0[0];
#pragma unroll
            for (int r = 1; r < 16; ++r) pmax = fmaxf(pmax, p0[r]);
#pragma unroll
            for (int r = 0; r < 16; ++r) pmax = fmaxf(pmax, p1[r]);
            { auto rr = __builtin_amdgcn_permlane32_swap(__float_as_uint(pmax), __float_as_uint(pmax), false, false); pmax = fmaxf(__uint_as_float(rr[0]), __uint_as_float(rr[1])); }
            float mn, alpha;
            if (__all(pmax - m_reg <= THR / SCALE)) { mn = m_reg; alpha = 1.f; }
            else { mn = fmaxf(m_reg, pmax); alpha = __builtin_amdgcn_exp2f((m_reg - mn) * C); m_reg = mn; }
            const float mnC = -mn * C;
#pragma unroll
            for (int r = 0; r < 16; ++r) { p0[r] = __builtin_amdgcn_exp2f(fmaf(p0[r], C, mnC)); p1[r] = __builtin_amdgcn_exp2f(fmaf(p1[r], C, mnC)); }
            if (BAND) {
#pragma unroll
                for (int r = 0; r < 16; ++r) { p0[r] = ((vmask >> r) & 1u) ? p0[r] : 0.f; p1[r] = ((vmask >> (16 + r)) & 1u) ? p1[r] : 0.f; } }
            float ps = 0.f;
#pragma unroll
            for (int r = 0; r < 16; ++r) ps += p0[r];
#pragma unroll
            for (int r = 0; r < 16; ++r) ps += p1[r];
            { auto rr = __builtin_amdgcn_permlane32_swap(__float_as_uint(ps), __float_as_uint(ps), false, false); ps = __uint_as_float(rr[0]) + __uint_as_float(rr[1]); }
            l_reg = l_reg * alpha + ps;
            bf16x8 pa0, pa1, pa2, pa3;
#define PK4(P, BASE, OUT) do { unsigned a0 = cvt_pk_bf16(P[BASE + 0], P[BASE + 1]), a1 = cvt_pk_bf16(P[BASE + 2], P[BASE + 3]); \
        unsigned b0 = cvt_pk_bf16(P[BASE + 4], P[BASE + 5]), b1 = cvt_pk_bf16(P[BASE + 6], P[BASE + 7]); \
        auto r0 = __builtin_amdgcn_permlane32_swap(a0, b0, false, false); auto r1 = __builtin_amdgcn_permlane32_swap(a1, b1, false, false); \
        u32x4 w = {r0[0], r1[0], r0[1], r1[1]}; OUT = *reinterpret_cast<bf16x8*>(&w); } while (0)
            PK4(p0, 0, pa0); PK4(p0, 8, pa1); PK4(p1, 0, pa2); PK4(p1, 8, pa3);
#undef PK4
            if (__any(alpha < 1.f)) {
                if (hi == 0) al_l[r32] = alpha;
                LDS_WAIT();
#pragma unroll
                for (int r = 0; r < 16; ++r) { const float a = al_l[crow(r, hi)];
#pragma unroll
                    for (int d = 0; d < 4; ++d) o[d][r] *= a; }
            }
            const int vb = vb0 + (j & 1) * 16384;
            pv_one<0>(o[0], vb, pa0, pa1, pa2, pa3); pv_one<1>(o[1], vb, pa0, pa1, pa2, pa3); pv_one<2>(o[2], vb, pa0, pa1, pa2, pa3); pv_one<3>(o[3], vb, pa0, pa1, pa2, pa3);
        }
        if (j + 1 < ntiles) SWRITE((j + 1) & 1);
    }
#undef BG_STEP
#undef KPOS
#undef SLOAD
#undef SWRITE
}

__device__ __forceinline__ void attn_pass_band_dma(const bf16_t* __restrict__ Qw, const bf16_t* __restrict__ Kb, const bf16_t* __restrict__ Vb, size_t kvs,
                                                   int key0, int L, int qpos, int t_lo, int t_hi, LAS char* lds, f32x16 (&o)[4], float& m_reg, float& l_reg, const BgConv bg, BgState& bs) {
    constexpr int DQK = 128, ND0 = 8, ntiles = 6; constexpr bool BAND = true;
    constexpr float SCALE = 0.08838834764831845f, C = SCALE * 1.4426950408889634f, THR = 8.f;
    const int tid = fresh_tid(), wid = __builtin_amdgcn_readfirstlane(tid >> 6), lane = tid & 63, r32 = lane & 31, hi = lane >> 5;
    LAS char* V_lds = lds; LAS char* K_lds = lds + 49152;
    LAS float* al_l = (LAS float*)(lds + 98304) + wid * 64;
    bf16x8 qr[ND0];
#pragma unroll
    for (int d0 = 0; d0 < ND0; ++d0) qr[d0] = *(const bf16x8*)(Qw + d0 * 16);
    const int vb0 = (int)(unsigned)(size_t)V_lds + v_rd_base(lane);
    int vrow[2], vcol[2], krow[2], kcol[2];
#pragma unroll
    for (int i = 0; i < 2; ++i) { const int g = (i * 8 + wid) * 64 + lane;
        const int sub = g >> 5, within = g & 31, kk = (sub >> 2) * 8 + (within >> 2);
        vrow[i] = (kk & ~0xC) | ((kk & 4) << 1) | ((kk & 8) >> 1); vcol[i] = (sub & 3) * 32 + (within & 3) * 8;
        krow[i] = g >> 4; kcol[i] = (((g & 15) ^ (krow[i] & 7))) * 8; }
#define KPOSC(j, row) ({ int _p = key0 + 64 * (j) + (row); _p = _p < 0 ? 0 : (_p >= L ? L - 1 : _p); (size_t)_p; })
#define DMA_TILE(j, b) do { _Pragma("unroll") for (int _i = 0; _i < 2; ++_i) { \
        __builtin_amdgcn_global_load_lds((const unsigned*)(Vb + KPOSC(j, vrow[_i]) * kvs + vcol[_i]), (LAS unsigned*)(V_lds + (b) * 16384 + (_i * 8 + wid) * 1024), 16, 0, 0); \
        __builtin_amdgcn_global_load_lds((const unsigned*)(Kb + KPOSC(j, krow[_i]) * kvs + kcol[_i]), (LAS unsigned*)(K_lds + (b) * 16384 + (_i * 8 + wid) * 1024), 16, 0, 0); } } while (0)
    asm volatile("s_waitcnt vmcnt(0) lgkmcnt(0)" ::: "memory"); __builtin_amdgcn_s_barrier(); asm volatile("" ::: "memory");
    DMA_TILE(0, 0); DMA_TILE(1, 1);
    int cur = 0;
    for (int j = 0; j < ntiles; ++j) {
        if (j + 1 < ntiles) asm volatile("s_waitcnt vmcnt(4)" ::: "memory"); else asm volatile("s_waitcnt vmcnt(0)" ::: "memory");
        asm volatile("s_waitcnt lgkmcnt(0)" ::: "memory"); __builtin_amdgcn_s_barrier(); asm volatile("" ::: "memory");
        { LAS unsigned char* bgscr = (LAS unsigned char*)lds + LDS_BG + wid * LDS_BGW;
          bg_finish<false>(bg, bs.pend, bs.par, bgscr, lane);
          if (j + 1 < ntiles) bg_issue(bg, bs.it, bs.pend, bs.par, bgscr, lane); }
        if (j + 2 < ntiles) { const int nb = cur == 0 ? 2 : cur - 1; DMA_TILE(j + 2, nb); }
        if (j >= t_lo && j <= t_hi) {
            const LAS char* Kt = K_lds + cur * 16384;
            f32x16 p0 = {}, p1 = {};
#pragma unroll
            for (int d0 = 0; d0 < ND0; ++d0) { const int cb = (d0 * 16 + hi * 8) * 2;
                const bf16x8 b0 = *(const LAS bf16x8*)(Kt + (DQK == 128 ? KSWZ128(r32, cb) : KSWZ64(r32, cb)));
                const bf16x8 b1 = *(const LAS bf16x8*)(Kt + (DQK == 128 ? KSWZ128(32 + r32, cb) : KSWZ64(32 + r32, cb)));
                p0 = __builtin_amdgcn_mfma_f32_32x32x16_bf16(b0, qr[d0], p0, 0, 0, 0);
                p1 = __builtin_amdgcn_mfma_f32_32x32x16_bf16(b1, qr[d0], p1, 0, 0, 0); }
            unsigned vmask = 0xffffffffu;
            if (BAND) { vmask = 0u; const int kb = key0 + 64 * j;
#pragma unroll
                for (int r = 0; r < 16; ++r) { const int k0p = kb + crow(r, hi), k1p = k0p + 32; const int d0p = qpos - k0p, d1p = qpos - k1p;
                    const bool v0 = (d0p <= 64) && (d0p >= -64) && (k0p >= 0) && (k0p < L), v1 = (d1p <= 64) && (d1p >= -64) && (k1p >= 0) && (k1p < L);
                    vmask |= (v0 ? 1u : 0u) << r; vmask |= (v1 ? 1u : 0u) << (16 + r);
                    p0[r] = v0 ? p0[r] : -1e30f; p1[r] = v1 ? p1[r] : -1e30f; } }
            float pmax = p0[0];
#pragma unroll
            for (int r = 1; r < 16; ++r) pmax = fmaxf(pmax, p0[r]);
#pragma unroll
            for (int r = 0; r < 16; ++r) pmax = fmaxf(pmax, p1[r]);
            { auto rr = __builtin_amdgcn_permlane32_swap(__float_as_uint(pmax), __float_as_uint(pmax), false, false); pmax = fmaxf(__uint_as_float(rr[0]), __uint_as_float(rr[1])); }
            float mn, alpha;
            if (__all(pmax - m_reg <= THR / SCALE)) { mn = m_reg; alpha = 1.f; }
            else { mn = fmaxf(m_reg, pmax); alpha = __builtin_amdgcn_exp2f((m_reg - mn) * C); m_reg = mn; }
            const float mnC = -mn * C;
#pragma unroll
            for (int r = 0; r < 16; ++r) { p0[r] = __builtin_amdgcn_exp2f(fmaf(p0[r], C, mnC)); p1[r] = __builtin_amdgcn_exp2f(fmaf(p1[r], C, mnC)); }
            if (BAND) {
#pragma unroll
                for (int r = 0; r < 16; ++r) { p0[r] = ((vmask >> r) & 1u) ? p0[r] : 0.f; p1[r] = ((vmask >> (16 + r)) & 1u) ? p1[r] : 0.f; } }
            float ps = 0.f;
#pragma unroll
            for (int r = 0; r < 16; ++r) ps += p0[r];
#pragma unroll
            for (int r = 0; r < 16; ++r) ps += p1[r];
            { auto rr = __builtin_amdgcn_permlane32_swap(__float_as_uint(ps), __float_as_uint(ps), false, false); ps = __uint_as_float(rr[0]) + __uint_as_float(rr[1]); }
            l_reg = l_reg * alpha + ps;
            bf16x8 pa0, pa1, pa2, pa3;
#define PK4(P, BASE, OUT) do { unsigned a0 = cvt_pk_bf16(P[BASE + 0], P[BASE + 1]), a1 = cvt_pk_bf16(P[BASE + 2], P[BASE + 3]); \
        unsigned b0 = cvt_pk_bf16(P[BASE + 4], P[BASE + 5]), b1 = cvt_pk_bf16(P[BASE + 6], P[BASE + 7]); \
        auto r0 = __builtin_amdgcn_permlane32_swap(a0, b0, false, false); auto r1 = __builtin_amdgcn_permlane32_swap(a1, b1, false, false); \
        u32x4 w = {r0[0], r1[0], r0[1], r1[1]}; OUT = *reinterpret_cast<bf16x8*>(&w); } while (0)
            PK4(p0, 0, pa0); PK4(p0, 8, pa1); PK4(p1, 0, pa2); PK4(p1, 8, pa3);
#undef PK4
            if (__any(alpha < 1.f)) {
                if (hi == 0) al_l[r32] = alpha;
                LDS_WAIT();
#pragma unroll
                for (int r = 0; r < 16; ++r) { const float a = al_l[crow(r, hi)];
#pragma unroll
                    for (int d = 0; d < 4; ++d) o[d][r] *= a; }
            }
            const int vb = vb0 + cur * 16384;
            pv_one<0>(o[0], vb, pa0, pa1, pa2, pa3); pv_one<1>(o[1], vb, pa0, pa1, pa2, pa3); pv_one<2>(o[2], vb, pa0, pa1, pa2, pa3); pv_one<3>(o[3], vb, pa0, pa1, pa2, pa3);
        }
        cur = cur == 2 ? 0 : cur + 1;
    }
    asm volatile("s_waitcnt vmcnt(0) lgkmcnt(0)" ::: "memory");
#undef KPOSC
#undef DMA_TILE
}
}

__device__ __forceinline__ void transpose_item(const float* __restrict__ src, int N, bf16_t* __restrict__ dst, int dK, LAS float* scr, int lane) {
#pragma unroll 8
    for (int i = 0; i < 32; ++i) { const int kk = 2 * i + (lane >> 5); scr[kk * 33 + (lane & 31)] = src[(size_t)kk * N + (lane & 31)]; }
    LDS_WAIT();
    const int c = lane & 7;
#pragma unroll
    for (int j = 0; j < 4; ++j) { const int n = (lane >> 3) + 8 * j; const LAS float* s = scr + (8 * c) * 33 + n;
        u32x4 o; o.x = cvt_pk_bf16(s[0 * 33], s[1 * 33]); o.y = cvt_pk_bf16(s[2 * 33], s[3 * 33]); o.z = cvt_pk_bf16(s[4 * 33], s[5 * 33]); o.w = cvt_pk_bf16(s[6 * 33], s[7 * 33]);
        *(u32x4*)(dst + (size_t)n * dK + 8 * c) = o; }
    LDS_WAIT();
}

__device__ __forceinline__ void transpose_item_fp8(const float* __restrict__ src, int N, unsigned char* __restrict__ dst, int dK, float sc, LAS float* scr, int lane) {
#pragma unroll 8
    for (int i = 0; i < 32; ++i) { const int kk = 2 * i + (lane >> 5); scr[kk * 33 + (lane & 31)] = src[(size_t)kk * N + (lane & 31)]; }
    LDS_WAIT();
    const int c = lane & 7;
#pragma unroll
    for (int j = 0; j < 4; ++j) { const int n = (lane >> 3) + 8 * j; const LAS float* s = scr + (8 * c) * 33 + n;
        u32x2 o; o.x = cvt_pk4_fp8(s[0 * 33] * sc, s[1 * 33] * sc, s[2 * 33] * sc, s[3 * 33] * sc); o.y = cvt_pk4_fp8(s[4 * 33] * sc, s[5 * 33] * sc, s[6 * 33] * sc, s[7 * 33] * sc);
        *(u32x2*)(dst + (size_t)n * dK + 8 * c) = o; }
    LDS_WAIT();
}

__device__ __forceinline__ void phase0(const Params& p, LAS unsigned char* lds, int vcu, int G) {
    unsigned char* ws = p.ws;
    const int tid = fresh_tid(), wave = tid >> 6, lane = tid & 63;
    const int gw = vcu * 8 + wave, NGW = G * 8;
    LAS float* scr = (LAS float*)(lds + wave * 8448);
    { const float* x = p.in[0]; bf16_t* xb = (bf16_t*)(ws + WS_XB); const size_t n8 = (size_t)T_TOK * DM / 8;
      for (size_t i = (size_t)blockIdx.x * NTHREADS + tid; i < n8; i += (size_t)G * NTHREADS) {
          const f32x4 a = *(const f32x4*)(x + i * 8), b = *(const f32x4*)(x + i * 8 + 4);
          u32x4 o; o.x = cvt_pk_bf16(a[0], a[1]); o.y = cvt_pk_bf16(a[2], a[3]); o.z = cvt_pk_bf16(b[0], b[1]); o.w = cvt_pk_bf16(b[2], b[3]);
          *(u32x4*)(xb + i * 8) = o;
          u32x2 o8; o8.x = cvt_pk4_fp8(a[0] * SX8, a[1] * SX8, a[2] * SX8, a[3] * SX8); o8.y = cvt_pk4_fp8(b[0] * SX8, b[1] * SX8, b[2] * SX8, b[3] * SX8);
          *(u32x2*)(ws + WS_X8 + i * 8) = o8; } }
    { const float* w_in = p.in[1]; const float* w_br = p.in[7]; const float* w_out = p.in[8];
      bf16_t* WINT = (bf16_t*)(ws + WS_WINT); bf16_t* WBT = (bf16_t*)(ws + WS_WBT); bf16_t* WOT = (bf16_t*)(ws + WS_WOT);
      for (int it = gw; it < 10240 + 1024 + 2048; it += NGW) {
          int r = it;
          if (r < 10240) { const int kb = r / 320, nb = r % 320;
              if (nb >= 144 && nb < 192) transpose_item(w_in + (size_t)(64 * kb) * ZC + 32 * nb, ZC, WINT + (size_t)(32 * nb) * DM + 64 * kb, DM, scr, lane);
              else transpose_item_fp8(w_in + (size_t)(64 * kb) * ZC + 32 * nb, ZC, ws + WS_WING8 + (size_t)(32 * (nb < 144 ? nb : nb - 48)) * DM + 64 * kb, DM, SWG8, scr, lane);
              continue; }
          r -= 10240;
          if (r < 1024) { const int g = r >> 9, r2 = r & 511, kb = r2 >> 6, nb = r2 & 63; transpose_item(w_br + ((size_t)g * 512 + 64 * kb) * DM + 32 * nb, DM, WBT + (size_t)(32 * nb) * 1024 + g * 512 + 64 * kb, 1024, scr, lane); continue; }
          r -= 1024;
          { const int kb = r >> 6, nb = r & 63; transpose_item(w_out + (size_t)(64 * kb) * DM + 32 * nb, DM, WOT + (size_t)(32 * nb) * DM + 64 * kb, DM, scr, lane); }
      } }
    { float* cosA = (float*)(ws + WS_COSA); float* sinA = (float*)(ws + WS_SINA); float* cosB = (float*)(ws + WS_COSB); float* sinB = (float*)(ws + WS_SINB);
      const int gt = blockIdx.x * NTHREADS + tid, NGT = G * NTHREADS;
      for (int i = gt; i < SEQ * 16; i += NGT) { const int pos = i >> 4, k = i & 15; const float inv = (float)pow(500000.0, -(double)k / 16.0); const float ang = (float)pos * inv; cosA[i] = cosf(ang); sinA[i] = sinf(ang); }
      for (int i = gt; i < SEQ * 8; i += NGT) { const int pos = i >> 3, k = i & 7; const float inv = (float)pow(500000.0, -(double)k / 8.0); const float ang = (float)pos * inv; cosB[i] = cosf(ang); sinB[i] = sinf(ang); }
      const float* wr = p.in[11]; float* wrt = (float*)(ws + WS_WRT);
      for (int i = gt; i < NE * DM; i += NGT) { const int e = i >> 11, d = i & (DM - 1); wrt[i] = wr[d * NE + e]; } }
}

__device__ __forceinline__ void moe_weight_convert(LAS unsigned char* lds, const BgConv bg, BgState& bs) {
    const int tid = fresh_tid(), wave = __builtin_amdgcn_readfirstlane(tid >> 6), lane = tid & 63;
    LAS unsigned char* scr = lds + LDS_BG + wave * LDS_BGW;
    for (;;) { bg_finish(bg, bs.pend, bs.par, scr, lane); if (bs.it >= BG_ITEMS) break; bg_issue(bg, bs.it, bs.pend, bs.par, scr, lane); }
}
__device__ __forceinline__ void bg_drain(LAS unsigned char* lds, const BgConv bg, BgState& bs) {
    const int tid = fresh_tid(), wave = __builtin_amdgcn_readfirstlane(tid >> 6), lane = tid & 63;
    bg_finish(bg, bs.pend, bs.par, lds + LDS_BG + wave * LDS_BGW, lane);
}

__device__ __forceinline__ void dil_item(const Params& p, LAS unsigned char* lds, int idx, const BgConv bg, BgState& bs) {
    using namespace att;
    unsigned char* ws = p.ws;
    const bf16_t* Z = (const bf16_t*)(ws + WS_Z); bf16_t* OG = (bf16_t*)(ws + WS_OG); float* LSEG = (float*)(ws + WS_LSEG);
    const int tid = fresh_tid(), wid = __builtin_amdgcn_readfirstlane(tid >> 6), lane = tid & 63, r32 = lane & 31, hi = lane >> 5;
    const int sub = idx & 15, h = (idx >> 4) & 3, bgi = idx >> 6, g = bgi % 3, b = bgi / 3;
    const int lr = g * 2, r = 1 << lr, L = SEQ >> lr, phase = sub & (r - 1), qb = sub >> lr;
    const int head = g * 4 + h;
    const int qpos = qb * 256 + wid * 32 + r32;
    const size_t tokq = (size_t)b * SEQ + phase + (size_t)r * qpos;
    const bf16_t* Qw = Z + tokq * ZC + head * 128 + hi * 8;
    const bf16_t* Kb = Z + ((size_t)b * SEQ + phase) * ZC + 1536 + head * 128;
    const bf16_t* Vb = Z + ((size_t)b * SEQ + phase) * ZC + 3072 + head * 128;
    f32x16 o[4] = {}; float m_reg = -1e30f, l_reg = 0.f;
    attn_pass_band_dma(Qw, Kb, Vb, (size_t)r * ZC, qb * 256 - 64, L, qpos, wid >> 1, (wid >> 1) + 2, (LAS char*)lds, o, m_reg, l_reg, bg, bs);
    LAS float* li_l = (LAS float*)(lds + 98304) + wid * 64 + 32;
    int r32e = r32, hie = hi; asm volatile("" : "+v"(r32e), "+v"(hie));
    if (hie == 0) { li_l[r32e] = l_reg; const size_t tq = (size_t)b * SEQ + phase + (size_t)r * (qb * 256 + wid * 32 + r32e); LSEG[((size_t)g * T_TOK + tq) * 4 + h] = m_reg * 0.08838834764831845f + __logf(l_reg); }
    LDS_WAIT();
#pragma unroll
    for (int rr = 0; rr < 16; ++rr) { const int row = crow(rr, hie); const float rl = 1.f / li_l[row];
        const size_t tok = (size_t)b * SEQ + phase + (size_t)r * (qb * 256 + wid * 32 + row);
        bf16_t* op = OG + ((size_t)g * T_TOK + tok) * 512 + h * 128 + r32e;
#pragma unroll
        for (int d0 = 0; d0 < 4; ++d0) op[d0 * 32] = f2bf(o[d0][rr] * rl);
        asm volatile("" ::: "memory"); }
    LDS_WAIT();
}

__device__ __forceinline__ void diff_item(const Params& p, LAS unsigned char* lds, int item, const BgConv bg, BgState& bs) {
    using namespace att;
    unsigned char* ws = p.ws;
    const bf16_t* Z = (const bf16_t*)(ws + WS_Z); float* O0 = (float*)(ws + WS_O0); bf16_t* BR = (bf16_t*)(ws + WS_BR);
    const int tid = fresh_tid(), wid = __builtin_amdgcn_readfirstlane(tid >> 6), lane = tid & 63, r32 = lane & 31, hi = lane >> 5;
    const int b = item >> 6, h = (item >> 4) & 3, qb = item & 15;
    const size_t tok0 = (size_t)b * SEQ + qb * 256 + wid * 32;
    LAS float* li_l = (LAS float*)(lds + 65536) + wid * 64 + 32;
    for (int c = 0; c < 2; ++c) {
        const bf16_t* Qw = Z + (tok0 + r32) * ZC + 4608 + h * 128 + c * 64 + hi * 8;
        const bf16_t* Kb = Z + ((size_t)b * SEQ) * ZC + 5120 + h * 128 + c * 64;
        const bf16_t* Vb = Z + ((size_t)b * SEQ) * ZC + 5632 + h * 128;
        f32x16 o[4] = {}; float m_reg = -1e30f, l_reg = 0.f;
        attn_pass<64, false>(Qw, Kb, Vb, (size_t)ZC, SEQ / 64, 0, SEQ, 0, 0, SEQ / 64 - 1, (LAS char*)lds, o, m_reg, l_reg, bg, bs);
        int r32e = r32, hie = hi, lanee = lane; asm volatile("" : "+v"(r32e), "+v"(hie), "+v"(lanee));
        if (hie == 0) li_l[r32e] = l_reg;
        LDS_WAIT();
        if (c == 0) {
#pragma unroll
            for (int rr = 0; rr < 16; ++rr) { const int row = crow(rr, hie); const float rl = 1.f / li_l[row];
                float* op = O0 + (tok0 + row) * 512 + h * 128 + r32e;
#pragma unroll
                for (int d0 = 0; d0 < 4; ++d0) op[d0 * 32] = o[d0][rr] * rl;
                asm volatile("" ::: "memory"); }
        } else {
            const float s1 = wave_sum(p.in[2][lanee] * p.in[3][lanee]), s2 = wave_sum(p.in[4][lanee] * p.in[5][lanee]);
            const float lam = __expf(s1) - __expf(s2) + 0.2f;
            const float* nw = p.in[6];
            float nwv[4];
#pragma unroll
            for (int d0 = 0; d0 < 4; ++d0) nwv[d0] = nw[d0 * 32 + r32e] * 0.8f;
#pragma unroll
            for (int rr = 0; rr < 16; ++rr) { const int row = crow(rr, hie); const float rl = 1.f / li_l[row];
                const float* ip = O0 + (tok0 + row) * 512 + h * 128 + r32e;
                float v[4], ss = 0.f;
#pragma unroll
                for (int d0 = 0; d0 < 4; ++d0) { v[d0] = ip[d0 * 32] - lam * (o[d0][rr] * rl); ss += v[d0] * v[d0]; }
                ss = half_sum(ss);
                const float rinv = rsqrtf(ss * (1.f / 128.f) + 1e-5f);
                bf16_t* op = BR + (tok0 + row) * 1024 + 512 + h * 128 + r32e;
#pragma unroll
                for (int d0 = 0; d0 < 4; ++d0) op[d0 * 32] = f2bf(v[d0] * rinv * nwv[d0]);
                asm volatile("" ::: "memory"); }
        }
        LDS_WAIT();
    }
}

__device__ __forceinline__ void combine_rows(const Params& p, int vcu, int G) {
    unsigned char* ws = p.ws;
    const bf16_t* OG = (const bf16_t*)(ws + WS_OG); const float* LSEG = (const float*)(ws + WS_LSEG); bf16_t* BR = (bf16_t*)(ws + WS_BR);
    const int tid = fresh_tid(), wave = tid >> 6, lane = tid & 63;
    const int h = lane >> 4;
    for (int t = vcu * 8 + wave; t < T_TOK; t += G * 8) {
        const float l0 = LSEG[((size_t)0 * T_TOK + t) * 4 + h], l1 = LSEG[((size_t)1 * T_TOK + t) * 4 + h], l2 = LSEG[((size_t)2 * T_TOK + t) * 4 + h];
        const float mx = fmaxf(l0, fmaxf(l1, l2)); float w0 = __expf(l0 - mx), w1 = __expf(l1 - mx), w2 = __expf(l2 - mx); const float inv = 1.f / (w0 + w1 + w2); w0 *= inv; w1 *= inv; w2 *= inv;
        const u32x4 a = *(const u32x4*)(OG + ((size_t)0 * T_TOK + t) * 512 + lane * 8), bq = *(const u32x4*)(OG + ((size_t)1 * T_TOK + t) * 512 + lane * 8), cq = *(const u32x4*)(OG + ((size_t)2 * T_TOK + t) * 512 + lane * 8);
        u32x4 o;
#pragma unroll
        for (int k = 0; k < 4; ++k) { const float lo = w0 * bf_lo(a[k]) + w1 * bf_lo(bq[k]) + w2 * bf_lo(cq[k]), hi2 = w0 * bf_hi(a[k]) + w1 * bf_hi(bq[k]) + w2 * bf_hi(cq[k]); o[k] = cvt_pk_bf16(lo, hi2); }
        *(u32x4*)(BR + (size_t)t * 1024 + lane * 8) = o;
    }
}

__device__ __forceinline__ void ln1_router(const Params& p, LAS unsigned char* lds, int vcu, int G) {
    unsigned char* ws = p.ws;
    const float* V1 = p.in[0]; const bf16_t* MIX = (const bf16_t*)(ws + WS_MIX); unsigned char* X1B = ws + WS_X1B;     const float* wrt = (const float*)(ws + WS_WRT); float* AFFT = (float*)(ws + WS_AFFT);
    const float* g1 = p.in[9]; const float* b1 = p.in[10];
    const int tid = fresh_tid(), wave = tid >> 6, lane = tid & 63;
    __syncthreads();
    for (int i = tid; i < NE * DM / 4; i += NTHREADS) ((LAS f32x4*)lds)[i] = ((const f32x4*)wrt)[i];
    __syncthreads();
    for (int rp = vcu * 8 + wave; rp < T_TOK / 4; rp += G * 8) {
        const int t0 = rp * 4;
        f32x4 v[4][8];
#pragma unroll
        for (int q = 0; q < 4; ++q) {
            const float* xr = V1 + (size_t)(t0 + q) * DM + lane * 4; const bf16_t* mr = MIX + (size_t)(t0 + q) * DM + lane * 4; float s = 0.f;
#pragma unroll
            for (int j = 0; j < 8; ++j) { v[q][j] = *(const f32x4*)(xr + 256 * j) * ALPHA + pg8::ld_bf16x4(mr + 256 * j); s += (v[q][j][0] + v[q][j][1]) + (v[q][j][2] + v[q][j][3]); }
            const float mean = wave_sum(s) * (1.f / DM); float s2 = 0.f;
#pragma unroll
            for (int j = 0; j < 8; ++j) { v[q][j] = v[q][j] - mean; s2 += (v[q][j][0] * v[q][j][0] + v[q][j][1] * v[q][j][1]) + (v[q][j][2] * v[q][j][2] + v[q][j][3] * v[q][j][3]); }
            const float rstd = rsqrtf(wave_sum(s2) * (1.f / DM) + LN_EPS);
            unsigned char* xbo = X1B + (size_t)(t0 + q) * DM + lane * 4;
#pragma unroll
            for (int j = 0; j < 8; ++j) { const f32x4 gg = *(const f32x4*)(g1 + lane * 4 + 256 * j), bb = *(const f32x4*)(b1 + lane * 4 + 256 * j);
                v[q][j] = v[q][j] * rstd * gg + bb; *(unsigned*)(xbo + 256 * j) = cvt_pk4_fp8(v[q][j][0] * SX8, v[q][j][1] * SX8, v[q][j][2] * SX8, v[q][j][3] * SX8); }
            asm volatile("" ::: "memory");
        }
        float lg[4] = {0.f, 0.f, 0.f, 0.f};
        const LAS float* wl = (const LAS float*)lds + lane * 4;
#pragma unroll 1
        for (int e = 0; e < NE; ++e) {
            f32x4 W[8];
#pragma unroll
            for (int j = 0; j < 8; ++j) W[j] = *(const LAS f32x4*)(wl + e * DM + 256 * j);
#pragma unroll
            for (int q = 0; q < 4; ++q) { float a = 0.f;
#pragma unroll
                for (int j = 0; j < 8; ++j) a += (v[q][j][0] * W[j][0] + v[q][j][1] * W[j][1]) + (v[q][j][2] * W[j][2] + v[q][j][3] * W[j][3]);
                a = wave_sum(a); lg[q] = (lane == e) ? a : lg[q]; }
        }
#pragma unroll
        for (int q = 0; q < 4; ++q) {
            float mx = lg[q];
            mx = fmaxf(mx, swz_xor<1>(mx)); mx = fmaxf(mx, swz_xor<2>(mx)); mx = fmaxf(mx, swz_xor<4>(mx)); mx = fmaxf(mx, swz_xor<8>(mx));
            const float ex = expf(lg[q] - mx); float sum = ex;
            sum += swz_xor<1>(sum); sum += swz_xor<2>(sum); sum += swz_xor<4>(sum); sum += swz_xor<8>(sum);
            const int t = t0 + q, bb = t >> 12, s = t & (SEQ - 1);
            if (lane < NE) AFFT[((size_t)bb * NE + lane) * SEQ + s] = ex / sum;
        }
    }
}

__device__ __forceinline__ void topk_gather(const Params& p, LAS unsigned char* lds, int G) {
    unsigned char* ws = p.ws;
    const float* AFFT = (const float*)(ws + WS_AFFT); int* SLOT = (int*)(ws + WS_SLOT); float* GATE = (float*)(ws + WS_GATE);
    const unsigned char* X1B = ws + WS_X1B; unsigned char* XG = ws + WS_XG;
    const int tid = fresh_tid(), wave = tid >> 6, lane = tid & 63;
    LAS unsigned* hist = (LAS unsigned*)lds;
    LAS unsigned* ctl = hist + 256;
    LAS unsigned* wtot = hist + 272;
    LAS int* rows = (LAS int*)(hist + 288);
    for (int item = blockIdx.x; item < NB * NE * 4; item += G) {
        const int qd = item & 3, be = item >> 2, b = be >> 4, e = be & 15;
        const float* ap = AFFT + (size_t)be * SEQ + tid * 8;
        const f32x4 fa = *(const f32x4*)ap, fb = *(const f32x4*)(ap + 4);
        float av[8] = {fa[0], fa[1], fa[2], fa[3], fb[0], fb[1], fb[2], fb[3]};
        unsigned key[8];
#pragma unroll
        for (int i = 0; i < 8; ++i) key[i] = __float_as_uint(av[i]);
        unsigned prefix = 0u, mask = 0u, remaining = CAP;
        for (int pass = 0; pass < 4; ++pass) {
            const int shift = 24 - 8 * pass;
            __syncthreads();
            if (tid < 256) hist[tid] = 0u;
            __syncthreads();
#pragma unroll
            for (int i = 0; i < 8; ++i) if ((key[i] & mask) == prefix) atomicAdd((unsigned*)&hist[(key[i] >> shift) & 255u], 1u);
            __syncthreads();
            if (wave == 0) {
                unsigned c0 = hist[4 * lane], c1 = hist[4 * lane + 1], c2 = hist[4 * lane + 2], c3 = hist[4 * lane + 3];
                const unsigned t = c0 + c1 + c2 + c3; unsigned v = t;
#pragma unroll
                for (int of = 1; of < 64; of <<= 1) { const unsigned u = __shfl_down(v, of); if (lane + of < 64) v += u; }
                unsigned cum = v - t;
                unsigned cs[4] = {c0, c1, c2, c3};
#pragma unroll
                for (int k = 3; k >= 0; --k) { if (cum < remaining && cum + cs[k] >= remaining) { ctl[0] = 4 * lane + k; ctl[1] = remaining - cum; } cum += cs[k]; }
            }
            __syncthreads();
            prefix |= ctl[0] << shift; mask |= 0xFFu << shift; remaining = ctl[1];
        }
        const unsigned Tk = prefix, need_eq = remaining, cnt_gt_total = CAP - need_eq;
        unsigned ngt = 0, neq = 0;
#pragma unroll
        for (int i = 0; i < 8; ++i) { ngt += key[i] > Tk ? 1u : 0u; neq += key[i] == Tk ? 1u : 0u; }
        const unsigned packed = ngt | (neq << 16); unsigned incl = packed;
#pragma unroll
        for (int of = 1; of < 64; of <<= 1) { const unsigned u = __shfl_up(incl, of); if (lane >= of) incl += u; }
        __syncthreads();
        if (lane == 63) wtot[wave] = incl;
        __syncthreads();
        unsigned base = 0;
        for (int w = 0; w < wave; ++w) base += wtot[w];
        unsigned excl = base + incl - packed; unsigned rgt = excl & 0xffffu, req = excl >> 16;
        int slots[8];
#pragma unroll
        for (int i = 0; i < 8; ++i) { int sl = -1;
            if (key[i] > Tk) { sl = (int)rgt; ++rgt; } else if (key[i] == Tk) { if (req < need_eq) sl = (int)(cnt_gt_total + req); ++req; }
            slots[i] = sl;
            if (sl >= 0) { if ((sl >> 7) == qd) rows[sl & 127] = tid * 8 + i; if (qd == 0) GATE[(size_t)e * 2048 + b * CAP + sl] = av[i]; } }
        if (qd == 0) { int* sp = SLOT + (size_t)be * SEQ + tid * 8; *(int4*)sp = make_int4(slots[0], slots[1], slots[2], slots[3]); *(int4*)(sp + 4) = make_int4(slots[4], slots[5], slots[6], slots[7]); }
        __syncthreads();
        for (int r = wave; r < 128; r += 8) {
            const int s = rows[r];
            const u32x4* src = (const u32x4*)(X1B + ((size_t)b * SEQ + s) * DM); u32x4* dst = (u32x4*)(XG + ((size_t)e * 2048 + b * CAP + qd * 128 + r) * DM);
#pragma unroll
            for (int j = 0; j < 2; ++j) dst[lane + 64 * j] = src[lane + 64 * j];
        }
    }
}

__device__ __forceinline__ void ln2_rows(const Params& p, int vcu, int G) {
    unsigned char* ws = p.ws;
    const bf16_t* YS = (const bf16_t*)(ws + WS_YS); const int* SLOT = (const int*)(ws + WS_SLOT);
    const float* g2 = p.in[15]; const float* b2 = p.in[16]; float* out = p.out;
    const int tid = fresh_tid(), wave = tid >> 6, lane = tid & 63;
    for (int t = vcu * 8 + wave; t < T_TOK; t += G * 8) {
        const int b = t >> 12, s = t & (SEQ - 1);
        const int myslot = lane < NE ? SLOT[((size_t)b * NE + lane) * SEQ + s] : -1;
        f32x4 v[8];
        const float* xr = p.in[0] + (size_t)t * DM + lane * 4; const bf16_t* mr = (const bf16_t*)(ws + WS_MIX) + (size_t)t * DM + lane * 4;
        { float s0 = 0.f;
#pragma unroll
          for (int j = 0; j < 8; ++j) { const u32x2 mw = __builtin_nontemporal_load((const u32x2*)(mr + 256 * j)); const f32x4 mv = {bf_lo(mw.x), bf_hi(mw.x), bf_lo(mw.y), bf_hi(mw.y)};
              v[j] = __builtin_nontemporal_load((const f32x4*)(xr + 256 * j)) * ALPHA + mv; s0 += (v[j][0] + v[j][1]) + (v[j][2] + v[j][3]); }
          const float mean1 = wave_sum(s0) * (1.f / DM); float q1 = 0.f;
#pragma unroll
          for (int j = 0; j < 8; ++j) { v[j] = v[j] - mean1; q1 += (v[j][0] * v[j][0] + v[j][1] * v[j][1]) + (v[j][2] * v[j][2] + v[j][3] * v[j][3]); }
          const float rstd1 = rsqrtf(wave_sum(q1) * (1.f / DM) + LN_EPS);
#pragma unroll
          for (int j = 0; j < 8; ++j) { const f32x4 gg = *(const f32x4*)(p.in[9] + lane * 4 + 256 * j), bb = *(const f32x4*)(p.in[10] + lane * 4 + 256 * j); v[j] = (v[j] * rstd1 * gg + bb) * ALPHA; } }
        for (int e = 0; e < NE; ++e) {
            const int sl = __builtin_amdgcn_readlane(myslot, e);
            if (sl >= 0) { const bf16_t* yr = YS + ((size_t)e * 2048 + b * CAP + sl) * DM + lane * 4;
#pragma unroll
                for (int j = 0; j < 8; ++j) { const u32x2 yw = __builtin_nontemporal_load((const u32x2*)(yr + 256 * j)); v[j] += (f32x4){bf_lo(yw.x), bf_hi(yw.x), bf_lo(yw.y), bf_hi(yw.y)}; } }
        }
        float sm = 0.f;
#pragma unroll
        for (int j = 0; j < 8; ++j) sm += (v[j][0] + v[j][1]) + (v[j][2] + v[j][3]);
        const float mean = wave_sum(sm) * (1.f / DM); float s2 = 0.f;
#pragma unroll
        for (int j = 0; j < 8; ++j) { v[j] = v[j] - mean; s2 += (v[j][0] * v[j][0] + v[j][1] * v[j][1]) + (v[j][2] * v[j][2] + v[j][3] * v[j][3]); }
        const float rstd = rsqrtf(wave_sum(s2) * (1.f / DM) + LN_EPS);
        float* orow = out + (size_t)t * DM + lane * 4;
#pragma unroll
        for (int j = 0; j < 8; ++j) { const f32x4 gg = *(const f32x4*)(g2 + lane * 4 + 256 * j), bb = *(const f32x4*)(b2 + lane * 4 + 256 * j); __builtin_nontemporal_store(v[j] * rstd * gg + bb, (f32x4*)(orow + 256 * j)); }
    }
}

__global__ void __launch_bounds__(NTHREADS, 2) mega(Params p) {
    extern __shared__ __attribute__((aligned(16))) unsigned char shm[];
    LAS unsigned char* lds = (LAS unsigned char*)shm;
    cg::grid_group grid = cg::this_grid();
    const int G = gridDim.x, bx = blockIdx.x;
    const int vcu = (G % 8 == 0) ? (bx % 8) * (G / 8) + bx / 8 : bx;
    unsigned char* ws = p.ws;
    if (fresh_tid() < 16) ((LAS unsigned*)(lds + LDS_BARW))[fresh_tid()] = 0u;
    __syncthreads();
    const XcdBarrier xb = xcd_barrier_post((unsigned*)(ws + WS_BARW), (volatile LAS unsigned*)(lds + LDS_BARW));

    const BgConv bg{p.in[12], p.in[13], p.in[14], ws + WS_WGUT, ws + WS_WDT, G * 8, 0};
    BgState bs; bs.it = vcu * 8 + __builtin_amdgcn_readfirstlane(fresh_tid() >> 6); bs.pend = -1; bs.par = 0; bs.tick = 0;
    if (PHASE_MASK & 1) REPS(0) phase0(p, lds, vcu, G);
    if (p.ws == nullptr) grid.sync();
    xcd_barrier(xb);
    if (PHASE_MASK & 2) REPS(1) {
      { pg8::Gemm g{(const bf16_t*)(ws + WS_XB), (const bf16_t*)(ws + WS_WINT) + (size_t)4608 * DM, T_TOK, 1536, DM}; pg8::InBf16Order S{G, bx};
        pg8::EpiZ E{(bf16_t*)(ws + WS_Z), (const float*)(ws + WS_COSA), (const float*)(ws + WS_SINA), (const float*)(ws + WS_COSB), (const float*)(ws + WS_SINB), 18, 1.f};
        pg8::gemm_phase(lds, g, S, E); }
      { pg8::Gemm g{(const bf16_t*)(ws + WS_X8), (const bf16_t*)(ws + WS_WING8), T_TOK, 8704, DM}; pg8::InFp8Order S{G, bx};
        pg8::EpiInFp8 E{pg8::EpiZ{(bf16_t*)(ws + WS_Z), (const float*)(ws + WS_COSA), (const float*)(ws + WS_SINA), (const float*)(ws + WS_COSB), (const float*)(ws + WS_SINB), 0, 1.f / (SX8 * SWG8)}, pg8::EpiGate{ws + WS_GF}};
        pg8::gemm_phase<pg8::EpiInFp8, pg8::InFp8Order, true>(lds, g, S, E); } }
    xcd_barrier(xb);
    if (PHASE_MASK & 4) REPS(2) for (int it = vcu; it < 768; it += G) dil_item(p, lds, it, bg, bs);
    bg_drain(lds, bg, bs);
    xcd_barrier(xb);
    if (PHASE_MASK & 8) REPS(3) combine_rows(p, vcu, G);
    if (PHASE_MASK & 16) REPS(4) for (int it = vcu; it < 256; it += G) diff_item(p, lds, it, bg, bs);
    bg_drain(lds, bg, bs);
    xcd_barrier(xb);
    if (PHASE_MASK & 32) REPS(5) { pg8::Gemm g{(const bf16_t*)(ws + WS_BR), (const bf16_t*)(ws + WS_WBT), T_TOK, DM, 1024}; pg8::StaticOrder S; S.init(T_TOK, DM, G, bx);
      pg8::EpiBranch E{(bf16_t*)(ws + WS_MERGED), ws + WS_GF};
      pg8::gemm_phase(lds, g, S, E); }
    xcd_barrier(xb);
    if (PHASE_MASK & 64) REPS(6) { pg8::Gemm g{(const bf16_t*)(ws + WS_MERGED), (const bf16_t*)(ws + WS_WOT), T_TOK, DM, DM}; pg8::StaticOrder S; S.init(T_TOK, DM, G, bx);
      pg8::EpiOut E{(bf16_t*)(ws + WS_MIX)};
      pg8::gemm_phase(lds, g, S, E); }
    xcd_barrier(xb);
    if (PHASE_MASK & 128) moe_weight_convert(lds, bg, bs);
    if (PHASE_MASK & 256) REPS(8) ln1_router(p, lds, vcu, G);
    xcd_barrier(xb);
    if (PHASE_MASK & 512) REPS(9) topk_gather(p, lds, G);
    xcd_barrier(xb);
    if (PHASE_MASK & 1024) REPS(10) { pg8::Gemm g{(const bf16_t*)(ws + WS_XG), (const bf16_t*)(ws + WS_WGUT), NE * 2048, NE * 4096, DM}; pg8::UpOrder S{G, bx};
      pg8::EpiUp E{ws + WS_H};
      pg8::gemm_phase<pg8::EpiUp, pg8::UpOrder, true>(lds, g, S, E); }
    xcd_barrier(xb);
    if (PHASE_MASK & 2048) REPS(11) { pg8::Gemm g{(const bf16_t*)(ws + WS_H), (const bf16_t*)(ws + WS_WDT), NE * 2048, NE * 2048, DM}; pg8::DownOrder S{G, bx};
      pg8::EpiDown E{(bf16_t*)(ws + WS_YS), (const float*)(ws + WS_GATE)};
      pg8::gemm_phase<pg8::EpiDown, pg8::DownOrder, true>(lds, g, S, E); }
    xcd_barrier(xb);
    if (PHASE_MASK & 4096) REPS(12) ln2_rows(p, vcu, G);
}

extern "C" void kernel_launch(void* const* d_in, const int* in_sizes, int n_in, void* d_out, int out_size, void* d_ws, size_t ws_size, hipStream_t stream) {
    static int grid = 0;
    if (grid == 0) {
        if (n_in != 17 || out_size != T_TOK * DM || ws_size < WS_END) { fprintf(stderr, "kernel_launch: unexpected shapes (n_in %d out %d ws %zu, need ws >= %zu)\n", n_in, out_size, ws_size, (size_t)WS_END); grid = -1; return; }
        int dev = 0, cus = 0, per_cu = 0;
        hipGetDevice(&dev); hipDeviceGetAttribute(&cus, hipDeviceAttributeMultiprocessorCount, dev);
        if (hipFuncSetAttribute((const void*)mega, hipFuncAttributeMaxDynamicSharedMemorySize, LDS_BYTES) != hipSuccess) { fprintf(stderr, "kernel_launch: hipFuncSetAttribute failed\n"); grid = -1; return; }
        if (hipOccupancyMaxActiveBlocksPerMultiprocessor(&per_cu, (const void*)mega, NTHREADS, LDS_BYTES) != hipSuccess || per_cu < 1) { fprintf(stderr, "kernel_launch: occupancy query gave %d\n", per_cu); per_cu = 1; }
        (void)hipGetLastError();
        grid = cus * per_cu;
    }
    if (grid < 0) return;
    Params p{};
    for (int i = 0; i < 17; ++i) p.in[i] = (const float*)d_in[i];
    p.out = (float*)d_out; p.ws = (unsigned char*)d_ws;
    void* args[] = {&p};
    if (hipMemsetAsync((char*)d_ws + WS_BARW, 0, XCD_BAR_WORDS * 4, stream) != hipSuccess) { fprintf(stderr, "kernel_launch: memset of the barrier words failed\n"); return; }
    hipError_t e = hipLaunchCooperativeKernel((void*)mega, dim3(grid), dim3(NTHREADS), args, LDS_BYTES, stream);
    if (e != hipSuccess) fprintf(stderr, "cooperative launch failed: %s (grid %d)\n", hipGetErrorString(e), grid);
}
```

```cpp
#include <hip/hip_runtime.h>
#include <hip/hip_cooperative_groups.h>
#include <cstdio>
#include <cstdint>
namespace cg = cooperative_groups;

#define LAS __attribute__((address_space(3)))
typedef unsigned short bf16_t;
typedef short bf16x8 __attribute__((ext_vector_type(8)));
typedef short s16x4 __attribute__((ext_vector_type(4)));
typedef float f32x4 __attribute__((ext_vector_type(4)));
typedef float f32x16 __attribute__((ext_vector_type(16)));
typedef unsigned u32x4 __attribute__((ext_vector_type(4)));
typedef unsigned u32x2 __attribute__((ext_vector_type(2)));
typedef int i32x4 __attribute__((ext_vector_type(4)));
typedef int i32x8 __attribute__((ext_vector_type(8)));

constexpr int T_TOK = 16384, DM = 2048, SEQ = 4096, NB = 4, ZC = 10240, NE = 16, CAP = 512;
constexpr float ALPHA = 1.189207115002721f;
constexpr float LN_EPS = 1e-5f;
constexpr float SX8 = 8.f, SW8 = 64.f, SH8 = 16.f, SWG8 = 32.f;
constexpr int LDS_BG = 100352, LDS_BGW = 4224, LDS_BARW = 135168;
constexpr int LDS_BYTES = LDS_BARW + 64;
constexpr int NTHREADS = 512;
#ifndef PHASE_MASK
#define PHASE_MASK 0xFFFF
#endif
#ifndef REP_MASK
#define REP_MASK 0
#endif
#define REPS(k) for (int rep_ = 0; rep_ < 1 + ((REP_MASK >> (k)) & 1); ++rep_)

constexpr size_t MiB = (size_t)1 << 20;
constexpr size_t WS_WGUT = 0, WS_WDT = 128 * MiB;
constexpr size_t WS_XB = 384 * MiB, WS_WINT = 448 * MiB, WS_Z = 488 * MiB;
constexpr size_t WS_XG = 384 * MiB, WS_YS = 384 * MiB, WS_H = 512 * MiB;
constexpr size_t WS_WBT = 808 * MiB, WS_WOT = 812 * MiB, WS_COSA = 820 * MiB, WS_SINA = WS_COSA + 256 * 1024,
                 WS_COSB = WS_SINA + 256 * 1024, WS_SINB = WS_COSB + 128 * 1024, WS_WRT = 821 * MiB,
                 WS_AFFT = 822 * MiB, WS_SLOT = 823 * MiB, WS_GATE = 824 * MiB, WS_LSEG = 825 * MiB;
constexpr size_t WS_BR = 826 * MiB, WS_MERGED = 858 * MiB, WS_OG = 922 * MiB, WS_O0 = 970 * MiB;
constexpr size_t WS_X1B = 922 * MiB;
constexpr size_t WS_GF = 192 * MiB;
constexpr size_t WS_MIX = 576 * MiB;
constexpr size_t WS_X8 = 320 * MiB, WS_WING8 = 352 * MiB;
constexpr size_t WS_BARW = 1002 * MiB, WS_END = 1002 * MiB + 16384;

struct Params { const float* in[17]; float* out; unsigned char* ws; };

typedef __bf16 bf16x2_t __attribute__((ext_vector_type(2)));
typedef float f32x2_t __attribute__((ext_vector_type(2)));
__device__ __forceinline__ unsigned cvt_pk_bf16(float lo, float hi) { const f32x2_t v = {lo, hi}; const bf16x2_t b = __builtin_convertvector(v, bf16x2_t); return __builtin_bit_cast(unsigned, b); }
__device__ __forceinline__ unsigned cvt_pk4_fp8(float a, float b, float c, float d) { int w = __builtin_amdgcn_cvt_pk_fp8_f32(a, b, 0, false); w = __builtin_amdgcn_cvt_pk_fp8_f32(c, d, w, true); return (unsigned)w; }
__device__ __forceinline__ float bf_lo(unsigned w) { return __uint_as_float(w << 16); }
__device__ __forceinline__ float bf_hi(unsigned w) { return __uint_as_float(w & 0xffff0000u); }
__device__ __forceinline__ bf16_t f2bf(float f) { unsigned u = __float_as_uint(f); u += 0x7FFFu + ((u >> 16) & 1u); return (bf16_t)(u >> 16); }
template <int K> __device__ __forceinline__ float swz_xor(float v) { return __int_as_float(__builtin_amdgcn_ds_swizzle(__float_as_int(v), (K << 10) | 0x1f)); }
__device__ __forceinline__ float half_sum(float v) { v += swz_xor<1>(v); v += swz_xor<2>(v); v += swz_xor<4>(v); v += swz_xor<8>(v); v += swz_xor<16>(v); return v; }
__device__ __forceinline__ float wave_sum(float v) {
    v = half_sum(v);
    auto rr = __builtin_amdgcn_permlane32_swap(__float_as_uint(v), __float_as_uint(v), false, false);
    return __uint_as_float(rr[0]) + __uint_as_float(rr[1]);
}
__device__ __forceinline__ int fresh_tid() { int t = __builtin_amdgcn_workitem_id_x(); asm volatile("" : "+v"(t)); return t; }
#define LDS_WAIT() asm volatile("s_waitcnt lgkmcnt(0)" ::: "memory")


#define XB_TMO      128
#define XB_XCNT(j)  (256  + 64 * (j))
#define XB_XSUB(j)  (1280 + 64 * (j))
#define XB_XGEN(j)  (2304 + 64 * (j))
#define XB_TOP      3328
#define XB_TOPGEN   3392
#define XCD_BAR_WORDS 3456
#define XB_SPIN_CAP (1u << 18)
__device__ __forceinline__ unsigned xb_ld(unsigned* p)              { return __hip_atomic_load(p, __ATOMIC_RELAXED, __HIP_MEMORY_SCOPE_AGENT); }
__device__ __forceinline__ unsigned xb_add(unsigned* p, unsigned v) { return __hip_atomic_fetch_add(p, v, __ATOMIC_RELAXED, __HIP_MEMORY_SCOPE_AGENT); }
__device__ __forceinline__ unsigned xb_xcc_id() { return (unsigned)__builtin_amdgcn_s_getreg((3 << 11) | 20) & 0xFu; }
#define XB_SPIN(cond, bar) do { unsigned _sp = 0; while (cond) { __builtin_amdgcn_s_sleep(1); \
    if ((++_sp & 255u) == 0u) { if (xb_ld(&(bar)[XB_TMO])) break; if (_sp > XB_SPIN_CAP) { atomicAdd(&(bar)[XB_TMO], 1u); break; } } } } while (0)
struct XcdBarrier { unsigned* bar; unsigned x; volatile LAS unsigned* st; };
__device__ __forceinline__ XcdBarrier xcd_barrier_post(unsigned* bar, volatile LAS unsigned* st) {
    XcdBarrier b; b.bar = bar; b.x = xb_xcc_id(); b.st = st;
    if (fresh_tid() == 0) (void)xb_add(&bar[XB_XCNT(b.x)], 1u);
    return b;
}
__device__ __forceinline__ void xcd_barrier_complete(unsigned* bar, unsigned x, unsigned& nloc, unsigned& nx) {
    const unsigned G = gridDim.x * gridDim.y * gridDim.z;
    unsigned sum, cnt, mine, sp = 0u;
    for (;;) {
        sum = 0u; cnt = 0u; mine = 0u;
#pragma unroll
        for (unsigned j = 0; j < 16; ++j) { const unsigned c = xb_ld(&bar[XB_XCNT(j)]); sum += c; cnt += (c > 0u) ? 1u : 0u; mine = (j == x) ? c : mine; }
        if (sum == G) break;
        __builtin_amdgcn_s_sleep(1);
        if ((++sp & 255u) == 0u) { if (xb_ld(&bar[XB_TMO])) break; if (sp > XB_SPIN_CAP) { atomicAdd(&bar[XB_TMO], 1u); break; } }
    }
    nloc = mine > 0u ? mine : 1u; nx = cnt > 0u ? cnt : 1u;
}
__device__ __forceinline__ void xcd_barrier(const XcdBarrier& b) {
    asm volatile("s_waitcnt vmcnt(0)" ::: "memory");
    __syncthreads();
    if (fresh_tid() == 0) {
        unsigned* bar = b.bar;
        __builtin_amdgcn_s_waitcnt(0);
        unsigned nloc = b.st[0], nx = b.st[1];
        if (nloc == 0u) { xcd_barrier_complete(bar, b.x, nloc, nx); b.st[0] = nloc; b.st[1] = nx; }
        const unsigned old = xb_add(&bar[XB_XSUB(b.x)], 1u);
        const unsigned gen = old / nloc;
        if (old + 1u == (gen + 1u) * nloc) {
            __builtin_amdgcn_fence(__ATOMIC_RELEASE, "agent");
            asm volatile("s_waitcnt vmcnt(0)" ::: "memory");
            const unsigned og = xb_add(&bar[XB_TOP], 1u);
            const unsigned tg = og / nx;
            if (og + 1u == (tg + 1u) * nx) xb_add(&bar[XB_TOPGEN], 1u);
            else XB_SPIN(xb_ld(&bar[XB_TOPGEN]) == tg, bar);
            __builtin_amdgcn_fence(__ATOMIC_ACQUIRE, "agent");
            xb_add(&bar[XB_XGEN(b.x)], 1u);
            asm volatile("s_waitcnt vmcnt(0)" ::: "memory");
        } else {
            XB_SPIN(xb_ld(&bar[XB_XGEN(b.x)]) == gen, bar);
            __builtin_amdgcn_fence(__ATOMIC_ACQUIRE, "agent");
            asm volatile("s_waitcnt vmcnt(0)" ::: "memory");
        }
    }
    __syncthreads();
}

namespace pg8 {
constexpr int BM = 256, BK = 64, HALF = 128, HTB = HALF * BK * 2, STAGE_BYTES = 8 * HTB, NXCD = 8, WGM = 8;
__host__ __device__ __forceinline__ int lds_byte(int r, int c) { const int st = (r >> 4) * 2 + (c >> 5), rr = r & 15, cc = c & 31, ob = rr * 64 + cc * 2; return st * 1024 + (ob ^ (((ob >> 9) & 1) << 5)); }
__host__ __device__ __forceinline__ void stage_rc(int b, int& R, int& C) { const int st = b / 1024, sb = b % 1024, swz = sb ^ (((sb >> 9) & 1) << 5); R = (st >> 1) * 16 + swz / 64; C = (st & 1) * 32 + (swz % 64) / 2; }
__host__ __device__ __forceinline__ int perm32(int rho) { const int n = rho >> 4, i = rho & 15; return 8 * (i >> 2) + 4 * n + (i & 3); }
struct Unit { int pm, pn; };
struct Gemm { const bf16_t* A; const bf16_t* Bt; int M, N, K; };

__device__ __forceinline__ void static_map(int L, int nM, int nN, int& pm, int& pn) {
    const int nwg = nM * nN; int wgid = L;
    { const int q = nwg / NXCD, r = nwg % NXCD, xcd = wgid % NXCD, off = wgid / NXCD; wgid = (xcd < r ? xcd * (q + 1) : r * (q + 1) + (xcd - r) * q) + off; }
    const int nig = WGM * nN, gid = wgid / nig, fm = gid * WGM, gsz = (nM - fm) < WGM ? (nM - fm) : WGM;
    pm = fm + ((wgid % nig) % gsz); pn = (wgid % nig) / gsz;
}
struct StaticOrder {
    int nM, nN, nwg, G, c;
    __device__ void init(int M, int N, int G_, int c_) { nM = M / BM; nN = N / BM; nwg = nM * nN; G = G_; c = c_; }
    __device__ bool next(int i, Unit& u) const { const long L = (long)i * G + c; if (L >= nwg) return false; static_map((int)L, nM, nN, u.pm, u.pn); return true; }
    __device__ __forceinline__ void a_ready(const Unit&) const {}
    __device__ __forceinline__ void done(const Unit&) const {}
};
struct BranchOrder {
    int G, c;
    __device__ bool next(int i, Unit& u) const { const long L = (long)(i >> 1) * G + c; if (L >= 512) return false; int pm, pn; static_map((int)L, 64, 8, pm, pn); const int g = i & 1; u.pm = g * 64 + pm; u.pn = g * 8 + pn; return true; }
    __device__ __forceinline__ void a_ready(const Unit&) const {}
    __device__ __forceinline__ void done(const Unit&) const {}
};
struct InFp8Order {
    int G, c;
    __device__ bool next(int i, Unit& u) const { long L; if (G != 256) L = (long)i * G + c; else if (i < 8) L = (long)i * G + c; else if (i == 8 && c >= G / 2) L = 8L * G + (c - G / 2); else return false; if (L >= 2176) return false; static_map((int)L, 64, 34, u.pm, u.pn); return true; }
    __device__ __forceinline__ void a_ready(const Unit&) const {}
    __device__ __forceinline__ void done(const Unit&) const {}
};
struct InBf16Order {
    int G, c;
    __device__ bool next(int i, Unit& u) const { long L; if (G != 256) L = (long)i * G + c; else if (i == 0) L = c; else if (i == 1 && c < G / 2) L = (long)G + c; else return false; if (L >= 384) return false; static_map((int)L, 64, 6, u.pm, u.pn); return true; }
    __device__ __forceinline__ void a_ready(const Unit&) const {}
    __device__ __forceinline__ void done(const Unit&) const {}
};
struct UpOrder {
    int G, c;
    __device__ bool next(int i, Unit& u) const { const long L = (long)i * G + c; if (L >= 2048) return false; const int rd = (int)L >> 8, cc = (int)L & 255, x = cc & 7, k = cc >> 3;
        const int e = 2 * rd + (x >> 2), pn0 = (x & 3) * 4 + (k >> 3), pm0 = k & 7; u.pm = e * 8 + pm0; u.pn = e * 16 + pn0; return true; }
    __device__ __forceinline__ void a_ready(const Unit&) const {}
    __device__ __forceinline__ void done(const Unit&) const {}
};
struct DownOrder {
    int G, c;
    __device__ bool next(int i, Unit& u) const { const long L = (long)i * G + c; if (L >= 1024) return false; const int rd = (int)L >> 8, cc = (int)L & 255, x = cc & 7, k = cc >> 3;
        const int e = 4 * rd + (x >> 1), pn0 = (x & 1) * 4 + (k >> 3), pm0 = k & 7; u.pm = e * 8 + pm0; u.pn = e * 8 + pn0; return true; }
    __device__ __forceinline__ void a_ready(const Unit&) const {}
    __device__ __forceinline__ void done(const Unit&) const {}
};

template <class Epi, class Sched, bool FP8 = false>
__device__ __forceinline__ void gemm_phase(LAS unsigned char* lds, const Gemm g, const Sched& S, const Epi& E) {
    const int tid = fresh_tid(), wid = __builtin_amdgcn_readfirstlane(tid >> 6), lane = tid & 63, wr = wid >> 2, wc = wid & 3, fr = lane & 15, fq = lane >> 4;
    const int K = g.K, nt = FP8 ? K / 128 : K / BK, pitch = FP8 ? K : 2 * K;
    unsigned voffA[2], voffB[2];
#pragma unroll
    for (int i = 0; i < 2; ++i) { int R, C; stage_rc(tid * 16 + i * 8192, R, C); const int Rb = Epi::PERM ? ((R & ~31) + perm32(R & 31)) : R; voffA[i] = (unsigned)(R * pitch + C * 2); voffB[i] = (unsigned)(Rb * pitch + C * 2); }
    const size_t kstep = (size_t)(BK * 2);
    const size_t hstep = (size_t)HALF * pitch;
    const size_t tstep = 2 * hstep;
    const unsigned ldsw = (unsigned)wid * 1024u;
    const int aoff = lds_byte(wr * 64 + fr, fq * 8), boff = lds_byte(wc * 32 + fr, fq * 8);
#define PG8_SA(b, h) (((b) * 2 + (h)) * HTB)
#define PG8_SB(b, h) ((4 + (b) * 2 + (h)) * HTB)
#define PG8_STAGE(bufoff, gbase, voff) do { _Pragma("unroll") for (int _i = 0; _i < 2; ++_i) \
        __builtin_amdgcn_global_load_lds((const unsigned*)((const char*)(gbase) + (voff)[_i]), (LAS unsigned*)(lds + (bufoff) + ldsw + _i * 8192), 16, 0, 0); } while (0)
#define PG8_RD8(addr) __builtin_shufflevector(*(const LAS i32x4*)(addr), *(const LAS i32x4*)((addr) + 1024), 0, 1, 2, 3, 4, 5, 6, 7)
#define PG8_LDA(dst, b, h) do { _Pragma("unroll") for (int m = 0; m < 4; ++m) { if constexpr (FP8) dst##8[m] = PG8_RD8(lds + PG8_SA(b, h) + aoff + m * 2048); \
        else { _Pragma("unroll") for (int k = 0; k < 2; ++k) dst[m][k] = *(const LAS bf16x8*)(lds + PG8_SA(b, h) + aoff + m * 2048 + k * 1024); } } } while (0)
#define PG8_LDB(dst, b, h) do { _Pragma("unroll") for (int n = 0; n < 2; ++n) { if constexpr (FP8) dst##8[n] = PG8_RD8(lds + PG8_SB(b, h) + boff + n * 2048); \
        else { _Pragma("unroll") for (int k = 0; k < 2; ++k) dst[n][k] = *(const LAS bf16x8*)(lds + PG8_SB(b, h) + boff + n * 2048 + k * 1024); } } } while (0)
#define PG8_CAT(v) __builtin_shufflevector(__builtin_bit_cast(i32x4, v[0]), __builtin_bit_cast(i32x4, v[1]), 0, 1, 2, 3, 4, 5, 6, 7)
#define PG8_MMA(ai, bj, At, Bt) do { __builtin_amdgcn_s_setprio(1); _Pragma("unroll") for (int m = 0; m < 4; ++m) _Pragma("unroll") for (int n = 0; n < 2; ++n) { \
        if constexpr (FP8) asm volatile("v_mfma_f32_16x16x128_f8f6f4 %0, %1, %2, %0" : "+v"(acc[ai][bj][m][n]) : "v"(Bt##8[n]), "v"(At##8[m]));   \
        else { _Pragma("unroll") for (int k = 0; k < 2; ++k) acc[ai][bj][m][n] = __builtin_amdgcn_mfma_f32_16x16x32_bf16(Bt[n][k], At[m][k], acc[ai][bj][m][n], 0, 0, 0); } } \
        __builtin_amdgcn_s_setprio(0); } while (0)
#define PG8_WAIT_V(n) asm volatile("s_waitcnt vmcnt(" #n ")" ::: "memory")
#define PG8_WAIT_L(n) asm volatile("s_waitcnt lgkmcnt(" #n ")" ::: "memory")
#define PG8_BAR __builtin_amdgcn_s_barrier()
#define PG8_SCHED __builtin_amdgcn_sched_barrier(0)
    Unit cur, nxt; int ui = 0;
    if (!S.next(0, cur)) return;
    f32x4 acc[2][2][4][2];
#pragma unroll
    for (int a = 0; a < 2; ++a)
#pragma unroll
        for (int b = 0; b < 2; ++b)
#pragma unroll
            for (int m = 0; m < 4; ++m)
#pragma unroll
                for (int n = 0; n < 2; ++n) acc[a][b][m][n] = (f32x4){0.f, 0.f, 0.f, 0.f};
    bf16x8 At[4][2], B0[2][2], B1[2][2]; i32x8 At8[4], B08[2], B18[2];
    const char* cA = (const char*)g.A + (size_t)cur.pm * tstep; const char* cB = (const char*)g.Bt + (size_t)cur.pn * tstep;
    S.a_ready(cur);
    PG8_STAGE(PG8_SB(0, 0), cB, voffB); PG8_STAGE(PG8_SA(0, 0), cA, voffA); PG8_STAGE(PG8_SB(0, 1), cB + hstep, voffB); PG8_STAGE(PG8_SA(0, 1), cA + hstep, voffA);
    if (wr == 1) PG8_BAR;
    PG8_WAIT_V(4); PG8_BAR;
    PG8_STAGE(PG8_SB(1, 0), cB + kstep, voffB); PG8_STAGE(PG8_SA(1, 0), cA + kstep, voffA); PG8_STAGE(PG8_SB(1, 1), cB + hstep + kstep, voffB);
    PG8_WAIT_V(6); PG8_BAR;
    for (;;) {
        const bool has_next = S.next(ui + 1, nxt);
        const char* nA = has_next ? (const char*)g.A + (size_t)nxt.pm * tstep : cA; const char* nB = has_next ? (const char*)g.Bt + (size_t)nxt.pn * tstep : cB;
        for (int t = 0; t < nt; t += 2) {
            const bool last = (t == nt - 2);
            const char* a1 = cA + (size_t)(t + 1) * kstep;
            const char* a2 = last ? nA : cA + (size_t)(t + 2) * kstep; const char* b2 = last ? nB : cB + (size_t)(t + 2) * kstep;
            const char* a3 = a2 + kstep; const char* b3 = b2 + kstep;
            if (last && has_next) S.a_ready(nxt);
            if constexpr (Epi::MID_T > 0) { if (t == Epi::MID_T) { PG8_SCHED; E.mid(acc, cur, wr, wc, fr, fq); PG8_SCHED; } }
            PG8_LDB(B0, 0, 0); PG8_SCHED; PG8_LDA(At, 0, 0); PG8_STAGE(PG8_SA(1, 1), a1 + hstep, voffA);
            PG8_WAIT_L(8); PG8_BAR; PG8_WAIT_L(0); PG8_MMA(0, 0, At, B0); PG8_BAR; PG8_SCHED;
            PG8_LDB(B1, 0, 1); PG8_STAGE(PG8_SB(0, 0), b2, voffB);
            PG8_BAR; PG8_WAIT_L(0); PG8_MMA(0, 1, At, B1); PG8_BAR;
            PG8_LDA(At, 0, 1); PG8_STAGE(PG8_SA(0, 0), a2, voffA);
            PG8_BAR; PG8_WAIT_L(0); PG8_MMA(1, 0, At, B0); PG8_BAR; PG8_SCHED;
            PG8_STAGE(PG8_SB(0, 1), b2 + hstep, voffB);
            PG8_WAIT_V(6); PG8_BAR; PG8_MMA(1, 1, At, B1); PG8_BAR;
            PG8_LDB(B0, 1, 0); PG8_SCHED; PG8_LDA(At, 1, 0); PG8_STAGE(PG8_SA(0, 1), a2 + hstep, voffA);
            PG8_WAIT_L(8); PG8_BAR; PG8_WAIT_L(0); PG8_MMA(0, 0, At, B0); PG8_BAR; PG8_SCHED;
            PG8_LDB(B1, 1, 1); PG8_STAGE(PG8_SB(1, 0), b3, voffB);
            PG8_BAR; PG8_WAIT_L(0); PG8_MMA(0, 1, At, B1); PG8_BAR;
            PG8_LDA(At, 1, 1); PG8_STAGE(PG8_SA(1, 0), a3, voffA);
            PG8_BAR; PG8_WAIT_L(0); PG8_MMA(1, 0, At, B0); PG8_BAR; PG8_SCHED;
            PG8_STAGE(PG8_SB(1, 1), b3 + hstep, voffB);
            PG8_WAIT_V(6); PG8_BAR; PG8_MMA(1, 1, At, B1); PG8_BAR;
        }
        if constexpr (FP8) {
            asm volatile("s_nop 15\n\ts_nop 15\n\ts_nop 15" ::: "memory");
#pragma unroll
            for (int a = 0; a < 2; ++a)
#pragma unroll
                for (int b = 0; b < 2; ++b)
#pragma unroll
                    for (int m = 0; m < 4; ++m)
#pragma unroll
                        for (int n = 0; n < 2; ++n) asm volatile("" : "+v"(acc[a][b][m][n]));
        }
        E(acc, cur, wr, wc, fr, fq); S.done(cur);
        if (!has_next) break;
#pragma unroll
        for (int a = 0; a < 2; ++a)
#pragma unroll
            for (int b = 0; b < 2; ++b)
#pragma unroll
                for (int m = 0; m < 4; ++m)
#pragma unroll
                    for (int n = 0; n < 2; ++n) acc[a][b][m][n] = (f32x4){0.f, 0.f, 0.f, 0.f};
        cur = nxt; cA = nA; cB = nB; ++ui;
    }
    PG8_WAIT_V(0);
    if (wr == 0) PG8_BAR;
    PG8_BAR;
#undef PG8_SA
#undef PG8_SB
#undef PG8_STAGE
#undef PG8_LDA
#undef PG8_RD8
#undef PG8_LDB
#undef PG8_MMA
#undef PG8_CAT
#undef PG8_WAIT_V
#undef PG8_WAIT_L
#undef PG8_BAR
#undef PG8_SCHED
}

__device__ __forceinline__ void st_bf16x4(bf16_t* p, f32x4 v) { u32x2 w; w.x = cvt_pk_bf16(v[0], v[1]); w.y = cvt_pk_bf16(v[2], v[3]); *(u32x2*)p = w; }
__device__ __forceinline__ f32x4 ld_bf16x4(const bf16_t* p) { const u32x2 w = *(const u32x2*)p; return (f32x4){bf_lo(w.x), bf_hi(w.x), bf_lo(w.y), bf_hi(w.y)}; }

__device__ __forceinline__ size_t gf_off(int tile, int wid, int ai, int m, int bj, int lane) { return (size_t)tile * 131072 + wid * 16384 + (ai * 4 + m) * 2048 + bj * 1024 + lane * 16; }
struct EpiZ {
    static constexpr int MID_T = 0; static constexpr bool PERM = true;
    bf16_t* Z; const float* cosA; const float* sinA; const float* cosB; const float* sinB; int pn_off; float sc;
    __device__ __forceinline__ void operator()(const f32x4 (&acc)[2][2][4][2], const Unit& u, int wr, int wc, int fr, int fq) const {
        asm volatile("" : "+v"(fr), "+v"(fq));
        const int pn = u.pn + pn_off;
        const int type = pn < 12 ? 1 : pn < 18 ? 0 : pn < 22 ? 2 : 0;
        const int row0 = u.pm * BM + wr * 64 + fr, col0 = pn * BM + wc * 32 + 8 * fq;
#pragma unroll
        for (int ai = 0; ai < 2; ++ai)
#pragma unroll
            for (int m = 0; m < 4; ++m) {
                const int row = row0 + ai * HALF + m * 16, pos = row & (SEQ - 1);
                f32x4 c0 = {1.f, 1.f, 1.f, 1.f}, s0 = {0.f, 0.f, 0.f, 0.f}, c1 = c0, s1 = s0;
                if (type == 1 && wc == 0) { const float* cp = cosA + pos * 16 + 8 * (fq & 1); const float* sp = sinA + pos * 16 + 8 * (fq & 1);
                    c0 = *(const f32x4*)cp; c1 = *(const f32x4*)(cp + 4); s0 = *(const f32x4*)sp; s1 = *(const f32x4*)(sp + 4); }
                if (type == 2 && (wc & 1) == 0) { const float* cp = cosB + pos * 8; const float* sp = sinB + pos * 8;
                    c0 = *(const f32x4*)cp; c1 = *(const f32x4*)(cp + 4); s0 = *(const f32x4*)sp; s1 = *(const f32x4*)(sp + 4); }
                bf16_t* rowp = Z + (size_t)row * ZC + col0;
#pragma unroll
                for (int bj = 0; bj < 2; ++bj) {
                    f32x4 v0 = acc[ai][bj][m][0] * sc, v1 = acc[ai][bj][m][1] * sc;
                    if (type == 1 && wc == 0) {
                        f32x4 p0, p1;
#pragma unroll
                        for (int j = 0; j < 4; ++j) { p0[j] = __shfl_xor(v0[j], 32); p1[j] = __shfl_xor(v1[j], 32); }
                        if (fq < 2) { v0 = v0 * c0 - p0 * s0; v1 = v1 * c1 - p1 * s1; } else { v0 = v0 * c0 + p0 * s0; v1 = v1 * c1 + p1 * s1; }
                    }
                    if (type == 2 && (wc & 1) == 0) {
                        f32x4 p0, p1;
#pragma unroll
                        for (int j = 0; j < 4; ++j) { p0[j] = swz_xor<16>(v0[j]); p1[j] = swz_xor<16>(v1[j]); }
                        if (fq == 0) { v0 = v0 * c0 - p0 * s0; v1 = v1 * c1 - p1 * s1; } else if (fq == 1) { v0 = v0 * c0 + p0 * s0; v1 = v1 * c1 + p1 * s1; }
                    }
                    u32x4 w; w.x = cvt_pk_bf16(v0[0], v0[1]); w.y = cvt_pk_bf16(v0[2], v0[3]); w.z = cvt_pk_bf16(v1[0], v1[1]); w.w = cvt_pk_bf16(v1[2], v1[3]);
                    *(u32x4*)(rowp + bj * HALF) = w;
                }
            }
    }
};
struct EpiGate {
    static constexpr int MID_T = 0; static constexpr bool PERM = true;
    unsigned char* GF;
    __device__ __forceinline__ void operator()(const f32x4 (&acc)[2][2][4][2], const Unit& u, int wr, int wc, int fr, int fq) const {
        asm volatile("" : "+v"(fr), "+v"(fq));
        const int tile = ((u.pn >> 3) * 64 + u.pm) * 8 + (u.pn & 7), wid = wr * 4 + wc, lane = fq * 16 + fr;
        constexpr float SC = -1.f / (SX8 * SWG8);
#pragma unroll
        for (int ai = 0; ai < 2; ++ai)
#pragma unroll
            for (int m = 0; m < 4; ++m)
#pragma unroll
                for (int bj = 0; bj < 2; ++bj) {
                    f32x4 v0 = acc[ai][bj][m][0], v1 = acc[ai][bj][m][1];
#pragma unroll
                    for (int j = 0; j < 4; ++j) { v0[j] = __builtin_amdgcn_rcpf(1.f + __expf(v0[j] * SC)); v1[j] = __builtin_amdgcn_rcpf(1.f + __expf(v1[j] * SC)); }
                    u32x4 w; w.x = cvt_pk_bf16(v0[0], v0[1]); w.y = cvt_pk_bf16(v0[2], v0[3]); w.z = cvt_pk_bf16(v1[0], v1[1]); w.w = cvt_pk_bf16(v1[2], v1[3]);
                    __builtin_nontemporal_store(w, (u32x4*)(GF + gf_off(tile, wid, ai, m, bj, lane)));
                }
    }
};
struct EpiInFp8 {
    static constexpr int MID_T = 0; static constexpr bool PERM = true;
    EpiZ z; EpiGate g;
    __device__ __forceinline__ void operator()(const f32x4 (&acc)[2][2][4][2], const Unit& u, int wr, int wc, int fr, int fq) const {
        if (u.pn < 18) z(acc, u, wr, wc, fr, fq);
        else { Unit u2; u2.pm = u.pm; u2.pn = u.pn - 18; g(acc, u2, wr, wc, fr, fq); }
    }
};
struct EpiBranch {
    static constexpr int MID_T = 8; static constexpr bool PERM = true;
    bf16_t* merged; const unsigned char* GF;
    __device__ __forceinline__ void mid(f32x4 (&acc)[2][2][4][2], const Unit& u, int wr, int wc, int fr, int fq) const {
        asm volatile("" : "+v"(fr), "+v"(fq));
        const int t0 = u.pm * 8 + u.pn, wid = wr * 4 + wc, lane = fq * 16 + fr;
#pragma unroll
        for (int ai = 0; ai < 2; ++ai) {
#pragma unroll
            for (int m = 0; m < 4; ++m)
#pragma unroll
                for (int bj = 0; bj < 2; ++bj) {
                    const u32x4 a = *(const u32x4*)(GF + gf_off(t0, wid, ai, m, bj, lane)), b = *(const u32x4*)(GF + gf_off(512 + t0, wid, ai, m, bj, lane));
                    const f32x4 g00 = {bf_lo(a.x), bf_hi(a.x), bf_lo(a.y), bf_hi(a.y)}, g01 = {bf_lo(a.z), bf_hi(a.z), bf_lo(a.w), bf_hi(a.w)};
                    const f32x4 g10 = {bf_lo(b.x), bf_hi(b.x), bf_lo(b.y), bf_hi(b.y)}, g11 = {bf_lo(b.z), bf_hi(b.z), bf_lo(b.w), bf_hi(b.w)};
#pragma unroll
                    for (int j = 0; j < 4; ++j) { acc[ai][bj][m][0][j] *= g00[j] * __builtin_amdgcn_rcpf(g10[j]); acc[ai][bj][m][1][j] *= g01[j] * __builtin_amdgcn_rcpf(g11[j]); }
                }
            asm volatile("" ::: "memory");
        }
    }
    __device__ __forceinline__ void operator()(const f32x4 (&acc)[2][2][4][2], const Unit& u, int wr, int wc, int fr, int fq) const {
        asm volatile("" : "+v"(fr), "+v"(fq));
        const int t1 = 512 + u.pm * 8 + u.pn, wid = wr * 4 + wc, lane = fq * 16 + fr;
        const int row0 = u.pm * BM + wr * 64 + fr, col0 = u.pn * BM + wc * 32 + 8 * fq;
#pragma unroll
        for (int ai = 0; ai < 2; ++ai)
#pragma unroll
            for (int m = 0; m < 4; ++m) {
                bf16_t* mp = merged + (size_t)(row0 + ai * HALF + m * 16) * DM + col0;
#pragma unroll
                for (int bj = 0; bj < 2; ++bj) {
                    const u32x4 b = *(const u32x4*)(GF + gf_off(t1, wid, ai, m, bj, lane));
                    const f32x4 g10 = {bf_lo(b.x), bf_hi(b.x), bf_lo(b.y), bf_hi(b.y)}, g11 = {bf_lo(b.z), bf_hi(b.z), bf_lo(b.w), bf_hi(b.w)};
                    const f32x4 y0 = acc[ai][bj][m][0] * g10, y1 = acc[ai][bj][m][1] * g11;
                    u32x4 w; w.x = cvt_pk_bf16(y0[0], y0[1]); w.y = cvt_pk_bf16(y0[2], y0[3]); w.z = cvt_pk_bf16(y1[0], y1[1]); w.w = cvt_pk_bf16(y1[2], y1[3]);
                    *(u32x4*)(mp + bj * HALF) = w;
                }
            }
    }
};
struct EpiOut {
    static constexpr int MID_T = 0; static constexpr bool PERM = true;
    bf16_t* MIX;
    __device__ __forceinline__ void operator()(const f32x4 (&acc)[2][2][4][2], const Unit& u, int wr, int wc, int fr, int fq) const {
        asm volatile("" : "+v"(fr), "+v"(fq));
        const int row0 = u.pm * BM + wr * 64 + fr, col0 = u.pn * BM + wc * 32 + 8 * fq;
#pragma unroll
        for (int ai = 0; ai < 2; ++ai)
#pragma unroll
            for (int m = 0; m < 4; ++m) {
                bf16_t* rowp = MIX + (size_t)(row0 + ai * HALF + m * 16) * DM + col0;
#pragma unroll
                for (int bj = 0; bj < 2; ++bj) { const f32x4 y0 = acc[ai][bj][m][0], y1 = acc[ai][bj][m][1];
                    u32x4 w; w.x = cvt_pk_bf16(y0[0], y0[1]); w.y = cvt_pk_bf16(y0[2], y0[3]); w.z = cvt_pk_bf16(y1[0], y1[1]); w.w = cvt_pk_bf16(y1[2], y1[3]);
                    *(u32x4*)(rowp + bj * HALF) = w; }
            }
    }
};
struct EpiUp {
    static constexpr int MID_T = 0; static constexpr bool PERM = true;
    unsigned char* H8;
    __device__ __forceinline__ void operator()(const f32x4 (&acc)[2][2][4][2], const Unit& u, int wr, int wc, int fr, int fq) const {
        asm volatile("" : "+v"(fr), "+v"(fq));
        const int pn0 = u.pn & 15;
        const int row0 = u.pm * BM + wr * 64 + fr, col0 = pn0 * HALF + wc * 32 + 8 * fq;
        constexpr float SC = 1.f / (SX8 * SW8);
#pragma unroll
        for (int ai = 0; ai < 2; ++ai)
#pragma unroll
            for (int m = 0; m < 4; ++m) {
                unsigned char* rowp = H8 + (size_t)(row0 + ai * HALF + m * 16) * DM + col0;
                u32x2 w8;
#pragma unroll
                for (int n = 0; n < 2; ++n) {
                    const f32x4 gt = acc[ai][0][m][n] * SC, up = acc[ai][1][m][n] * (SC * SH8); f32x4 h;
#pragma unroll
                    for (int j = 0; j < 4; ++j) h[j] = gt[j] * __builtin_amdgcn_rcpf(1.f + __expf(-gt[j])) * up[j];
                    w8[n] = cvt_pk4_fp8(h[0], h[1], h[2], h[3]);
                }
                *(u32x2*)rowp = w8;
            }
    }
};
struct EpiDown {
    static constexpr int MID_T = 0; static constexpr bool PERM = true;
    bf16_t* YS; const float* gate;
    __device__ __forceinline__ void operator()(const f32x4 (&acc)[2][2][4][2], const Unit& u, int wr, int wc, int fr, int fq) const {
        asm volatile("" : "+v"(fr), "+v"(fq));
        const int pn0 = u.pn & 7;
        const int row0 = u.pm * BM + wr * 64 + fr, col0 = pn0 * BM + wc * 32 + 8 * fq;
#pragma unroll
        for (int ai = 0; ai < 2; ++ai)
#pragma unroll
            for (int m = 0; m < 4; ++m) {
                const int row = row0 + ai * HALF + m * 16; const float gt = gate[row] * (1.f / (SH8 * SW8));
                bf16_t* rowp = YS + (size_t)row * DM + col0;
#pragma unroll
                for (int bj = 0; bj < 2; ++bj) { const f32x4 y0 = acc[ai][bj][m][0] * gt, y1 = acc[ai][bj][m][1] * gt;
                    u32x4 w; w.x = cvt_pk_bf16(y0[0], y0[1]); w.y = cvt_pk_bf16(y0[2], y0[3]); w.z = cvt_pk_bf16(y1[0], y1[1]); w.w = cvt_pk_bf16(y1[2], y1[3]);
                    *(u32x4*)(rowp + bj * HALF) = w; }
            }
    }
};
}


struct BgConv { const float* w0; const float* w1; const float* w2; unsigned char* WGUT; unsigned char* WDT; int NGW; int pad; };
struct BgState { int it, pend, par, tick; };
constexpr int BG_ITEMS = 3 * 65536;
__device__ __forceinline__ void bg_decode(const BgConv bg, int it, const float*& src, unsigned char*& dst) {
    const int mat = it >> 16, r = it & 65535, e = r >> 12, r2 = r & 4095, kb = r2 >> 6, nb = r2 & 63, k0 = 32 * kb, n0 = 32 * nb;
    src = (mat == 0 ? bg.w0 : mat == 1 ? bg.w1 : bg.w2) + ((size_t)e * DM + k0) * DM + n0;
    if (mat == 2) dst = bg.WDT + ((size_t)e * DM + n0) * DM + k0;
    else dst = bg.WGUT + ((size_t)e * 4096 + (n0 >> 7) * 256 + mat * 128 + (n0 & 127)) * DM + k0;
}
template <bool WAIT = true> __device__ __forceinline__ void bg_finish(const BgConv bg, int& pend, int par, LAS unsigned char* scr, int lane) {
    if (pend < 0) return;
    const float* src; unsigned char* dst; bg_decode(bg, pend, src, dst);
    if (WAIT) asm volatile("s_waitcnt vmcnt(0)" ::: "memory");
    const int c = lane & 1, n = lane >> 1;
    const LAS float* s0 = (const LAS float*)(scr + (2 * c) * 1056) + n;
    const LAS float* s1 = (const LAS float*)(scr + (2 * c + 1) * 1056) + n;
    u32x4 o;
    o.x = cvt_pk4_fp8(s0[0 * 32] * SW8, s0[1 * 32] * SW8, s0[2 * 32] * SW8, s0[3 * 32] * SW8); o.y = cvt_pk4_fp8(s0[4 * 32] * SW8, s0[5 * 32] * SW8, s0[6 * 32] * SW8, s0[7 * 32] * SW8);
    o.z = cvt_pk4_fp8(s1[0 * 32] * SW8, s1[1 * 32] * SW8, s1[2 * 32] * SW8, s1[3 * 32] * SW8); o.w = cvt_pk4_fp8(s1[4 * 32] * SW8, s1[5 * 32] * SW8, s1[6 * 32] * SW8, s1[7 * 32] * SW8);
    *(u32x4*)(dst + (size_t)n * DM + 16 * c) = o;
    LDS_WAIT();
    pend = -1;
}
__device__ __forceinline__ void bg_issue(const BgConv bg, int& it, int& pend, int& par, LAS unsigned char* scr, int lane) {
    if (it >= BG_ITEMS) return;
    const float* src; unsigned char* dst; bg_decode(bg, it, src, dst);
    par ^= 1;
    const float* lp = src + (size_t)(lane >> 3) * DM + (lane & 7) * 4;
#pragma unroll
    for (int i = 0; i < 4; ++i) __builtin_amdgcn_global_load_lds((const unsigned*)(lp + (size_t)(8 * i) * DM), (LAS unsigned*)(scr + i * 1056), 16, 0, 0);
    pend = it; it += bg.NGW;
}

namespace att {
#define KSWZ128(row, colB) ((row) * 256 + ((colB) ^ (((row) & 7) << 4)))
#define KSWZ64(row, colB) ((row) * 128 + ((colB) ^ (((row) & 7) << 4)))
#define SBAR() __builtin_amdgcn_sched_barrier(0)
__device__ __forceinline__ int crow(int r, int hi) { return (r & 3) + 8 * (r >> 2) + 4 * hi; }
__device__ __forceinline__ int v_st(int k, int c) { const int kk = (k & ~0xC) | ((k & 4) << 1) | ((k & 8) >> 1); return ((kk >> 3) * 4 + (c >> 5)) * 512 + ((kk & 7) * 32 + (c & 31)) * 2; }
__device__ __forceinline__ int v_rd_base(int lane) { return ((lane & 3) << 3) | (((lane >> 2) & 3) << 6) | (((lane >> 4) & 1) << 5) | (((lane >> 5) & 1) << 8); }
constexpr int v_rd_off(int d0, int ks, int half) { return d0 * 512 + ks * 4096 + half * 2048; }
template <int OFF> __device__ __forceinline__ s16x4 tr_read(int vb) { s16x4 r; asm volatile("ds_read_b64_tr_b16 %0, %1 offset:%2" : "=&v"(r) : "v"(vb), "i"(OFF) : "memory"); return r; }
template <int D0> __device__ __forceinline__ void pv_one(f32x16& od, int vb, bf16x8 pa0, bf16x8 pa1, bf16x8 pa2, bf16x8 pa3) {
    const s16x4 l0 = tr_read<v_rd_off(D0, 0, 0)>(vb), h0 = tr_read<v_rd_off(D0, 0, 1)>(vb), l1 = tr_read<v_rd_off(D0, 1, 0)>(vb), h1 = tr_read<v_rd_off(D0, 1, 1)>(vb);
    const s16x4 l2 = tr_read<v_rd_off(D0, 2, 0)>(vb), h2 = tr_read<v_rd_off(D0, 2, 1)>(vb), l3 = tr_read<v_rd_off(D0, 3, 0)>(vb), h3 = tr_read<v_rd_off(D0, 3, 1)>(vb);
    asm volatile("s_waitcnt lgkmcnt(0)" ::: "memory"); SBAR();
#define PK(L, H) (bf16x8){L[0], L[1], L[2], L[3], H[0], H[1], H[2], H[3]}
    od = __builtin_amdgcn_mfma_f32_32x32x16_bf16(pa0, PK(l0, h0), od, 0, 0, 0);
    od = __builtin_amdgcn_mfma_f32_32x32x16_bf16(pa1, PK(l1, h1), od, 0, 0, 0);
    od = __builtin_amdgcn_mfma_f32_32x32x16_bf16(pa2, PK(l2, h2), od, 0, 0, 0);
    od = __builtin_amdgcn_mfma_f32_32x32x16_bf16(pa3, PK(l3, h3), od, 0, 0, 0);
#undef PK
}

template <int DQK, bool BAND>
__device__ __forceinline__ void attn_pass(const bf16_t* __restrict__ Qw, const bf16_t* __restrict__ Kb, const bf16_t* __restrict__ Vb, size_t kvs,
                                          int ntiles, int key0, int L, int qpos, int t_lo, int t_hi, LAS char* lds, f32x16 (&o)[4], float& m_reg, float& l_reg, const BgConv bg, BgState& bs) {
    constexpr float SCALE = DQK == 128 ? 0.08838834764831845f : 0.125f;
    constexpr float C = SCALE * 1.4426950408889634f;
    constexpr float THR = 8.f;
    constexpr int ND0 = DQK / 16;
    const int tid = fresh_tid(), wid = __builtin_amdgcn_readfirstlane(tid >> 6), lane = tid & 63, r32 = lane & 31, hi = lane >> 5;
    LAS char* V_lds = lds; LAS char* K_lds = lds + 32768;
    LAS float* al_l = (LAS float*)(lds + 65536) + wid * 64;
    LAS unsigned char* bgscr = (LAS unsigned char*)lds + LDS_BG + wid * LDS_BGW;
    bf16x8 qr[ND0];
#pragma unroll
    for (int d0 = 0; d0 < ND0; ++d0) qr[d0] = *(const bf16x8*)(Qw + d0 * 16);
    const int sr = tid >> 4, sc = (tid & 15) * 8, vst0 = v_st(sr, sc), vst1 = v_st(32 + sr, sc);
    const int kr64 = tid >> 3, kc64 = (tid & 7) * 8;
    const int vb0 = (int)(unsigned)(size_t)V_lds + v_rd_base(lane);
    bf16x8 vs0, vs1, ks0, ks1;
#define KPOS(j, row) ({ int _p = key0 + 64 * (j) + (row); if (BAND) { _p = _p < 0 ? 0 : (_p >= L ? L - 1 : _p); } (size_t)_p; })
#define SLOAD(j) do { const size_t _p0 = KPOS(j, sr) * kvs, _p1 = KPOS(j, 32 + sr) * kvs; \
        vs0 = *(const bf16x8*)(Vb + _p0 + sc); vs1 = *(const bf16x8*)(Vb + _p1 + sc); \
        if (DQK == 128) { ks0 = *(const bf16x8*)(Kb + _p0 + sc); ks1 = *(const bf16x8*)(Kb + _p1 + sc); } \
        else { ks0 = *(const bf16x8*)(Kb + KPOS(j, kr64) * kvs + kc64); } } while (0)
#define SWRITE(b) do { *(LAS bf16x8*)(V_lds + (b) * 16384 + vst0) = vs0; *(LAS bf16x8*)(V_lds + (b) * 16384 + vst1) = vs1; \
        if (DQK == 128) { *(LAS bf16x8*)(K_lds + (b) * 16384 + KSWZ128(sr, sc * 2)) = ks0; *(LAS bf16x8*)(K_lds + (b) * 16384 + KSWZ128(32 + sr, sc * 2)) = ks1; } \
        else { *(LAS bf16x8*)(K_lds + (b) * 16384 + KSWZ64(kr64, kc64 * 2)) = ks0; } } while (0)
    __syncthreads();
    SLOAD(0); SWRITE(0);
    for (int j = 0; j < ntiles; ++j) {
        __syncthreads();
        constexpr bool SHADOW = (DQK == 64);
        if (SHADOW) { if (bs.pend >= 0) asm volatile("s_waitcnt vmcnt(0)" ::: "memory"); }
        else bg_finish<true>(bg, bs.pend, bs.par, bgscr, lane);
        if (j + 1 < ntiles) SLOAD(j + 1);
#define BG_STEP() do { bg_finish<false>(bg, bs.pend, bs.par, bgscr, lane); if (bs.tick != 2) bg_issue(bg, bs.it, bs.pend, bs.par, bgscr, lane); bs.tick = bs.tick == 2 ? 0 : bs.tick + 1; } while (0)
        if (!SHADOW || (BAND && !(j >= t_lo && j <= t_hi))) BG_STEP();
        if (!BAND || (j >= t_lo && j <= t_hi)) {
            const LAS char* Kt = K_lds + (j & 1) * 16384;
            f32x16 p0 = {}, p1 = {};
#pragma unroll
            for (int d0 = 0; d0 < ND0; ++d0) { const int cb = (d0 * 16 + hi * 8) * 2;
                const bf16x8 b0 = *(const LAS bf16x8*)(Kt + (DQK == 128 ? KSWZ128(r32, cb) : KSWZ64(r32, cb)));
                const bf16x8 b1 = *(const LAS bf16x8*)(Kt + (DQK == 128 ? KSWZ128(32 + r32, cb) : KSWZ64(32 + r32, cb)));
                p0 = __builtin_amdgcn_mfma_f32_32x32x16_bf16(b0, qr[d0], p0, 0, 0, 0);
                p1 = __builtin_amdgcn_mfma_f32_32x32x16_bf16(b1, qr[d0], p1, 0, 0, 0); }
            if (SHADOW) { SBAR(); BG_STEP(); SBAR(); }
            unsigned vmask = 0xffffffffu;
            if (BAND) { vmask = 0u; const int kb = key0 + 64 * j;
#pragma unroll
                for (int r = 0; r < 16; ++r) { const int k0p = kb + crow(r, hi), k1p = k0p + 32; const int d0p = qpos - k0p, d1p = qpos - k1p;
                    const bool v0 = (d0p <= 64) && (d0p >= -64) && (k0p >= 0) && (k0p < L), v1 = (d1p <= 64) && (d1p >= -64) && (k1p >= 0) && (k1p < L);
                    vmask |= (v0 ? 1u : 0u) << r; vmask |= (v1 ? 1u : 0u) << (16 + r);
                    p0[r] = v0 ? p0[r] : -1e30f; p1[r] = v1 ? p1[r] : -1e30f; } }
            float pmax = p0[0];
#pragma unroll
            for (int r = 1; r < 16; ++r) pmax = fmaxf(pmax, p0[r]);
#pragma unroll
            for (int r = 0; r < 16; ++r) pmax = fmaxf(pmax, p1[r]);
            { auto rr = __builtin_amdgcn_permlane32_swap(__float_as_uint(pmax), __float_as_uint(pmax), false, false); pmax = fmaxf(__uint_as_float(rr[0]), __uint_as_float(rr[1])); }
            float mn, alpha;
            if (__all(pmax - m_reg <= THR / SCALE)) { mn = m_reg; alpha = 1.f; }
            else { mn = fmaxf(m_reg, pmax); alpha = __builtin_amdgcn_exp2f((m_reg - mn) * C); m_reg = mn; }
            const float mnC = -mn * C;
#pragma unroll
            for (int r = 0; r < 16; ++r) { p0[r] = __builtin_amdgcn_exp2f(fmaf(p0[r], C, mnC)); p1[r] = __builtin_amdgcn_exp2f(fmaf(p1[r], C, mnC)); }
            if (BAND) {
#pragma unroll
                for (int r = 0; r < 16; ++r) { p0[r] = ((vmask >> r) & 1u) ? p0[r] : 0.f; p1[r] = ((vmask >> (16 + r)) & 1u) ? p1[r] : 0.f; } }
            float ps = 0.f;
#pragma unroll
            for (int r = 0; r < 16; ++r) ps += p0[r];
#pragma unroll
            for (int r = 0; r < 16; ++r) ps += p1[r];
            { auto rr = __builtin_amdgcn_permlane32_swap(__float_as_uint(ps), __float_as_uint(ps), false, false); ps = __uint_as_float(rr[0]) + __uint_as_float(rr[1]); }
            l_reg = l_reg * alpha + ps;
            bf16x8 pa0, pa1, pa2, pa3;
#define PK4(P, BASE, OUT) do { unsigned a0 = cvt_pk_bf16(P[BASE + 0], P[BASE + 1]), a1 = cvt_pk_bf16(P[BASE + 2], P[BASE + 3]); \
        unsigned b0 = cvt_pk_bf16(P[BASE + 4], P[BASE + 5]), b1 = cvt_pk_bf16(P[BASE + 6], P[BASE + 7]); \
        auto r0 = __builtin_amdgcn_permlane32_swap(a0, b0, false, false); auto r1 = __builtin_amdgcn_permlane32_swap(a1, b1, false, false); \
        u32x4 w = {r0[0], r1[0], r0[1], r1[1]}; OUT = *reinterpret_cast<bf16x8*>(&w); } while (0)
            PK4(p0, 0, pa0); PK4(p0, 8, pa1); PK4(p1, 0, pa2); PK4(p1, 8, pa3);
#undef PK4
            if (__any(alpha < 1.f)) {
                if (hi == 0) al_l[r32] = alpha;
                LDS_WAIT();
#pragma unroll
                for (int r = 0; r < 16; ++r) { const float a = al_l[crow(r, hi)];
#pragma unroll
                    for (int d = 0; d < 4; ++d) o[d][r] *= a; }
            }
            const int vb = vb0 + (j & 1) * 16384;
            pv_one<0>(o[0], vb, pa0, pa1, pa2, pa3); pv_one<1>(o[1], vb, pa0, pa1, pa2, pa3); pv_one<2>(o[2], vb, pa0, pa1, pa2, pa3); pv_one<3>(o[3], vb, pa0, pa1, pa2, pa3);
        }
        if (j + 1 < ntiles) SWRITE((j + 1) & 1);
    }
#undef BG_STEP
#undef KPOS
#undef SLOAD
#undef SWRITE
}

__device__ __forceinline__ void attn_pass_band_dma(const bf16_t* __restrict__ Qw, const bf16_t* __restrict__ Kb, const bf16_t* __restrict__ Vb, size_t kvs,
                                                   int key0, int L, int qpos, int t_lo, int t_hi, LAS char* lds, f32x16 (&o)[4], float& m_reg, float& l_reg, const BgConv bg, BgState& bs) {
    constexpr int DQK = 128, ND0 = 8, ntiles = 6; constexpr bool BAND = true;
    constexpr float SCALE = 0.08838834764831845f, C = SCALE * 1.4426950408889634f, THR = 8.f;
    const int tid = fresh_tid(), wid = __builtin_amdgcn_readfirstlane(tid >> 6), lane = tid & 63, r32 = lane & 31, hi = lane >> 5;
    LAS char* V_lds = lds; LAS char* K_lds = lds + 49152;
    LAS float* al_l = (LAS float*)(lds + 98304) + wid * 64;
    bf16x8 qr[ND0];
#pragma unroll
    for (int d0 = 0; d0 < ND0; ++d0) qr[d0] = *(const bf16x8*)(Qw + d0 * 16);
    const int vb0 = (int)(unsigned)(size_t)V_lds + v_rd_base(lane);
    int vrow[2], vcol[2], krow[2], kcol[2];
#pragma unroll
    for (int i = 0; i < 2; ++i) { const int g = (i * 8 + wid) * 64 + lane;
        const int sub = g >> 5, within = g & 31, kk = (sub >> 2) * 8 + (within >> 2);
        vrow[i] = (kk & ~0xC) | ((kk & 4) << 1) | ((kk & 8) >> 1); vcol[i] = (sub & 3) * 32 + (within & 3) * 8;
        krow[i] = g >> 4; kcol[i] = (((g & 15) ^ (krow[i] & 7))) * 8; }
#define KPOSC(j, row) ({ int _p = key0 + 64 * (j) + (row); _p = _p < 0 ? 0 : (_p >= L ? L - 1 : _p); (size_t)_p; })
#define DMA_TILE(j, b) do { _Pragma("unroll") for (int _i = 0; _i < 2; ++_i) { \
        __builtin_amdgcn_global_load_lds((const unsigned*)(Vb + KPOSC(j, vrow[_i]) * kvs + vcol[_i]), (LAS unsigned*)(V_lds + (b) * 16384 + (_i * 8 + wid) * 1024), 16, 0, 0); \
        __builtin_amdgcn_global_load_lds((const unsigned*)(Kb + KPOSC(j, krow[_i]) * kvs + kcol[_i]), (LAS unsigned*)(K_lds + (b) * 16384 + (_i * 8 + wid) * 1024), 16, 0, 0); } } while (0)
    asm volatile("s_waitcnt vmcnt(0) lgkmcnt(0)" ::: "memory"); __builtin_amdgcn_s_barrier(); asm volatile("" ::: "memory");
    DMA_TILE(0, 0); DMA_TILE(1, 1);
    int cur = 0;
    for (int j = 0; j < ntiles; ++j) {
        if (j + 1 < ntiles) asm volatile("s_waitcnt vmcnt(4)" ::: "memory"); else asm volatile("s_waitcnt vmcnt(0)" ::: "memory");
        asm volatile("s_waitcnt lgkmcnt(0)" ::: "memory"); __builtin_amdgcn_s_barrier(); asm volatile("" ::: "memory");
        { LAS unsigned char* bgscr = (LAS unsigned char*)lds + LDS_BG + wid * LDS_BGW;
          bg_finish<false>(bg, bs.pend, bs.par, bgscr, lane);
          if (j + 1 < ntiles) bg_issue(bg, bs.it, bs.pend, bs.par, bgscr, lane); }
        if (j + 2 < ntiles) { const int nb = cur == 0 ? 2 : cur - 1; DMA_TILE(j + 2, nb); }
        if (j >= t_lo && j <= t_hi) {
            const LAS char* Kt = K_lds + cur * 16384;
            f32x16 p0 = {}, p1 = {};
#pragma unroll
            for (int d0 = 0; d0 < ND0; ++d0) { const int cb = (d0 * 16 + hi * 8) * 2;
                const bf16x8 b0 = *(const LAS bf16x8*)(Kt + (DQK == 128 ? KSWZ128(r32, cb) : KSWZ64(r32, cb)));
                const bf16x8 b1 = *(const LAS bf16x8*)(Kt + (DQK == 128 ? KSWZ128(32 + r32, cb) : KSWZ64(32 + r32, cb)));
                p0 = __builtin_amdgcn_mfma_f32_32x32x16_bf16(b0, qr[d0], p0, 0, 0, 0);
                p1 = __builtin_amdgcn_mfma_f32_32x32x16_bf16(b1, qr[d0], p1, 0, 0, 0); }
            unsigned vmask = 0xffffffffu;
            if (BAND) { vmask = 0u; const int kb = key0 + 64 * j;
#pragma unroll
                for (int r = 0; r < 16; ++r) { const int k0p = kb + crow(r, hi), k1p = k0p + 32; const int d0p = qpos - k0p, d1p = qpos - k1p;
                    const bool v0 = (d0p <= 64) && (d0p >= -64) && (k0p >= 0) && (k0p < L), v1 = (d1p <= 64) && (d1p >= -64) && (k1p >= 0) && (k1p < L);
                    vmask |= (v0 ? 1u : 0u) << r; vmask |= (v1 ? 1u : 0u) << (16 + r);
                    p0[r] = v0 ? p0[r] : -1e30f; p1[r] = v1 ? p1[r] : -1e30f; } }
            float pmax = p0[0];
#pragma unroll
            for (int r = 1; r < 16; ++r) pmax = fmaxf(pmax, p0[r]);
#pragma unroll
            for (int r = 0; r < 16; ++r) pmax = fmaxf(pmax, p1[r]);
            { auto rr = __builtin_amdgcn_permlane32_swap(__float_as_uint(pmax), __float_as_uint(pmax), false, false); pmax = fmaxf(__uint_as_float(rr[0]), __uint_as_float(rr[1])); }
            float mn, alpha;
            if (__all(pmax - m_reg <= THR / SCALE)) { mn = m_reg; alpha = 1.f; }
            else { mn = fmaxf(m_reg, pmax); alpha = __builtin_amdgcn_exp2f((m_reg - mn) * C); m_reg = mn; }
            const float mnC = -mn * C;
#pragma unroll
            for (int r = 0; r < 16; ++r) { p0[r] = __builtin_amdgcn_exp2f(fmaf(p0[r], C, mnC)); p1[r] = __builtin_amdgcn_exp2f(fmaf(p1[r], C, mnC)); }
            if (BAND) {
#pragma unroll
                for (int r = 0; r < 16; ++r) { p0[r] = ((vmask >> r) & 1u) ? p0[r] : 0.f; p1[r] = ((vmask >> (16 + r)) & 1u) ? p1[r] : 0.f; } }
            float ps = 0.f;
#pragma unroll
            for (int r = 0; r < 16; ++r) ps += p0[r];
#pragma unroll
            for (int r = 0; r < 16; ++r) ps += p1[r];
            { auto rr = __builtin_amdgcn_permlane32_swap(__float_as_uint(ps), __float_as_uint(ps), false, false); ps = __uint_as_float(rr[0]) + __uint_as_float(rr[1]); }
            l_reg = l_reg * alpha + ps;
            bf16x8 pa0, pa1, pa2, pa3;
#define PK4(P, BASE, OUT) do { unsigned a0 = cvt_pk_bf16(P[BASE + 0], P[BASE + 1]), a1 = cvt_pk_bf16(P[BASE + 2], P[BASE + 3]); \
        unsigned b0 = cvt_pk_bf16(P[BASE + 4], P[BASE + 5]), b1 = cvt_pk_bf16(P[BASE + 6], P[BASE + 7]); \
        auto r0 = __builtin_amdgcn_permlane32_swap(a0, b0, false, false); auto r1 = __builtin_amdgcn_permlane32_swap(a1, b1, false, false); \
        u32x4 w = {r0[0], r1[0], r0[1], r1[1]}; OUT = *reinterpret_cast<bf16x8*>(&w); } while (0)
            PK4(p0, 0, pa0); PK4(p0, 8, pa1); PK4(p1, 0, pa2); PK4(p1, 8, pa3);
#undef PK4
            if (__any(alpha < 1.f)) {
                if (hi == 0) al_l[r32] = alpha;
                LDS_WAIT();
#pragma unroll
                for (int r = 0; r < 16; ++r) { const float a = al_l[crow(r, hi)];
#pragma unroll
                    for (int d = 0; d < 4; ++d) o[d][r] *= a; }
            }
            const int vb = vb0 + cur * 16384;
            pv_one<0>(o[0], vb, pa0, pa1, pa2, pa3); pv_one<1>(o[1], vb, pa0, pa1, pa2, pa3); pv_one<2>(o[2], vb, pa0, pa1, pa2, pa3); pv_one<3>(o[3], vb, pa0, pa1, pa2, pa3);
        }
        cur = cur == 2 ? 0 : cur + 1;
    }
    asm volatile("s_waitcnt vmcnt(0) lgkmcnt(0)" ::: "memory");
#undef KPOSC
#undef DMA_TILE
}
}

__device__ __forceinline__ void transpose_item(const float* __restrict__ src, int N, bf16_t* __restrict__ dst, int dK, LAS float* scr, int lane) {
#pragma unroll 8
    for (int i = 0; i < 32; ++i) { const int kk = 2 * i + (lane >> 5); scr[kk * 33 + (lane & 31)] = __builtin_nontemporal_load(src + (size_t)kk * N + (lane & 31)); }
    LDS_WAIT();
    const int c = lane & 7;
#pragma unroll
    for (int j = 0; j < 4; ++j) { const int n = (lane >> 3) + 8 * j; const LAS float* s = scr + (8 * c) * 33 + n;
        u32x4 o; o.x = cvt_pk_bf16(s[0 * 33], s[1 * 33]); o.y = cvt_pk_bf16(s[2 * 33], s[3 * 33]); o.z = cvt_pk_bf16(s[4 * 33], s[5 * 33]); o.w = cvt_pk_bf16(s[6 * 33], s[7 * 33]);
        *(u32x4*)(dst + (size_t)n * dK + 8 * c) = o; }
    LDS_WAIT();
}

__device__ __forceinline__ void transpose_item_fp8(const float* __restrict__ src, int N, unsigned char* __restrict__ dst, int dK, float sc, LAS float* scr, int lane) {
#pragma unroll 8
    for (int i = 0; i < 32; ++i) { const int kk = 2 * i + (lane >> 5); scr[kk * 33 + (lane & 31)] = __builtin_nontemporal_load(src + (size_t)kk * N + (lane & 31)); }
    LDS_WAIT();
    const int c = lane & 7;
#pragma unroll
    for (int j = 0; j < 4; ++j) { const int n = (lane >> 3) + 8 * j; const LAS float* s = scr + (8 * c) * 33 + n;
        u32x2 o; o.x = cvt_pk4_fp8(s[0 * 33] * sc, s[1 * 33] * sc, s[2 * 33] * sc, s[3 * 33] * sc); o.y = cvt_pk4_fp8(s[4 * 33] * sc, s[5 * 33] * sc, s[6 * 33] * sc, s[7 * 33] * sc);
        *(u32x2*)(dst + (size_t)n * dK + 8 * c) = o; }
    LDS_WAIT();
}

__device__ __forceinline__ void phase0(const Params& p, LAS unsigned char* lds, int vcu, int G) {
    unsigned char* ws = p.ws;
    const int tid = fresh_tid(), wave = tid >> 6, lane = tid & 63;
    const int gw = vcu * 8 + wave, NGW = G * 8;
    LAS float* scr = (LAS float*)(lds + wave * 8448);
    { const float* x = p.in[0]; bf16_t* xb = (bf16_t*)(ws + WS_XB); const size_t n8 = (size_t)T_TOK * DM / 8;
      for (size_t i = (size_t)blockIdx.x * NTHREADS + tid; i < n8; i += (size_t)G * NTHREADS) {
          const f32x4 a = __builtin_nontemporal_load((const f32x4*)(x + i * 8)), b = __builtin_nontemporal_load((const f32x4*)(x + i * 8 + 4));
          u32x4 o; o.x = cvt_pk_bf16(a[0], a[1]); o.y = cvt_pk_bf16(a[2], a[3]); o.z = cvt_pk_bf16(b[0], b[1]); o.w = cvt_pk_bf16(b[2], b[3]);
          *(u32x4*)(xb + i * 8) = o;
          u32x2 o8; o8.x = cvt_pk4_fp8(a[0] * SX8, a[1] * SX8, a[2] * SX8, a[3] * SX8); o8.y = cvt_pk4_fp8(b[0] * SX8, b[1] * SX8, b[2] * SX8, b[3] * SX8);
          *(u32x2*)(ws + WS_X8 + i * 8) = o8; } }
    { const float* w_in = p.in[1]; const float* w_br = p.in[7]; const float* w_out = p.in[8];
      bf16_t* WINT = (bf16_t*)(ws + WS_WINT); bf16_t* WBT = (bf16_t*)(ws + WS_WBT); bf16_t* WOT = (bf16_t*)(ws + WS_WOT);
      for (int it = gw; it < 10240 + 1024 + 2048; it += NGW) {
          int r = it;
          if (r < 10240) { const int kb = r / 320, nb = r % 320;
              if (nb >= 144 && nb < 192) transpose_item(w_in + (size_t)(64 * kb) * ZC + 32 * nb, ZC, WINT + (size_t)(32 * nb) * DM + 64 * kb, DM, scr, lane);
              else transpose_item_fp8(w_in + (size_t)(64 * kb) * ZC + 32 * nb, ZC, ws + WS_WING8 + (size_t)(32 * (nb < 144 ? nb : nb - 48)) * DM + 64 * kb, DM, SWG8, scr, lane);
              continue; }
          r -= 10240;
          if (r < 1024) { const int g = r >> 9, r2 = r & 511, kb = r2 >> 6, nb = r2 & 63; transpose_item(w_br + ((size_t)g * 512 + 64 * kb) * DM + 32 * nb, DM, WBT + (size_t)(32 * nb) * 1024 + g * 512 + 64 * kb, 1024, scr, lane); continue; }
          r -= 1024;
          { const int kb = r >> 6, nb = r & 63; transpose_item(w_out + (size_t)(64 * kb) * DM + 32 * nb, DM, WOT + (size_t)(32 * nb) * DM + 64 * kb, DM, scr, lane); }
      } }
    { float* cosA = (float*)(ws + WS_COSA); float* sinA = (float*)(ws + WS_SINA); float* cosB = (float*)(ws + WS_COSB); float* sinB = (float*)(ws + WS_SINB);
      const int gt = blockIdx.x * NTHREADS + tid, NGT = G * NTHREADS;
      for (int i = gt; i < SEQ * 16; i += NGT) { const int pos = i >> 4, k = i & 15; const float inv = (float)pow(500000.0, -(double)k / 16.0); const float ang = (float)pos * inv; cosA[i] = cosf(ang); sinA[i] = sinf(ang); }
      for (int i = gt; i < SEQ * 8; i += NGT) { const int pos = i >> 3, k = i & 7; const float inv = (float)pow(500000.0, -(double)k / 8.0); const float ang = (float)pos * inv; cosB[i] = cosf(ang); sinB[i] = sinf(ang); }
      const float* wr = p.in[11]; float* wrt = (float*)(ws + WS_WRT);
      for (int i = gt; i < NE * DM; i += NGT) { const int e = i >> 11, d = i & (DM - 1); wrt[i] = wr[d * NE + e]; } }
}

__device__ __forceinline__ void moe_weight_convert(LAS unsigned char* lds, const BgConv bg, BgState& bs) {
    const int tid = fresh_tid(), wave = __builtin_amdgcn_readfirstlane(tid >> 6), lane = tid & 63;
    LAS unsigned char* scr = lds + LDS_BG + wave * LDS_BGW;
    for (;;) { bg_finish(bg, bs.pend, bs.par, scr, lane); if (bs.it >= BG_ITEMS) break; bg_issue(bg, bs.it, bs.pend, bs.par, scr, lane); }
}
__device__ __forceinline__ void bg_drain(LAS unsigned char* lds, const BgConv bg, BgState& bs) {
    const int tid = fresh_tid(), wave = __builtin_amdgcn_readfirstlane(tid >> 6), lane = tid & 63;
    bg_finish(bg, bs.pend, bs.par, lds + LDS_BG + wave * LDS_BGW, lane);
}

__device__ __forceinline__ void dil_item(const Params& p, LAS unsigned char* lds, int idx, const BgConv bg, BgState& bs) {
    using namespace att;
    unsigned char* ws = p.ws;
    const bf16_t* Z = (const bf16_t*)(ws + WS_Z); bf16_t* OG = (bf16_t*)(ws + WS_OG); float* LSEG = (float*)(ws + WS_LSEG);
    const int tid = fresh_tid(), wid = __builtin_amdgcn_readfirstlane(tid >> 6), lane = tid & 63, r32 = lane & 31, hi = lane >> 5;
    const int sub = idx & 15, h = (idx >> 4) & 3, bgi = idx >> 6, g = bgi % 3, b = bgi / 3;
    const int lr = g * 2, r = 1 << lr, L = SEQ >> lr, phase = sub & (r - 1), qb = sub >> lr;
    const int head = g * 4 + h;
    const int qpos = qb * 256 + wid * 32 + r32;
    const size_t tokq = (size_t)b * SEQ + phase + (size_t)r * qpos;
    const bf16_t* Qw = Z + tokq * ZC + head * 128 + hi * 8;
    const bf16_t* Kb = Z + ((size_t)b * SEQ + phase) * ZC + 1536 + head * 128;
    const bf16_t* Vb = Z + ((size_t)b * SEQ + phase) * ZC + 3072 + head * 128;
    f32x16 o[4] = {}; float m_reg = -1e30f, l_reg = 0.f;
    attn_pass_band_dma(Qw, Kb, Vb, (size_t)r * ZC, qb * 256 - 64, L, qpos, wid >> 1, (wid >> 1) + 2, (LAS char*)lds, o, m_reg, l_reg, bg, bs);
    LAS float* li_l = (LAS float*)(lds + 98304) + wid * 64 + 32;
    int r32e = r32, hie = hi; asm volatile("" : "+v"(r32e), "+v"(hie));
    if (hie == 0) { li_l[r32e] = l_reg; const size_t tq = (size_t)b * SEQ + phase + (size_t)r * (qb * 256 + wid * 32 + r32e); LSEG[((size_t)g * T_TOK + tq) * 4 + h] = m_reg * 0.08838834764831845f + __logf(l_reg); }
    LDS_WAIT();
#pragma unroll
    for (int rr = 0; rr < 16; ++rr) { const int row = crow(rr, hie); const float rl = 1.f / li_l[row];
        const size_t tok = (size_t)b * SEQ + phase + (size_t)r * (qb * 256 + wid * 32 + row);
        bf16_t* op = OG + ((size_t)g * T_TOK + tok) * 512 + h * 128 + r32e;
#pragma unroll
        for (int d0 = 0; d0 < 4; ++d0) op[d0 * 32] = f2bf(o[d0][rr] * rl);
        asm volatile("" ::: "memory"); }
    LDS_WAIT();
}

__device__ __forceinline__ void diff_item(const Params& p, LAS unsigned char* lds, int item, const BgConv bg, BgState& bs) {
    using namespace att;
    unsigned char* ws = p.ws;
    const bf16_t* Z = (const bf16_t*)(ws + WS_Z); float* O0 = (float*)(ws + WS_O0); bf16_t* BR = (bf16_t*)(ws + WS_BR);
    const int tid = fresh_tid(), wid = __builtin_amdgcn_readfirstlane(tid >> 6), lane = tid & 63, r32 = lane & 31, hi = lane >> 5;
    const int b = item >> 6, h = (item >> 4) & 3, qb = item & 15;
    const size_t tok0 = (size_t)b * SEQ + qb * 256 + wid * 32;
    LAS float* li_l = (LAS float*)(lds + 65536) + wid * 64 + 32;
    for (int c = 0; c < 2; ++c) {
        const bf16_t* Qw = Z + (tok0 + r32) * ZC + 4608 + h * 128 + c * 64 + hi * 8;
        const bf16_t* Kb = Z + ((size_t)b * SEQ) * ZC + 5120 + h * 128 + c * 64;
        const bf16_t* Vb = Z + ((size_t)b * SEQ) * ZC + 5632 + h * 128;
        f32x16 o[4] = {}; float m_reg = -1e30f, l_reg = 0.f;
        attn_pass<64, false>(Qw, Kb, Vb, (size_t)ZC, SEQ / 64, 0, SEQ, 0, 0, SEQ / 64 - 1, (LAS char*)lds, o, m_reg, l_reg, bg, bs);
        int r32e = r32, hie = hi, lanee = lane; asm volatile("" : "+v"(r32e), "+v"(hie), "+v"(lanee));
        if (hie == 0) li_l[r32e] = l_reg;
        LDS_WAIT();
        if (c == 0) {
#pragma unroll
            for (int rr = 0; rr < 16; ++rr) { const int row = crow(rr, hie); const float rl = 1.f / li_l[row];
                float* op = O0 + (tok0 + row) * 512 + h * 128 + r32e;
#pragma unroll
                for (int d0 = 0; d0 < 4; ++d0) op[d0 * 32] = o[d0][rr] * rl;
                asm volatile("" ::: "memory"); }
        } else {
            const float s1 = wave_sum(p.in[2][lanee] * p.in[3][lanee]), s2 = wave_sum(p.in[4][lanee] * p.in[5][lanee]);
            const float lam = __expf(s1) - __expf(s2) + 0.2f;
            const float* nw = p.in[6];
            float nwv[4];
#pragma unroll
            for (int d0 = 0; d0 < 4; ++d0) nwv[d0] = nw[d0 * 32 + r32e] * 0.8f;
#pragma unroll
            for (int rr = 0; rr < 16; ++rr) { const int row = crow(rr, hie); const float rl = 1.f / li_l[row];
                const float* ip = O0 + (tok0 + row) * 512 + h * 128 + r32e;
                float v[4], ss = 0.f;
#pragma unroll
                for (int d0 = 0; d0 < 4; ++d0) { v[d0] = ip[d0 * 32] - lam * (o[d0][rr] * rl); ss += v[d0] * v[d0]; }
                ss = half_sum(ss);
                const float rinv = rsqrtf(ss * (1.f / 128.f) + 1e-5f);
                bf16_t* op = BR + (tok0 + row) * 1024 + 512 + h * 128 + r32e;
#pragma unroll
                for (int d0 = 0; d0 < 4; ++d0) op[d0 * 32] = f2bf(v[d0] * rinv * nwv[d0]);
                asm volatile("" ::: "memory"); }
        }
        LDS_WAIT();
    }
}

__device__ __forceinline__ void combine_rows(const Params& p, int vcu, int G) {
    unsigned char* ws = p.ws;
    const bf16_t* OG = (const bf16_t*)(ws + WS_OG); const float* LSEG = (const float*)(ws + WS_LSEG); bf16_t* BR = (bf16_t*)(ws + WS_BR);
    const int tid = fresh_tid(), wave = tid >> 6, lane = tid & 63;
    const int h = lane >> 4;
    for (int t = vcu * 8 + wave; t < T_TOK; t += G * 8) {
        const float l0 = LSEG[((size_t)0 * T_TOK + t) * 4 + h], l1 = LSEG[((size_t)1 * T_TOK + t) * 4 + h], l2 = LSEG[((size_t)2 * T_TOK + t) * 4 + h];
        const float mx = fmaxf(l0, fmaxf(l1, l2)); float w0 = __expf(l0 - mx), w1 = __expf(l1 - mx), w2 = __expf(l2 - mx); const float inv = 1.f / (w0 + w1 + w2); w0 *= inv; w1 *= inv; w2 *= inv;
        const u32x4 a = *(const u32x4*)(OG + ((size_t)0 * T_TOK + t) * 512 + lane * 8), bq = *(const u32x4*)(OG + ((size_t)1 * T_TOK + t) * 512 + lane * 8), cq = *(const u32x4*)(OG + ((size_t)2 * T_TOK + t) * 512 + lane * 8);
        u32x4 o;
#pragma unroll
        for (int k = 0; k < 4; ++k) { const float lo = w0 * bf_lo(a[k]) + w1 * bf_lo(bq[k]) + w2 * bf_lo(cq[k]), hi2 = w0 * bf_hi(a[k]) + w1 * bf_hi(bq[k]) + w2 * bf_hi(cq[k]); o[k] = cvt_pk_bf16(lo, hi2); }
        *(u32x4*)(BR + (size_t)t * 1024 + lane * 8) = o;
    }
}

__device__ __forceinline__ void ln1_router(const Params& p, LAS unsigned char* lds, int vcu, int G) {
    unsigned char* ws = p.ws;
    const float* V1 = p.in[0]; const bf16_t* MIX = (const bf16_t*)(ws + WS_MIX); unsigned char* X1B = ws + WS_X1B;     const float* wrt = (const float*)(ws + WS_WRT); float* AFFT = (float*)(ws + WS_AFFT);
    const float* g1 = p.in[9]; const float* b1 = p.in[10];
    const int tid = fresh_tid(), wave = tid >> 6, lane = tid & 63;
    __syncthreads();
    for (int i = tid; i < NE * DM / 4; i += NTHREADS) ((LAS f32x4*)lds)[i] = ((const f32x4*)wrt)[i];
    __syncthreads();
    for (int rp = vcu * 8 + wave; rp < T_TOK / 4; rp += G * 8) {
        const int t0 = rp * 4;
        f32x4 v[4][8];
#pragma unroll
        for (int q = 0; q < 4; ++q) {
            const float* xr = V1 + (size_t)(t0 + q) * DM + lane * 4; const bf16_t* mr = MIX + (size_t)(t0 + q) * DM + lane * 4; float s = 0.f;
#pragma unroll
            for (int j = 0; j < 8; ++j) { v[q][j] = __builtin_nontemporal_load((const f32x4*)(xr + 256 * j)) * ALPHA + pg8::ld_bf16x4(mr + 256 * j); s += (v[q][j][0] + v[q][j][1]) + (v[q][j][2] + v[q][j][3]); }
            const float mean = wave_sum(s) * (1.f / DM); float s2 = 0.f;
#pragma unroll
            for (int j = 0; j < 8; ++j) { v[q][j] = v[q][j] - mean; s2 += (v[q][j][0] * v[q][j][0] + v[q][j][1] * v[q][j][1]) + (v[q][j][2] * v[q][j][2] + v[q][j][3] * v[q][j][3]); }
            const float rstd = rsqrtf(wave_sum(s2) * (1.f / DM) + LN_EPS);
            unsigned char* xbo = X1B + (size_t)(t0 + q) * DM + lane * 4;
#pragma unroll
            for (int j = 0; j < 8; ++j) { const f32x4 gg = *(const f32x4*)(g1 + lane * 4 + 256 * j), bb = *(const f32x4*)(b1 + lane * 4 + 256 * j);
                v[q][j] = v[q][j] * rstd * gg + bb; *(unsigned*)(xbo + 256 * j) = cvt_pk4_fp8(v[q][j][0] * SX8, v[q][j][1] * SX8, v[q][j][2] * SX8, v[q][j][3] * SX8); }
            asm volatile("" ::: "memory");
        }
        float lg[4] = {0.f, 0.f, 0.f, 0.f};
        const LAS float* wl = (const LAS float*)lds + lane * 4;
#pragma unroll 1
        for (int e = 0; e < NE; ++e) {
            f32x4 W[8];
#pragma unroll
            for (int j = 0; j < 8; ++j) W[j] = *(const LAS f32x4*)(wl + e * DM + 256 * j);
#pragma unroll
            for (int q = 0; q < 4; ++q) { float a = 0.f;
#pragma unroll
                for (int j = 0; j < 8; ++j) a += (v[q][j][0] * W[j][0] + v[q][j][1] * W[j][1]) + (v[q][j][2] * W[j][2] + v[q][j][3] * W[j][3]);
                a = wave_sum(a); lg[q] = (lane == e) ? a : lg[q]; }
        }
#pragma unroll
        for (int q = 0; q < 4; ++q) {
            float mx = lg[q];
            mx = fmaxf(mx, swz_xor<1>(mx)); mx = fmaxf(mx, swz_xor<2>(mx)); mx = fmaxf(mx, swz_xor<4>(mx)); mx = fmaxf(mx, swz_xor<8>(mx));
            const float ex = expf(lg[q] - mx); float sum = ex;
            sum += swz_xor<1>(sum); sum += swz_xor<2>(sum); sum += swz_xor<4>(sum); sum += swz_xor<8>(sum);
            const int t = t0 + q, bb = t >> 12, s = t & (SEQ - 1);
            if (lane < NE) AFFT[((size_t)bb * NE + lane) * SEQ + s] = ex / sum;
        }
    }
}

__device__ __forceinline__ void topk_gather(const Params& p, LAS unsigned char* lds, int G) {
    unsigned char* ws = p.ws;
    const float* AFFT = (const float*)(ws + WS_AFFT); int* SLOT = (int*)(ws + WS_SLOT); float* GATE = (float*)(ws + WS_GATE);
    const unsigned char* X1B = ws + WS_X1B; unsigned char* XG = ws + WS_XG;
    const int tid = fresh_tid(), wave = tid >> 6, lane = tid & 63;
    LAS unsigned* hist = (LAS unsigned*)lds;
    LAS unsigned* ctl = hist + 256;
    LAS unsigned* wtot = hist + 272;
    LAS int* rows = (LAS int*)(hist + 288);
    for (int item = blockIdx.x; item < NB * NE * 4; item += G) {
        const int qd = item & 3, be = item >> 2, b = be >> 4, e = be & 15;
        const float* ap = AFFT + (size_t)be * SEQ + tid * 8;
        const f32x4 fa = *(const f32x4*)ap, fb = *(const f32x4*)(ap + 4);
        float av[8] = {fa[0], fa[1], fa[2], fa[3], fb[0], fb[1], fb[2], fb[3]};
        unsigned key[8];
#pragma unroll
        for (int i = 0; i < 8; ++i) key[i] = __float_as_uint(av[i]);
        unsigned prefix = 0u, mask = 0u, remaining = CAP;
        for (int pass = 0; pass < 4; ++pass) {
            const int shift = 24 - 8 * pass;
            __syncthreads();
            if (tid < 256) hist[tid] = 0u;
            __syncthreads();
#pragma unroll
            for (int i = 0; i < 8; ++i) if ((key[i] & mask) == prefix) atomicAdd((unsigned*)&hist[(key[i] >> shift) & 255u], 1u);
            __syncthreads();
            if (wave == 0) {
                unsigned c0 = hist[4 * lane], c1 = hist[4 * lane + 1], c2 = hist[4 * lane + 2], c3 = hist[4 * lane + 3];
                const unsigned t = c0 + c1 + c2 + c3; unsigned v = t;
#pragma unroll
                for (int of = 1; of < 64; of <<= 1) { const unsigned u = __shfl_down(v, of); if (lane + of < 64) v += u; }
                unsigned cum = v - t;
                unsigned cs[4] = {c0, c1, c2, c3};
#pragma unroll
                for (int k = 3; k >= 0; --k) { if (cum < remaining && cum + cs[k] >= remaining) { ctl[0] = 4 * lane + k; ctl[1] = remaining - cum; } cum += cs[k]; }
            }
            __syncthreads();
            prefix |= ctl[0] << shift; mask |= 0xFFu << shift; remaining = ctl[1];
        }
        const unsigned Tk = prefix, need_eq = remaining, cnt_gt_total = CAP - need_eq;
        unsigned ngt = 0, neq = 0;
#pragma unroll
        for (int i = 0; i < 8; ++i) { ngt += key[i] > Tk ? 1u : 0u; neq += key[i] == Tk ? 1u : 0u; }
        const unsigned packed = ngt | (neq << 16); unsigned incl = packed;
#pragma unroll
        for (int of = 1; of < 64; of <<= 1) { const unsigned u = __shfl_up(incl, of); if (lane >= of) incl += u; }
        __syncthreads();
        if (lane == 63) wtot[wave] = incl;
        __syncthreads();
        unsigned base = 0;
        for (int w = 0; w < wave; ++w) base += wtot[w];
        unsigned excl = base + incl - packed; unsigned rgt = excl & 0xffffu, req = excl >> 16;
        int slots[8];
#pragma unroll
        for (int i = 0; i < 8; ++i) { int sl = -1;
            if (key[i] > Tk) { sl = (int)rgt; ++rgt; } else if (key[i] == Tk) { if (req < need_eq) sl = (int)(cnt_gt_total + req); ++req; }
            slots[i] = sl;
            if (sl >= 0) { if ((sl >> 7) == qd) rows[sl & 127] = tid * 8 + i; if (qd == 0) GATE[(size_t)e * 2048 + b * CAP + sl] = av[i]; } }
        if (qd == 0) { int* sp = SLOT + (size_t)be * SEQ + tid * 8; *(int4*)sp = make_int4(slots[0], slots[1], slots[2], slots[3]); *(int4*)(sp + 4) = make_int4(slots[4], slots[5], slots[6], slots[7]); }
        __syncthreads();
        for (int r = wave; r < 128; r += 8) {
            const int s = rows[r];
            const u32x4* src = (const u32x4*)(X1B + ((size_t)b * SEQ + s) * DM); u32x4* dst = (u32x4*)(XG + ((size_t)e * 2048 + b * CAP + qd * 128 + r) * DM);
#pragma unroll
            for (int j = 0; j < 2; ++j) dst[lane + 64 * j] = __builtin_nontemporal_load(src + lane + 64 * j);
        }
    }
}

__device__ __forceinline__ void ln2_rows(const Params& p, int vcu, int G) {
    unsigned char* ws = p.ws;
    const bf16_t* YS = (const bf16_t*)(ws + WS_YS); const int* SLOT = (const int*)(ws + WS_SLOT);
    const float* g2 = p.in[15]; const float* b2 = p.in[16]; float* out = p.out;
    const int tid = fresh_tid(), wave = tid >> 6, lane = tid & 63;
    for (int t = vcu * 8 + wave; t < T_TOK; t += G * 8) {
        const int b = t >> 12, s = t & (SEQ - 1);
        const int myslot = lane < NE ? SLOT[((size_t)b * NE + lane) * SEQ + s] : -1;
        f32x4 v[8];
        const float* xr = p.in[0] + (size_t)t * DM + lane * 4; const bf16_t* mr = (const bf16_t*)(ws + WS_MIX) + (size_t)t * DM + lane * 4;
        { float s0 = 0.f;
#pragma unroll
          for (int j = 0; j < 8; ++j) { const u32x2 mw = __builtin_nontemporal_load((const u32x2*)(mr + 256 * j)); const f32x4 mv = {bf_lo(mw.x), bf_hi(mw.x), bf_lo(mw.y), bf_hi(mw.y)};
              v[j] = __builtin_nontemporal_load((const f32x4*)(xr + 256 * j)) * ALPHA + mv; s0 += (v[j][0] + v[j][1]) + (v[j][2] + v[j][3]); }
          const float mean1 = wave_sum(s0) * (1.f / DM); float q1 = 0.f;
#pragma unroll
          for (int j = 0; j < 8; ++j) { v[j] = v[j] - mean1; q1 += (v[j][0] * v[j][0] + v[j][1] * v[j][1]) + (v[j][2] * v[j][2] + v[j][3] * v[j][3]); }
          const float rstd1 = rsqrtf(wave_sum(q1) * (1.f / DM) + LN_EPS);
#pragma unroll
          for (int j = 0; j < 8; ++j) { const f32x4 gg = *(const f32x4*)(p.in[9] + lane * 4 + 256 * j), bb = *(const f32x4*)(p.in[10] + lane * 4 + 256 * j); v[j] = (v[j] * rstd1 * gg + bb) * ALPHA; } }
        for (int e = 0; e < NE; ++e) {
            const int sl = __builtin_amdgcn_readlane(myslot, e);
            if (sl >= 0) { const bf16_t* yr = YS + ((size_t)e * 2048 + b * CAP + sl) * DM + lane * 4;
#pragma unroll
                for (int j = 0; j < 8; ++j) { const u32x2 yw = __builtin_nontemporal_load((const u32x2*)(yr + 256 * j)); v[j] += (f32x4){bf_lo(yw.x), bf_hi(yw.x), bf_lo(yw.y), bf_hi(yw.y)}; } }
        }
        float sm = 0.f;
#pragma unroll
        for (int j = 0; j < 8; ++j) sm += (v[j][0] + v[j][1]) + (v[j][2] + v[j][3]);
        const float mean = wave_sum(sm) * (1.f / DM); float s2 = 0.f;
#pragma unroll
        for (int j = 0; j < 8; ++j) { v[j] = v[j] - mean; s2 += (v[j][0] * v[j][0] + v[j][1] * v[j][1]) + (v[j][2] * v[j][2] + v[j][3] * v[j][3]); }
        const float rstd = rsqrtf(wave_sum(s2) * (1.f / DM) + LN_EPS);
        float* orow = out + (size_t)t * DM + lane * 4;
#pragma unroll
        for (int j = 0; j < 8; ++j) { const f32x4 gg = *(const f32x4*)(g2 + lane * 4 + 256 * j), bb = *(const f32x4*)(b2 + lane * 4 + 256 * j); __builtin_nontemporal_store(v[j] * rstd * gg + bb, (f32x4*)(orow + 256 * j)); }
    }
}

__global__ void __launch_bounds__(NTHREADS, 2) mega(Params p) {
    extern __shared__ __attribute__((aligned(16))) unsigned char shm[];
    LAS unsigned char* lds = (LAS unsigned char*)shm;
    cg::grid_group grid = cg::this_grid();
    const int G = gridDim.x, bx = blockIdx.x;
    const int vcu = (G % 8 == 0) ? (bx % 8) * (G / 8) + bx / 8 : bx;
    unsigned char* ws = p.ws;
    if (fresh_tid() < 16) ((LAS unsigned*)(lds + LDS_BARW))[fresh_tid()] = 0u;
    __syncthreads();
    const XcdBarrier xb = xcd_barrier_post((unsigned*)(ws + WS_BARW), (volatile LAS unsigned*)(lds + LDS_BARW));

    const BgConv bg{p.in[12], p.in[13], p.in[14], ws + WS_WGUT, ws + WS_WDT, G * 8, 0};
    BgState bs; bs.it = vcu * 8 + __builtin_amdgcn_readfirstlane(fresh_tid() >> 6); bs.pend = -1; bs.par = 0; bs.tick = 0;
    if (PHASE_MASK & 1) REPS(0) phase0(p, lds, vcu, G);
    if (p.ws == nullptr) grid.sync();
    xcd_barrier(xb);
    if (PHASE_MASK & 2) REPS(1) {
      { pg8::Gemm g{(const bf16_t*)(ws + WS_XB), (const bf16_t*)(ws + WS_WINT) + (size_t)4608 * DM, T_TOK, 1536, DM}; pg8::InBf16Order S{G, bx};
        pg8::EpiZ E{(bf16_t*)(ws + WS_Z), (const float*)(ws + WS_COSA), (const float*)(ws + WS_SINA), (const float*)(ws + WS_COSB), (const float*)(ws + WS_SINB), 18, 1.f};
        pg8::gemm_phase(lds, g, S, E); }
      { pg8::Gemm g{(const bf16_t*)(ws + WS_X8), (const bf16_t*)(ws + WS_WING8), T_TOK, 8704, DM}; pg8::InFp8Order S{G, bx};
        pg8::EpiInFp8 E{pg8::EpiZ{(bf16_t*)(ws + WS_Z), (const float*)(ws + WS_COSA), (const float*)(ws + WS_SINA), (const float*)(ws + WS_COSB), (const float*)(ws + WS_SINB), 0, 1.f / (SX8 * SWG8)}, pg8::EpiGate{ws + WS_GF}};
        pg8::gemm_phase<pg8::EpiInFp8, pg8::InFp8Order, true>(lds, g, S, E); } }
    xcd_barrier(xb);
    if (PHASE_MASK & 4) REPS(2) for (int it = vcu; it < 768; it += G) dil_item(p, lds, it, bg, bs);
    bg_drain(lds, bg, bs);
    xcd_barrier(xb);
    if (PHASE_MASK & 8) REPS(3) combine_rows(p, vcu, G);
    if (PHASE_MASK & 16) REPS(4) for (int it = vcu; it < 256; it += G) diff_item(p, lds, it, bg, bs);
    bg_drain(lds, bg, bs);
    xcd_barrier(xb);
    if (PHASE_MASK & 32) REPS(5) { pg8::Gemm g{(const bf16_t*)(ws + WS_BR), (const bf16_t*)(ws + WS_WBT), T_TOK, DM, 1024}; pg8::StaticOrder S; S.init(T_TOK, DM, G, bx);
      pg8::EpiBranch E{(bf16_t*)(ws + WS_MERGED), ws + WS_GF};
      pg8::gemm_phase(lds, g, S, E); }
    xcd_barrier(xb);
    if (PHASE_MASK & 64) REPS(6) { pg8::Gemm g{(const bf16_t*)(ws + WS_MERGED), (const bf16_t*)(ws + WS_WOT), T_TOK, DM, DM}; pg8::StaticOrder S; S.init(T_TOK, DM, G, bx);
      pg8::EpiOut E{(bf16_t*)(ws + WS_MIX)};
      pg8::gemm_phase(lds, g, S, E); }
    xcd_barrier(xb);
    if (PHASE_MASK & 128) moe_weight_convert(lds, bg, bs);
    if (PHASE_MASK & 256) REPS(8) ln1_router(p, lds, vcu, G);
    xcd_barrier(xb);
    if (PHASE_MASK & 512) REPS(9) topk_gather(p, lds, G);
    xcd_barrier(xb);
    if (PHASE_MASK & 1024) REPS(10) { pg8::Gemm g{(const bf16_t*)(ws + WS_XG), (const bf16_t*)(ws + WS_WGUT), NE * 2048, NE * 4096, DM}; pg8::UpOrder S{G, bx};
      pg8::EpiUp E{ws + WS_H};
      pg8::gemm_phase<pg8::EpiUp, pg8::UpOrder, true>(lds, g, S, E); }
    xcd_barrier(xb);
    if (PHASE_MASK & 2048) REPS(11) { pg8::Gemm g{(const bf16_t*)(ws + WS_H), (const bf16_t*)(ws + WS_WDT), NE * 2048, NE * 2048, DM}; pg8::DownOrder S{G, bx};
      pg8::EpiDown E{(bf16_t*)(ws + WS_YS), (const float*)(ws + WS_GATE)};
      pg8::gemm_phase<pg8::EpiDown, pg8::DownOrder, true>(lds, g, S, E); }
    xcd_barrier(xb);
    if (PHASE_MASK & 4096) REPS(12) ln2_rows(p, vcu, G);
}

extern "C" void kernel_launch(void* const* d_in, const int* in_sizes, int n_in, void* d_out, int out_size, void* d_ws, size_t ws_size, hipStream_t stream) {
    static int grid = 0;
    if (grid == 0) {
        if (n_in != 17 || out_size != T_TOK * DM || ws_size < WS_END) { fprintf(stderr, "kernel_launch: unexpected shapes (n_in %d out %d ws %zu, need ws >= %zu)\n", n_in, out_size, ws_size, (size_t)WS_END); grid = -1; return; }
        int dev = 0, cus = 0, per_cu = 0;
        hipGetDevice(&dev); hipDeviceGetAttribute(&cus, hipDeviceAttributeMultiprocessorCount, dev);
        if (hipFuncSetAttribute((const void*)mega, hipFuncAttributeMaxDynamicSharedMemorySize, LDS_BYTES) != hipSuccess) { fprintf(stderr, "kernel_launch: hipFuncSetAttribute failed\n"); grid = -1; return; }
        if (hipOccupancyMaxActiveBlocksPerMultiprocessor(&per_cu, (const void*)mega, NTHREADS, LDS_BYTES) != hipSuccess || per_cu < 1) { fprintf(stderr, "kernel_launch: occupancy query gave %d\n", per_cu); per_cu = 1; }
        (void)hipGetLastError();
        grid = cus * per_cu;
    }
    if (grid < 0) return;
    Params p{};
    for (int i = 0; i < 17; ++i) p.in[i] = (const float*)d_in[i];
    p.out = (float*)d_out; p.ws = (unsigned char*)d_ws;
    void* args[] = {&p};
    if (hipMemsetAsync((char*)d_ws + WS_BARW, 0, XCD_BAR_WORDS * 4, stream) != hipSuccess) { fprintf(stderr, "kernel_launch: memset of the barrier words failed\n"); return; }
    hipError_t e = hipLaunchCooperativeKernel((void*)mega, dim3(grid), dim3(NTHREADS), args, LDS_BYTES, stream);
    if (e != hipSuccess) fprintf(stderr, "cooperative launch failed: %s (grid %d)\n", hipGetErrorString(e), grid);
}
```
